# Optimizing an MI355X kernel written in HIP

```python
import jax
import jax.numpy as jnp
from jax import lax
import numpy as np

D_MODEL = 2048
BATCH = 2
SEQ = 4096
DEPTH = 1

ATT_HEADS = 8
ATT_KV_HEADS = 2
HEAD_DIM = 128
IDX_HEADS = 8
IDX_DIM = 64
TOPK_MAX = 256
Q_BLOCK = 128
ROPE_THETA = 10000.0
ATT_SCALE = HEAD_DIM ** -0.5
IDX_SCALE = (IDX_HEADS * IDX_DIM) ** -0.5
HG_HEADS = 8
HG_KEY_DIM = 128
HG_VAL_DIM = 128
HG_CHUNK = 64
N_GROUPS = 4
EXPERTS_PER_GROUP = 8
N_EXPERTS = N_GROUPS * EXPERTS_PER_GROUP
EXPERT_FF = D_MODEL // 4
EPS = 1e-6

IN_SPLITS = (ATT_HEADS * HEAD_DIM, ATT_KV_HEADS * HEAD_DIM, ATT_KV_HEADS * HEAD_DIM,
             IDX_HEADS * IDX_DIM, IDX_DIM, IDX_HEADS,
             HG_HEADS * HG_KEY_DIM, HG_HEADS * HG_KEY_DIM, HG_HEADS * HG_VAL_DIM, HG_HEADS * HG_VAL_DIM,
             D_MODEL, D_MODEL)
IN_WIDTH = sum(IN_SPLITS)

kernel_name = 'hybrid_dsa_hgrn2_hmoe_block'


def rmsnorm(x, g):
    xf = x.astype(jnp.float32)
    y = xf * lax.rsqrt(jnp.mean(xf * xf, axis=-1, keepdims=True) + EPS)
    return (y * g.astype(jnp.float32)).astype(x.dtype)


def ada_norm(x, g, shift, scale):
    return rmsnorm(x, g) * (1 + scale[:, None]) + shift[:, None]


def split_cols(z):
    parts = []
    off = 0
    for w in IN_SPLITS:
        parts.append(z[..., off:off + w])
        off += w
    return parts


def rope_tables(positions, dim):
    inv = jnp.power(ROPE_THETA, -jnp.arange(0, dim, 2, dtype=jnp.float32) / dim)
    ang = positions.astype(jnp.float32)[..., None] * inv
    return jnp.cos(ang), jnp.sin(ang)


def apply_rope(x, cos, sin):
    xf = x.astype(jnp.float32)
    half = x.shape[-1] // 2
    x1, x2 = xf[..., :half], xf[..., half:]
    c, s = cos[:, :, None], sin[:, :, None]
    return jnp.concatenate([x1 * c - x2 * s, x2 * c + x1 * s], axis=-1).astype(x.dtype)


def dsa_attention(q, k, v, q_idx, k_idx, w_idx):
    b, s = q.shape[0], q.shape[1]
    n_blk = s // Q_BLOCK
    topk = min(TOPK_MAX, s // 4)
    k_idx32 = k_idx.astype(jnp.float32)
    key_pos = jnp.arange(s)

    def to_blocks(a):
        return jnp.moveaxis(a.reshape((b, n_blk, Q_BLOCK) + a.shape[2:]), 1, 0)

    def block(args):
        qb, qib, wib, start = args
        t = start + jnp.arange(Q_BLOCK)
        causal = key_pos[None, :] <= t[:, None]
        dots = jnp.einsum('bqhd,bsd->bqhs', qib.astype(jnp.float32), k_idx32)
        score = jnp.einsum('bqh,bqhs->bqs', wib.astype(jnp.float32) * IDX_SCALE, jax.nn.relu(dots))
        score = jnp.where(causal[None], score, -jnp.inf)
        _, sel = lax.top_k(score, topk)
        valid = sel <= t[None, :, None]
        k_sel = jax.vmap(lambda kb, ib: kb[ib])(k, sel)
        v_sel = jax.vmap(lambda vb, ib: vb[ib])(v, sel)
        logits = jnp.einsum('bqhgd,bqkhd->bhgqk', qb.astype(jnp.float32), k_sel.astype(jnp.float32)) * ATT_SCALE
        logits = jnp.where(valid[:, None, None], logits, -jnp.inf)
        p = jax.nn.softmax(logits, axis=-1)
        return jnp.einsum('bhgqk,bqkhd->bqhgd', p.astype(v.dtype), v_sel)

    starts = jnp.arange(n_blk) * Q_BLOCK
    out = lax.map(block, (to_blocks(q), to_blocks(q_idx), to_blocks(w_idx), starts))
    return jnp.moveaxis(out, 0, 1).reshape(b, s, -1)


def hgrn2_recurrence(q, f_logit, i, lb):
    b, s, h, dk = q.shape
    dv = i.shape[-1]
    n_c = s // HG_CHUNK
    f32 = jnp.float32
    lb = lb.astype(f32)
    q = jax.nn.silu(q.astype(f32))
    f = lb + (1.0 - lb) * jax.nn.sigmoid(f_logit.astype(f32))
    log_f = jnp.log(f)
    k = 1.0 - f

    def chunks(a):
        return a.reshape((b, n_c, HG_CHUNK) + a.shape[2:])

    q, log_f, k, v = chunks(q), chunks(log_f), chunks(k), chunks(i.astype(f32))
    cum = jnp.cumsum(log_f, axis=2)
    cum_last = cum[:, :, -1]
    q_dec = q * jnp.exp(cum)
    k_dec = k * jnp.exp(-cum)
    att = jnp.einsum('bnthk,bnshk->bnhts', q_dec, k_dec)
    tril = jnp.tril(jnp.ones((HG_CHUNK, HG_CHUNK), dtype=bool))
    att = jnp.where(tril, att, 0.0)
    intra = jnp.einsum('bnhts,bnshv->bnthv', att, v)
    k_to_end = k * jnp.exp(cum_last[:, :, None] - cum)
    upd = jnp.einsum('bnshk,bnshv->bnhkv', k_to_end, v)

    def step(state, inp):
        decay, u = inp
        return decay[..., None] * state + u, state

    init = jnp.zeros((b, h, dk, dv), f32)
    _, s_prev = lax.scan(step, init, (jnp.moveaxis(jnp.exp(cum_last), 1, 0), jnp.moveaxis(upd, 1, 0)))
    s_prev = jnp.moveaxis(s_prev, 0, 1)
    inter = jnp.einsum('bnthk,bnhkv->bnthv', q_dec, s_prev)
    return (intra + inter).reshape(b, s, h, dv)


def hier_moe(h, w_rg, b_rg, w_re, b_re, w_gate, w_up, w_down):
    b, s, _ = h.shape
    g_logit = (h @ w_rg).astype(jnp.float32) + b_rg.astype(jnp.float32)
    p_grp, grp = lax.top_k(jax.nn.softmax(g_logit, axis=-1), 1)
    e_logit = ((h @ w_re).astype(jnp.float32) + b_re.astype(jnp.float32)).reshape(b, s, N_GROUPS, EXPERTS_PER_GROUP)
    e_in_grp = jnp.take_along_axis(e_logit, grp[..., None], axis=2)[:, :, 0]
    p_e, e_idx = lax.top_k(jax.nn.softmax(e_in_grp, axis=-1), 2)
    p_e = p_e / jnp.sum(p_e, axis=-1, keepdims=True)
    w_tok = p_grp * p_e
    comb = jnp.sum(jax.nn.one_hot(e_idx, EXPERTS_PER_GROUP, dtype=jnp.float32) * w_tok[..., None], axis=2)
    y = jnp.zeros_like(h)
    for gi in range(N_GROUPS):
        cg = jnp.where(grp == gi, comb, 0.0).astype(h.dtype)
        lo, hi = gi * EXPERTS_PER_GROUP, (gi + 1) * EXPERTS_PER_GROUP
        a = jnp.einsum('bsd,edf->bsef', h, w_gate[lo:hi])
        u = jnp.einsum('bsd,edf->bsef', h, w_up[lo:hi])
        y = y + jnp.einsum('bsef,efd->bsd', jax.nn.silu(a) * u * cg[..., None], w_down[lo:hi])
    return y


def setup_inputs(seed: int = 0) -> dict:
    key = jax.random.key(seed)
    ks = jax.random.split(key, 24)
    f32 = jnp.float32

    def nrm(k, shape, scale):
        return jax.random.normal(k, shape, f32) * scale

    d = D_MODEL
    hgw = HG_HEADS * HG_KEY_DIM
    return {
        'x': nrm(ks[0], (BATCH, SEQ, d), 1.0),
        'c': nrm(ks[1], (BATCH, d), 1.0),
        'positions': (jnp.arange(SEQ, dtype=jnp.int32)[None, :]
                      + jax.random.randint(ks[2], (BATCH, 1), 0, 1024, dtype=jnp.int32)),
        'w_ada': nrm(ks[3], (DEPTH, d, 6 * d), 0.5 * d ** -0.5),
        'b_ada': nrm(ks[4], (DEPTH, 6 * d), 0.02),
        'g_norm1': 1.0 + nrm(ks[5], (DEPTH, d), 0.02),
        'w_in': nrm(ks[6], (DEPTH, d, IN_WIDTH), d ** -0.5),
        'g_head': 1.0 + nrm(ks[7], (DEPTH, HG_HEADS, HG_VAL_DIM), 0.02),
        'hg_lower_bounds': 1.0 + nrm(ks[8], (DEPTH + 1, hgw), 0.1),
        'w_attn_up': nrm(ks[9], (DEPTH, ATT_HEADS * HEAD_DIM, d), (ATT_HEADS * HEAD_DIM) ** -0.5),
        'w_hgrn_up': nrm(ks[10], (DEPTH, HG_HEADS * HG_VAL_DIM, d), (HG_HEADS * HG_VAL_DIM) ** -0.5),
        'w_out': nrm(ks[11], (DEPTH, d, d), d ** -0.5),
        'g_norm2': 1.0 + nrm(ks[12], (DEPTH, d), 0.02),
        'w_router_group': nrm(ks[13], (DEPTH, d, N_GROUPS), d ** -0.5),
        'b_router_group': nrm(ks[14], (DEPTH, N_GROUPS), 0.01),
        'w_router_expert': nrm(ks[15], (DEPTH, d, N_EXPERTS), d ** -0.5),
        'b_router_expert': nrm(ks[16], (DEPTH, N_EXPERTS), 0.01),
        'w_exp_gate': nrm(ks[17], (DEPTH, N_EXPERTS, d, EXPERT_FF), d ** -0.5),
        'w_exp_up': nrm(ks[18], (DEPTH, N_EXPERTS, d, EXPERT_FF), d ** -0.5),
        'w_exp_down': nrm(ks[19], (DEPTH, N_EXPERTS, EXPERT_FF, d), EXPERT_FF ** -0.5),
        'g_final': 1.0 + nrm(ks[20], (d,), 0.02),
    }


def reference(x, c, positions, w_ada, b_ada, g_norm1, w_in, g_head, hg_lower_bounds, w_attn_up, w_hgrn_up,
              w_out, g_norm2, w_router_group, b_router_group, w_router_expert, b_router_expert,
              w_exp_gate, w_exp_up, w_exp_down, g_final):
    b, s, _ = x.shape
    cos_a, sin_a = rope_tables(positions, HEAD_DIM)
    cos_i, sin_i = rope_tables(positions, IDX_DIM)
    lb_all = jnp.cumsum(jax.nn.softmax(hg_lower_bounds.astype(jnp.float32), axis=0), axis=0)
    c_act = jax.nn.silu(c)
    for l in range(DEPTH):
        mod = c_act @ w_ada[l] + b_ada[l]
        sh1, sc1, gt1, sh2, sc2, gt2 = jnp.split(mod, 6, axis=-1)
        h = ada_norm(x, g_norm1[l], sh1, sc1)
        aq, ak, av, iq, ik, iw, hq, hf, hi, hog, ga, gh = split_cols(h @ w_in[l])
        aq = apply_rope(aq.reshape(b, s, ATT_HEADS, HEAD_DIM), cos_a, sin_a)
        aq = aq.reshape(b, s, ATT_KV_HEADS, ATT_HEADS // ATT_KV_HEADS, HEAD_DIM)
        ak = apply_rope(ak.reshape(b, s, ATT_KV_HEADS, HEAD_DIM), cos_a, sin_a)
        av = av.reshape(b, s, ATT_KV_HEADS, HEAD_DIM)
        iq = apply_rope(iq.reshape(b, s, IDX_HEADS, IDX_DIM), cos_i, sin_i)
        ik = apply_rope(ik[:, :, None], cos_i, sin_i)[:, :, 0]
        y_att = dsa_attention(aq, ak, av, iq, ik, iw)
        o_h = hgrn2_recurrence(hq.reshape(b, s, HG_HEADS, HG_KEY_DIM),
                               hf.reshape(b, s, HG_HEADS, HG_KEY_DIM),
                               hi.reshape(b, s, HG_HEADS, HG_VAL_DIM),
                               lb_all[l].reshape(HG_HEADS, HG_KEY_DIM))
        y_hg = rmsnorm(o_h, g_head[l]).astype(x.dtype).reshape(b, s, -1) * jax.nn.silu(hog)
        merged = (jax.nn.sigmoid(ga) * (y_att @ w_attn_up[l])
                  + jax.nn.sigmoid(gh) * (y_hg @ w_hgrn_up[l]))
        x = x + gt1[:, None] * (merged @ w_out[l])
        h2 = ada_norm(x, g_norm2[l], sh2, sc2)
        x = x + gt2[:, None] * hier_moe(h2, w_router_group[l], b_router_group[l], w_router_expert[l],
                                        b_router_expert[l], w_exp_gate[l], w_exp_up[l], w_exp_down[l])
    return rmsnorm(x, g_final)
```

```cpp
#include <hip/hip_runtime.h>
#include <cstdio>
#include <cstdint>

#define REPMASK 0x0
#ifndef MK_MULTI
#define MK_MULTI 0
#endif

#define GAS __attribute__((address_space(1)))
#define LAS __attribute__((address_space(3)))
typedef unsigned short bf16_t;
typedef short bf16x8 __attribute__((ext_vector_type(8)));
typedef short s16x4 __attribute__((ext_vector_type(4)));
typedef short v4i16_t __attribute__((ext_vector_type(4)));
typedef float f32x4 __attribute__((ext_vector_type(4)));
typedef float f32x2 __attribute__((ext_vector_type(2)));
typedef float f32x16 __attribute__((ext_vector_type(16)));
typedef unsigned u32x4 __attribute__((ext_vector_type(4)));
typedef unsigned u32x2 __attribute__((ext_vector_type(2)));

constexpr int DM = 2048, NBATCH = 2, SEQ = 4096, M = NBATCH * SEQ;
constexpr int NLOG = 10312, NPHYS = 10240;
constexpr int NEXP = 32, EFF = 512;
constexpr float EPS = 1e-6f;
constexpr float ATT_SCALE_L2E = 0.08838834764831845f * 1.4426950408889634f;
constexpr float IDX_SCALE = 0.04419417382415922f;
constexpr int TOPK = 256;

constexpr size_t MiB = 1u << 20;
constexpr size_t WS_CTL = 0, CTL_ZERO_BYTES = 1 * MiB;
constexpr size_t WS_WIN_T = 1 * MiB, WS_WAU_T = 42 * MiB, WS_WHU_T = 46 * MiB, WS_WOUT_T = 50 * MiB;
constexpr size_t WS_XN = 58 * MiB, WS_MODP = 90 * MiB, WS_MOD = 92 * MiB, WS_TABA = 93 * MiB, WS_TABI = 97 * MiB, WS_MASK = 99 * MiB;
constexpr size_t WS_W40T = 104 * MiB;
constexpr size_t WS_DECAY = 103 * MiB, WS_LIST = 105 * MiB, WS_LISTW = 106 * MiB, WS_SPREVT = 107 * MiB, WS_YATT = 139 * MiB, WS_YHG = 155 * MiB, WS_UPDT = 171 * MiB;
constexpr size_t WS_AQ = 235 * MiB, WS_AK = 251 * MiB, WS_AVT = 255 * MiB, WS_IQ = 259 * MiB, WS_IK = 267 * MiB, WS_IW = 268 * MiB, WS_HQ = 269 * MiB, WS_LOGF = 285 * MiB,
                 WS_KF = 317 * MiB, WS_HI = 333 * MiB, WS_HOG = 349 * MiB, WS_GA = 365 * MiB, WS_GH = 397 * MiB;
constexpr size_t WS_WGU_T = 235 * MiB, WS_WD_T = 363 * MiB;
constexpr size_t WS_SCORES = 429 * MiB;
constexpr size_t WS_MERGED = 429 * MiB, WS_YS = 461 * MiB, WS_ACT = 557 * MiB;
constexpr size_t WS_END = 581 * MiB;
constexpr int CW_BAR = 4096, CW_CNT = 16384, CW_DONE = 32768;

constexpr int RING_BYTES = 139264, LDSCTL_OFF = RING_BYTES, MISC_OFF = LDSCTL_OFF + 320, LDS_EXTRA = 147456, LDS_BYTES = 163840;
constexpr int NWAVES = 8, NTHREADS = 512;

#define RLX_AGENT __ATOMIC_RELAXED, __HIP_MEMORY_SCOPE_AGENT
#define LDS_WAIT() asm volatile("s_waitcnt lgkmcnt(0)" ::: "memory")
#define VM_WAIT() asm volatile("s_waitcnt vmcnt(0)" ::: "memory")
__device__ __forceinline__ float bf2f(unsigned b) { return __uint_as_float(b << 16); }
__device__ __forceinline__ unsigned pk2(float lo, float hi) { unsigned r; asm("v_cvt_pk_bf16_f32 %0, %1, %2" : "=v"(r) : "v"(lo), "v"(hi)); return r; }
__device__ __forceinline__ float fexp(float x) { return __builtin_amdgcn_exp2f(x * 1.4426950408889634f); }
__device__ __forceinline__ float frcp(float x) { return __builtin_amdgcn_rcpf(x); }
__device__ __forceinline__ float sigmoidf_(float x) { return frcp(1.0f + fexp(-x)); }
__device__ __forceinline__ float siluf_(float x) { return x * sigmoidf_(x); }
__device__ __forceinline__ float wave_sum(float v) {
#pragma unroll
    for (int o = 1; o < 64; o <<= 1) v += __shfl_xor(v, o);
    return v;
}
__device__ __forceinline__ int wave_sum_i_dpp(int v) {
    v += __builtin_amdgcn_update_dpp(0, v, 0xB1, 0xF, 0xF, false);
    v += __builtin_amdgcn_update_dpp(0, v, 0x4E, 0xF, 0xF, false);
    v += __builtin_amdgcn_update_dpp(0, v, 0x124, 0xF, 0xF, false);
    v += __builtin_amdgcn_update_dpp(0, v, 0x128, 0xF, 0xF, false);
    return __builtin_amdgcn_readlane(v, 0) + __builtin_amdgcn_readlane(v, 16) + __builtin_amdgcn_readlane(v, 32) + __builtin_amdgcn_readlane(v, 48);
}
__device__ __forceinline__ int wave_sum_i(int v) {
#pragma unroll
    for (int o = 1; o < 64; o <<= 1) v += __shfl_xor(v, o);
    return v;
}

#define XB_TMO      128
#define XB_XCNT(j)  (256  + 64 * (j))
#define XB_XSUB(j)  (1280 + 64 * (j))
#define XB_XGEN(j)  (2304 + 64 * (j))
#define XB_TOP      3328
#define XB_TOPGEN   3392
#define XCD_BAR_WORDS 3456
#define XB_SPIN_CAP (1u << 18)
__device__ __forceinline__ unsigned xb_ld(unsigned* p)              { return __hip_atomic_load(p, __ATOMIC_RELAXED, __HIP_MEMORY_SCOPE_AGENT); }
__device__ __forceinline__ unsigned xb_add(unsigned* p, unsigned v) { return __hip_atomic_fetch_add(p, v, __ATOMIC_RELAXED, __HIP_MEMORY_SCOPE_AGENT); }
__device__ __forceinline__ unsigned xb_xcc_id() { return (unsigned)__builtin_amdgcn_s_getreg((3 << 11) | 20) & 0xFu; }
#define XB_SPIN(cond, bar) do { unsigned _sp = 0; while (cond) { __builtin_amdgcn_s_sleep(1); \
    if ((++_sp & 255u) == 0u) { if (xb_ld(&(bar)[XB_TMO])) break; if (_sp > XB_SPIN_CAP) { atomicAdd(&(bar)[XB_TMO], 1u); break; } } } } while (0)
struct XcdBarrier { unsigned* bar; unsigned x; volatile LAS unsigned* st; };
__device__ __forceinline__ XcdBarrier xcd_barrier_post(unsigned* bar, volatile LAS unsigned* st) {
    XcdBarrier b; b.bar = bar; b.x = xb_xcc_id(); b.st = st;
    if (threadIdx.x == 0) (void)xb_add(&bar[XB_XCNT(b.x)], 1u);
    return b;
}
__device__ __forceinline__ void xcd_barrier_complete(unsigned* bar, unsigned x, unsigned& nloc, unsigned& nx) {
    const unsigned G = gridDim.x * gridDim.y * gridDim.z;
    unsigned sum, cnt, mine, sp = 0u;
    for (;;) {
        sum = 0u; cnt = 0u; mine = 0u;
#pragma unroll
        for (unsigned j = 0; j < 16; ++j) { const unsigned c = xb_ld(&bar[XB_XCNT(j)]); sum += c; cnt += (c > 0u) ? 1u : 0u; mine = (j == x) ? c : mine; }
        if (sum == G) break;
        __builtin_amdgcn_s_sleep(1);
        if ((++sp & 255u) == 0u) { if (xb_ld(&bar[XB_TMO])) break; if (sp > XB_SPIN_CAP) { atomicAdd(&bar[XB_TMO], 1u); break; } }
    }
    nloc = mine > 0u ? mine : 1u; nx = cnt > 0u ? cnt : 1u;
}
__device__ __forceinline__ void xcd_barrier(const XcdBarrier& b) {
    asm volatile("s_waitcnt vmcnt(0)" ::: "memory");
    __syncthreads();
    if (threadIdx.x == 0) {
        unsigned* bar = b.bar;
        __builtin_amdgcn_s_waitcnt(0);
        unsigned nloc = b.st[0], nx = b.st[1];
        if (nloc == 0u) { xcd_barrier_complete(bar, b.x, nloc, nx); b.st[0] = nloc; b.st[1] = nx; }
        const unsigned old = xb_add(&bar[XB_XSUB(b.x)], 1u);
        const unsigned gen = old / nloc;
        if (old + 1u == (gen + 1u) * nloc) {
            __builtin_amdgcn_fence(__ATOMIC_RELEASE, "agent");
            asm volatile("s_waitcnt vmcnt(0)" ::: "memory");
            const unsigned og = xb_add(&bar[XB_TOP], 1u);
            const unsigned tg = og / nx;
            if (og + 1u == (tg + 1u) * nx) xb_add(&bar[XB_TOPGEN], 1u);
            else XB_SPIN(xb_ld(&bar[XB_TOPGEN]) == tg, bar);
            __builtin_amdgcn_fence(__ATOMIC_ACQUIRE, "agent");
            xb_add(&bar[XB_XGEN(b.x)], 1u);
            asm volatile("s_waitcnt vmcnt(0)" ::: "memory");
        } else {
            XB_SPIN(xb_ld(&bar[XB_XGEN(b.x)]) == gen, bar);
            __builtin_amdgcn_fence(__ATOMIC_ACQUIRE, "agent");
            asm volatile("s_waitcnt vmcnt(0)" ::: "memory");
        }
    }
    __syncthreads();
}

namespace pg8 {
constexpr int BM = 256, BK = 64, HALF = 128, HTB = HALF * BK * 2, NXCD = 8, WGM = 8;
__host__ __device__ __forceinline__ int lds_byte(int r, int c) { const int st = (r >> 4) * 2 + (c >> 5), rr = r & 15, cc = c & 31, ob = rr * 64 + cc * 2; return st * 1024 + (ob ^ (((ob >> 9) & 1) << 5)); }
__host__ __device__ __forceinline__ void stage_rc(int b, int& R, int& C) { const int st = b / 1024, sb = b % 1024, swz = sb ^ (((sb >> 9) & 1) << 5); R = (st >> 1) * 16 + swz / 64; C = (st & 1) * 32 + (swz % 64) / 2; }
__host__ __device__ __forceinline__ int perm32(int rho) { const int n = rho >> 4, i = rho & 15; return 8 * (i >> 2) + 4 * n + (i & 3); }

__device__ __forceinline__ bool static_tile(int L, int nM, int nN, int& pm, int& pn) {
    const int nwg = nM * nN; if (L >= nwg) return false;
    int wgid = L; { const int q = nwg / NXCD, r = nwg % NXCD, xcd = wgid % NXCD, off = wgid / NXCD; wgid = (xcd < r ? xcd * (q + 1) : r * (q + 1) + (xcd - r) * q) + off; }
    const int nig = WGM * nN, gid = wgid / nig, fm = gid * WGM, gsz = (nM - fm) < WGM ? (nM - fm) : WGM;
    pm = fm + ((wgid % nig) % gsz); pn = (wgid % nig) / gsz; return true;
}

template <class P>
__device__ __forceinline__ void gemm_phase(LAS unsigned char* lds, P& prob) {
    typedef typename P::U Unit;
    const int tid = threadIdx.x, wid = __builtin_amdgcn_readfirstlane(tid >> 6), lane = tid & 63, wr = wid >> 2, wc = wid & 3, fr = lane & 15, fq = lane >> 4;
    const int K = prob.K, nt = K / BK;
    unsigned voffB[2]; int stR[2], stC[2];
#pragma unroll
    for (int i = 0; i < 2; ++i) { int R, C; stage_rc(tid * 16 + i * 8192, R, C); stR[i] = R; stC[i] = C; const int Rb = P::PERM ? ((R & ~31) + perm32(R & 31)) : R; voffB[i] = (unsigned)(Rb * K + C) * 2u; }
    const size_t kstep = (size_t)(BK * 2);
    const size_t hstep = (size_t)HALF * K * 2;
    const unsigned ldsw = (unsigned)wid * 1024u;
    const int aoff = lds_byte(wr * 64 + fr, fq * 8), boff = lds_byte(wc * 32 + fr, fq * 8);
#define PG8_SA(b, h) (((b) * 2 + (h)) * HTB)
#define PG8_SB(b, h) ((4 + (b) * 2 + (h)) * HTB)
#define PG8_STAGE2(bufoff, gbase, o0, o1) do { \
        __builtin_amdgcn_global_load_lds((const unsigned*)((const char*)(gbase) + (o0)), (LAS unsigned*)(lds + (bufoff) + ldsw), 16, 0, 0); \
        __builtin_amdgcn_global_load_lds((const unsigned*)((const char*)(gbase) + (o1)), (LAS unsigned*)(lds + (bufoff) + ldsw + 8192), 16, 0, 0); } while (0)
#define PG8_STAGE_B(bufoff, gbase, h) PG8_STAGE2(bufoff, (gbase) + (h) * hstep, voffB[0], voffB[1])
#define PG8_LDA(dst, b, h) do { _Pragma("unroll") for (int m = 0; m < 4; ++m) _Pragma("unroll") for (int k = 0; k < 2; ++k) dst[m][k] = *(const LAS bf16x8*)(lds + PG8_SA(b, h) + aoff + m * 2048 + k * 1024); } while (0)
#define PG8_LDB(dst, b, h) do { _Pragma("unroll") for (int n = 0; n < 2; ++n) _Pragma("unroll") for (int k = 0; k < 2; ++k) dst[n][k] = *(const LAS bf16x8*)(lds + PG8_SB(b, h) + boff + n * 2048 + k * 1024); } while (0)
#define PG8_MMA(ai, bj, At, Bt) do { __builtin_amdgcn_s_setprio(1); _Pragma("unroll") for (int m = 0; m < 4; ++m) _Pragma("unroll") for (int n = 0; n < 2; ++n) _Pragma("unroll") for (int k = 0; k < 2; ++k) \
        acc[ai][bj][m][n] = __builtin_amdgcn_mfma_f32_16x16x32_bf16(Bt[n][k], At[m][k], acc[ai][bj][m][n], 0, 0, 0); __builtin_amdgcn_s_setprio(0); } while (0)
#define PG8_WAIT_V(n) asm volatile("s_waitcnt vmcnt(" #n ")" ::: "memory")
#define PG8_WAIT_L(n) asm volatile("s_waitcnt lgkmcnt(" #n ")" ::: "memory")
#define PG8_BAR __builtin_amdgcn_s_barrier()
#define PG8_SCHED __builtin_amdgcn_sched_barrier(0)
    Unit cur, nxt; int ui = 0;
    if (!prob.next(0, cur)) return;
    f32x4 acc[2][2][4][2];
#pragma unroll
    for (int a = 0; a < 2; ++a)
#pragma unroll
        for (int b = 0; b < 2; ++b)
#pragma unroll
            for (int m = 0; m < 4; ++m)
#pragma unroll
                for (int n = 0; n < 2; ++n) acc[a][b][m][n] = (f32x4){0.f, 0.f, 0.f, 0.f};
    bf16x8 At[4][2], B0[2][2], B1[2][2];
    const char* cA; const char* cB; unsigned vc[2][2], vn[2][2];
    prob.ready(cur, true);
    prob.bases(cur, cA, cB); prob.lane_offs(cur, stR, stC, vc);
    PG8_STAGE_B(PG8_SB(0, 0), cB, 0); PG8_STAGE_B(PG8_SB(0, 1), cB, 1); PG8_STAGE2(PG8_SA(0, 0), cA, vc[0][0], vc[0][1]); PG8_STAGE2(PG8_SA(0, 1), cA, vc[1][0], vc[1][1]);
    if (wr == 1) PG8_BAR;
    PG8_WAIT_V(2); PG8_BAR;
    PG8_STAGE_B(PG8_SB(1, 0), cB + kstep, 0); PG8_STAGE2(PG8_SA(1, 0), cA + kstep, vc[0][0], vc[0][1]); PG8_STAGE_B(PG8_SB(1, 1), cB + kstep, 1);
    PG8_WAIT_V(6); PG8_BAR;
    for (;;) {
        const bool has_next = prob.next(ui + 1, nxt);
        const char* nA = cA; const char* nB = cB;
#pragma unroll
        for (int h = 0; h < 2; ++h) { vn[h][0] = vc[h][0]; vn[h][1] = vc[h][1]; }
        if (has_next) { prob.bases(nxt, nA, nB); prob.lane_offs(nxt, stR, stC, vn); }
        for (int t = 0; t < nt; t += 2) {
            const bool last = (t == nt - 2);
            if (last && has_next) prob.ready(nxt, wid == 0);
            const char* a1 = cA + (size_t)(t + 1) * kstep;
            const char* a2 = last ? nA : cA + (size_t)(t + 2) * kstep; const char* b2 = last ? nB : cB + (size_t)(t + 2) * kstep;
            const char* a3 = a2 + kstep; const char* b3 = b2 + kstep;
            const unsigned v00 = last ? vn[0][0] : vc[0][0], v01 = last ? vn[0][1] : vc[0][1], v10 = last ? vn[1][0] : vc[1][0], v11 = last ? vn[1][1] : vc[1][1];
            PG8_LDB(B0, 0, 0); PG8_LDB(B1, 0, 1); PG8_SCHED; PG8_LDA(At, 0, 0); PG8_STAGE2(PG8_SA(1, 1), a1, vc[1][0], vc[1][1]);
            PG8_WAIT_V(8); PG8_WAIT_L(0); PG8_BAR; PG8_MMA(0, 0, At, B0); PG8_MMA(0, 1, At, B1); PG8_BAR; PG8_SCHED;
            PG8_LDA(At, 0, 1); PG8_STAGE_B(PG8_SB(0, 0), b2, 0); PG8_STAGE_B(PG8_SB(0, 1), b2, 1); PG8_STAGE2(PG8_SA(0, 0), a2, v00, v01);
            PG8_WAIT_V(8); PG8_WAIT_L(0); PG8_BAR; PG8_MMA(1, 0, At, B0); PG8_MMA(1, 1, At, B1); PG8_BAR; PG8_SCHED;
            PG8_LDB(B0, 1, 0); PG8_LDB(B1, 1, 1); PG8_SCHED; PG8_LDA(At, 1, 0); PG8_STAGE2(PG8_SA(0, 1), a2, v10, v11);
            PG8_WAIT_V(8); PG8_WAIT_L(0); PG8_BAR; PG8_MMA(0, 0, At, B0); PG8_MMA(0, 1, At, B1); PG8_BAR; PG8_SCHED;
            PG8_LDA(At, 1, 1); PG8_STAGE_B(PG8_SB(1, 0), b3, 0); PG8_STAGE_B(PG8_SB(1, 1), b3, 1); PG8_STAGE2(PG8_SA(1, 0), a3, v00, v01);
            PG8_WAIT_V(8); PG8_WAIT_L(0); PG8_BAR; PG8_MMA(1, 0, At, B0); PG8_MMA(1, 1, At, B1); PG8_BAR; PG8_SCHED;
        }
        if (wr == 0) PG8_BAR;
        prob.epi(acc, cur, wr, wc, fr, fq);
        if (!has_next) break;
        if (!prob.keep(cur)) {
#pragma unroll
            for (int a = 0; a < 2; ++a)
#pragma unroll
                for (int b = 0; b < 2; ++b)
#pragma unroll
                    for (int m = 0; m < 4; ++m)
#pragma unroll
                        for (int n = 0; n < 2; ++n) acc[a][b][m][n] = (f32x4){0.f, 0.f, 0.f, 0.f};
        }
        cur = nxt; cA = nA; cB = nB; ++ui;
#pragma unroll
        for (int h = 0; h < 2; ++h) { vc[h][0] = vn[h][0]; vc[h][1] = vn[h][1]; }
        if (wr == 1) PG8_BAR;
    }
    PG8_WAIT_V(0);
    PG8_BAR;
#undef PG8_SA
#undef PG8_SB
#undef PG8_STAGE2
#undef PG8_STAGE_B
#undef PG8_LDA
#undef PG8_LDB
#undef PG8_MMA
#undef PG8_WAIT_V
#undef PG8_WAIT_L
#undef PG8_BAR
#undef PG8_SCHED
}
}

struct Frame {
    LAS unsigned char* lds;
    unsigned* ctl;
    unsigned char* ws;
    int tid, lane, wave, G, bid;
    const float *x, *c, *w_ada, *b_ada, *g_norm1, *w_in, *g_head, *hglb, *w_attn_up, *w_hgrn_up, *w_out, *g_norm2, *w_rg, *b_rg, *w_re, *b_re, *w_eg, *w_eu, *w_ed, *g_final;
    const int* positions;
    float* out;
};
#define WSP(T, off) ((T*)(F.ws + (off)))

__device__ __forceinline__ int win_phys(int n) {
    if (n < 1280) { const int head = n >> 7, j = n & 127; return head * 128 + (j < 64 ? 2 * j : 2 * (j - 64) + 1); }
    if (n < 1536) return n;
    if (n < 2048) { const int q = n - 1536, head = q >> 6, j = q & 63; return 1536 + head * 64 + (j < 32 ? 2 * j : 2 * (j - 32) + 1); }
    if (n < 2120) return -1;
    return n - 2120 + 2048;
}
struct RmWin { __device__ __forceinline__ int operator()(int n) const { return win_phys(n); } };
struct RmId  { __device__ __forceinline__ int operator()(int n) const { return n; } };
struct RmGate { int up; __device__ __forceinline__ int operator()(int f) const { return 8 * (f >> 2) + 4 * up + (f & 3); } };
template <class RM>
__device__ __forceinline__ void transpose_item(const float* W, int K, int N, bf16_t* WT, LAS float* scr, int item, int lane, RM rm) {
    const int nblk = (N + 31) / 32, kb = item / nblk, nb = item % nblk, k0 = 64 * kb, n0 = 32 * nb;
    const int nn = n0 + (lane & 31);
    float tv[32];
#pragma unroll
    for (int i = 0; i < 32; ++i) { const int kk = 2 * i + (lane >> 5); tv[i] = (nn < N) ? W[(size_t)(k0 + kk) * N + nn] : 0.f; }
#pragma unroll
    for (int i = 0; i < 32; ++i) { const int kk = 2 * i + (lane >> 5); scr[kk * 33 + (lane & 31)] = tv[i]; }
    LDS_WAIT(); asm volatile("" ::: "memory");
    const int c = lane & 7;
#pragma unroll
    for (int j = 0; j < 4; ++j) { const int n = (lane >> 3) + 8 * j; const LAS float* s = scr + (8 * c) * 33 + n;
        u32x4 o; o.x = pk2(s[0 * 33], s[1 * 33]); o.y = pk2(s[2 * 33], s[3 * 33]); o.z = pk2(s[4 * 33], s[5 * 33]); o.w = pk2(s[6 * 33], s[7 * 33]);
        if (n0 + n < N) { const int rr = rm(n0 + n); if (rr >= 0) *(u32x4*)(WT + (size_t)rr * K + k0 + 8 * c) = o; } }
    LDS_WAIT(); asm volatile("" ::: "memory");
}

struct TDesc { const float* W; bf16_t* WT; int K, N, kind, item; };
__device__ __forceinline__ int td_row(int kind, int n) { return kind == 0 ? n : kind == 1 ? win_phys(n) : (8 * (n >> 2) + 4 * (kind - 2) + (n & 3)); }
__device__ __forceinline__ void td_load(const TDesc& d, int lane, float (&tv)[32]) {
    const int nblk = (d.N + 31) / 32, kb = d.item / nblk, nb = d.item % nblk, k0 = 64 * kb, n0 = 32 * nb;
    int nn = n0 + (lane & 31); nn = nn < d.N ? nn : d.N - 1;
    const float* p = d.W + (size_t)(k0 + (lane >> 5)) * d.N + nn;
#pragma unroll
    for (int i = 0; i < 32; ++i) tv[i] = p[(size_t)(2 * i) * d.N];
}
__device__ __forceinline__ void td_lds(const float (&tv)[32], int lane, LAS float* scr) {
#pragma unroll
    for (int i = 0; i < 32; ++i) { const int kk = 2 * i + (lane >> 5); scr[kk * 33 + (lane & 31)] = tv[i]; }
}
__device__ __forceinline__ void td_store(const TDesc& d, int lane, LAS float* scr) {
    const int nblk = (d.N + 31) / 32, kb = d.item / nblk, nb = d.item % nblk, k0 = 64 * kb, n0 = 32 * nb;
    const int c = lane & 7;
#pragma unroll
    for (int j = 0; j < 4; ++j) { const int n = (lane >> 3) + 8 * j; const LAS float* sp = scr + (8 * c) * 33 + n;
        u32x4 o; o.x = pk2(sp[0 * 33], sp[1 * 33]); o.y = pk2(sp[2 * 33], sp[3 * 33]); o.z = pk2(sp[4 * 33], sp[5 * 33]); o.w = pk2(sp[6 * 33], sp[7 * 33]);
        if (n0 + n < d.N) { const int rr = td_row(d.kind, n0 + n); if (rr >= 0) *(u32x4*)(d.WT + (size_t)rr * d.K + k0 + 8 * c) = o; } }
}
#define TD_STREAM(it0_, stride_, total_, DESC, lane_, scr_) do { float tv_[32]; TDesc dc_, dn_; int it_ = (it0_); \
    if (it_ < (total_)) { DESC(it_, dc_); td_load(dc_, (lane_), tv_); } \
    for (; it_ < (total_); it_ += (stride_)) { td_lds(tv_, (lane_), (scr_)); __builtin_amdgcn_sched_barrier(0); \
        const bool hn_ = it_ + (stride_) < (total_); if (hn_) { DESC(it_ + (stride_), dn_); td_load(dn_, (lane_), tv_); } \
        LDS_WAIT(); asm volatile("" ::: "memory"); td_store(dc_, (lane_), (scr_)); LDS_WAIT(); asm volatile("" ::: "memory"); if (hn_) dc_ = dn_; } } while (0)

__device__ __forceinline__ void p0_prologue(Frame& F) {
    const int gw = F.bid * NWAVES + F.wave, NGW = F.G * NWAVES;
    {
        LAS float* red = (LAS float*)F.lds;
        float* MODP = WSP(float, WS_MODP);
        for (int task = F.bid; task < 48 * 16; task += F.G) {
            const int cg = task % 48, ks = task / 48;
            f32x4 a0 = {0.f, 0.f, 0.f, 0.f}, a1 = {0.f, 0.f, 0.f, 0.f};
            const int kb = ks * 128 + F.wave * 16;
#pragma unroll 16
            for (int i = 0; i < 16; ++i) { const int k = kb + i; const f32x4 wv = *(const f32x4*)(F.w_ada + (size_t)k * 12288 + cg * 256 + 4 * F.lane);
                const float s0 = siluf_(F.c[k]), s1 = siluf_(F.c[DM + k]); a0 += wv * s0; a1 += wv * s1; }
            *(LAS f32x4*)(red + (F.wave * 2 + 0) * 256 + 4 * F.lane) = a0; *(LAS f32x4*)(red + (F.wave * 2 + 1) * 256 + 4 * F.lane) = a1;
            __syncthreads();
            { const int b = F.tid >> 8, col = F.tid & 255; float s = 0.f;
#pragma unroll
              for (int w = 0; w < 8; ++w) s += red[(w * 2 + b) * 256 + col];
              MODP[((size_t)ks * 2 + b) * 12288 + cg * 256 + col] = s; }
            __syncthreads();
        }
    }
    {
        LAS float* scr = (LAS float*)(F.lds + F.wave * 16384);
        constexpr int I_IN = 32 * 323, I_AU = 16 * 64, I_HU = 16 * 64, I_OUT = 32 * 64;
        constexpr int NITEMS = I_IN + I_AU + I_HU + I_OUT;
#define P0_DESC(it, d) do { int r_ = (it); \
            if (r_ < I_IN) { d.W = F.w_in; d.K = DM; d.N = NLOG; d.WT = WSP(bf16_t, WS_WIN_T); d.kind = 1; d.item = r_; } \
            else if ((r_ -= I_IN) < I_AU) { d.W = F.w_attn_up; d.K = 1024; d.N = DM; d.WT = WSP(bf16_t, WS_WAU_T); d.kind = 0; d.item = r_; } \
            else if ((r_ -= I_AU) < I_HU) { d.W = F.w_hgrn_up; d.K = 1024; d.N = DM; d.WT = WSP(bf16_t, WS_WHU_T); d.kind = 0; d.item = r_; } \
            else { r_ -= I_HU; d.W = F.w_out; d.K = DM; d.N = DM; d.WT = WSP(bf16_t, WS_WOUT_T); d.kind = 0; d.item = r_; } } while (0)
        TD_STREAM(gw, NGW, NITEMS, P0_DESC, F.lane, scr);
#undef P0_DESC
        { bf16_t* W40 = WSP(bf16_t, WS_W40T); const int gt = F.bid * NTHREADS + F.tid, NGT = F.G * NTHREADS;
          for (int e = gt; e < 96 * 256; e += NGT) { const int n = e >> 8, k0 = (e & 255) * 8; u32x4 o = {0u, 0u, 0u, 0u};
              if (n < 72) { const int col = (n < 64) ? (2048 + (n >> 1) + 32 * (n & 1)) : (2112 + (n - 64)); const float* p = F.w_in + (size_t)k0 * NLOG + col;
                  o.x = pk2(p[0], p[NLOG]); o.y = pk2(p[2 * (size_t)NLOG], p[3 * (size_t)NLOG]); o.z = pk2(p[4 * (size_t)NLOG], p[5 * (size_t)NLOG]); o.w = pk2(p[6 * (size_t)NLOG], p[7 * (size_t)NLOG]); }
              *(u32x4*)(W40 + (size_t)n * DM + k0) = o; } }
    }
    {
        f32x2* TA = WSP(f32x2, WS_TABA); f32x2* TI = WSP(f32x2, WS_TABI);
        const int gt = F.bid * NTHREADS + F.tid, NGT = F.G * NTHREADS;
        for (int e = gt; e < M * 96; e += NGT) {
            const int m = e / 96, r = e % 96; const float pos = (float)F.positions[m];
            float inv; if (r < 64) inv = powf(10000.0f, -(float)(2 * r) / 128.0f); else inv = powf(10000.0f, -(float)(2 * (r - 64)) / 64.0f);
            const float ang = pos * inv; float sn, cs; sincosf(ang, &sn, &cs);
            if (r < 64) TA[(size_t)m * 64 + r] = (f32x2){cs, sn}; else TI[(size_t)m * 32 + (r - 64)] = (f32x2){cs, sn};
        }
    }
}

__device__ __forceinline__ float row_rstd(const float* xrow, int lane, f32x4 (&v)[8]) {
    float s = 0.f;
#pragma unroll
    for (int j = 0; j < 8; ++j) { v[j] = ((const f32x4*)xrow)[lane + 64 * j]; s += (v[j].x * v[j].x + v[j].y * v[j].y) + (v[j].z * v[j].z + v[j].w * v[j].w); }
    return 1.0f / sqrtf(wave_sum(s) * (1.0f / DM) + EPS);
}

__device__ __forceinline__ f32x16 mfma32(bf16x8 a, bf16x8 b, f32x16 c) { return __builtin_amdgcn_mfma_f32_32x32x16_bf16(a, b, c, 0, 0, 0); }
__device__ __forceinline__ int crow(int r, int hi) { return (r & 3) + 8 * (r >> 2) + 4 * hi; }
__device__ __forceinline__ void p1_norm1(Frame& F) {
    LAS float* CA = (LAS float*)(F.lds + LDS_EXTRA); LAS float* CB = CA + DM;
    LAS unsigned char* HB = F.lds;
    const float* MODP = WSP(float, WS_MODP); float* MOD = WSP(float, WS_MOD);
    const int lane = F.lane, r32 = lane & 31, hi = lane >> 5;
    for (int idx = F.bid * NTHREADS + F.tid; idx < 2 * 12288; idx += F.G * NTHREADS) { const int b = idx / 12288, j = idx % 12288; float s = F.b_ada[j]; float pv[16];
#pragma unroll
        for (int ks = 0; ks < 16; ++ks) pv[ks] = MODP[((size_t)ks * 2 + b) * 12288 + j];
        __builtin_amdgcn_sched_barrier(0);
#pragma unroll
        for (int ks = 0; ks < 16; ++ks) s += pv[ks];
        MOD[idx] = s; }
    for (int rb = F.bid; rb < M / 32; rb += F.G) {
        const int b = (rb * 32) / SEQ;
        __syncthreads();
#pragma unroll
        for (int kk = 0; kk < DM / NTHREADS; ++kk) { __builtin_amdgcn_sched_barrier(0); const int k = F.tid + kk * NTHREADS; float sh = F.b_ada[k], sc = F.b_ada[DM + k]; const float gn = F.g_norm1[k]; float p0[16], p1[16];
#pragma unroll
            for (int ks = 0; ks < 16; ++ks) { p0[ks] = MODP[((size_t)ks * 2 + b) * 12288 + k]; p1[ks] = MODP[((size_t)ks * 2 + b) * 12288 + DM + k]; }
            __builtin_amdgcn_sched_barrier(0);
#pragma unroll
            for (int ks = 0; ks < 16; ++ks) { sh += p0[ks]; sc += p1[ks]; }
            CA[k] = gn * (1.0f + sc); CB[k] = sh; }
        __syncthreads();
        bf16_t* XN = WSP(bf16_t, WS_XN);
#pragma unroll 1
        for (int r = 0; r < 4; ++r) { const int rl = F.wave * 4 + r, m = rb * 32 + rl; f32x4 v[8]; const float rs = row_rstd(F.x + (size_t)m * DM, lane, v);
#pragma unroll
            for (int j = 0; j < 8; ++j) { const int k = 4 * (lane + 64 * j); const f32x4 a = *(const LAS f32x4*)(CA + k), bb = *(const LAS f32x4*)(CB + k);
                const f32x4 h = v[j] * rs * a + bb; u32x2 o; o.x = pk2(h.x, h.y); o.y = pk2(h.z, h.w); *(u32x2*)(XN + (size_t)m * DM + k) = o; *(LAS u32x2*)(HB + rl * 4112 + k * 2) = o; } }
        __syncthreads();
        f32x16 acc[3]; acc[0] = f32x16{}; acc[1] = f32x16{}; acc[2] = f32x16{};
        { const bf16_t* W40 = WSP(bf16_t, WS_W40T) + (size_t)r32 * DM + 256 * F.wave + 8 * hi;
#pragma unroll
          for (int kb = 0; kb < 8; ++kb) { bf16x8 bq[2][3];
#pragma unroll
              for (int ks = 0; ks < 2; ++ks)
#pragma unroll
                  for (int nt = 0; nt < 3; ++nt) bq[ks][nt] = *(const bf16x8*)(W40 + (size_t)nt * 32 * DM + 16 * (2 * kb + ks));
              __builtin_amdgcn_sched_barrier(0);
#pragma unroll
              for (int ks = 0; ks < 2; ++ks) { const bf16x8 a = *(const LAS bf16x8*)(HB + r32 * 4112 + (256 * F.wave + 16 * (2 * kb + ks) + 8 * hi) * 2);
#pragma unroll
                  for (int nt = 0; nt < 3; ++nt) acc[nt] = mfma32(a, bq[ks][nt], acc[nt]); }
              __builtin_amdgcn_sched_barrier(0); } }
        __syncthreads();
        LAS float* PS = (LAS float*)HB;
#pragma unroll
        for (int nt = 0; nt < 3; ++nt)
#pragma unroll
            for (int r = 0; r < 16; ++r) PS[(F.wave * 96 + nt * 32 + r32) * 33 + crow(r, hi)] = acc[nt][r];
        __syncthreads();
        { bf16_t* IK = WSP(bf16_t, WS_IK); float* IW = WSP(float, WS_IW); const f32x2* TI = WSP(f32x2, WS_TABI);
          int tv = F.tid; asm volatile("" : "+v"(tv));
#pragma unroll
          for (int j = 0; j < 2; ++j) { const int idx = tv + 512 * j, row = idx >> 5, i = idx & 31; float x1 = 0.f, x2 = 0.f;
#pragma unroll
              for (int w = 0; w < 8; ++w) { x1 += PS[(w * 96 + 2 * i) * 33 + row]; x2 += PS[(w * 96 + 2 * i + 1) * 33 + row]; }
              const int m = rb * 32 + row; const f32x2 cs = TI[(size_t)m * 32 + i];
              *(unsigned*)(IK + (size_t)m * 64 + 2 * i) = pk2(x1 * cs.x - x2 * cs.y, x2 * cs.x + x1 * cs.y); }
          if (F.tid < 256) { const int row = F.tid >> 3, hh = F.tid & 7; float v = 0.f;
#pragma unroll
              for (int w = 0; w < 8; ++w) v += PS[(w * 96 + 64 + hh) * 33 + row];
              IW[(size_t)(rb * 32 + row) * 8 + hh] = v * IDX_SCALE; } }
    }
}

struct UnitT { int pm, pn, aux; };
struct ProbBase {
    typedef UnitT U;
    int K, G, c;
    __device__ __forceinline__ void lane_offs_plain(const int (&stR)[2], const int (&stC)[2], unsigned (&va)[2][2]) const {
#pragma unroll
        for (int h = 0; h < 2; ++h)
#pragma unroll
            for (int i = 0; i < 2; ++i) va[h][i] = (unsigned)((h * 128 + stR[i]) * K + stC[i]) * 2u;
    }
    __device__ __forceinline__ bool keep(const U&) const { return false; }
    __device__ __forceinline__ void ready(const U&, bool) const {}
};

struct ProbWin : ProbBase {
    static constexpr bool PERM = true;
    const char* A; const char* B; unsigned char* ws; const float* hglb;
    __device__ __forceinline__ bool next(int i, U& u) const { u.aux = 0; return pg8::static_tile(i * G + c, M / 256, NPHYS / 256, u.pm, u.pn); }
    __device__ __forceinline__ void bases(const U& u, const char*& a, const char*& b) const { a = A + (size_t)u.pm * 256 * K * 2; b = B + (size_t)u.pn * 256 * K * 2; }
    __device__ __forceinline__ void lane_offs(const U&, const int (&stR)[2], const int (&stC)[2], unsigned (&va)[2][2]) const { lane_offs_plain(stR, stC, va); }
    __device__ __forceinline__ void epi(f32x4 (&acc)[2][2][4][2], const U& u, int wr, int wc, int fr, int fq) const {
        const int pn = u.pn, row0 = u.pm * 256 + wr * 64 + fr, colw = wc * 32 + 8 * fq;
        if (pn <= 4 || pn == 6 || pn == 7 || pn == 40) {
            const bool d128 = (pn <= 4);
            const float* tab = d128 ? (const float*)(ws + WS_TABA) : (const float*)(ws + WS_TABI);
            const int tp = d128 ? 128 : 64;
            const int i0 = d128 ? (colw >> 1) : (((wc & 1) * 32 + 8 * fq) >> 1);
            bf16_t* O; int pitch, cb; float sc = 1.f;
            if (pn < 4) { O = (bf16_t*)(ws + WS_AQ); pitch = 1024; cb = pn * 256; sc = ATT_SCALE_L2E; }
            else if (pn == 4) { O = (bf16_t*)(ws + WS_AK); pitch = 256; cb = 0; }
            else if (pn < 8) { O = (bf16_t*)(ws + WS_IQ); pitch = 512; cb = (pn - 6) * 256; }
            else { O = (bf16_t*)(ws + WS_IK); pitch = 64; cb = 0; }
            f32x4 tt0[8], tt1[8];
#pragma unroll
            for (int ai = 0; ai < 2; ++ai)
#pragma unroll
                for (int m = 0; m < 4; ++m) { const int row = row0 + ai * 128 + m * 16; tt0[ai * 4 + m] = *(const f32x4*)(tab + (size_t)row * tp + 2 * i0); tt1[ai * 4 + m] = *(const f32x4*)(tab + (size_t)row * tp + 2 * i0 + 4); }
            __builtin_amdgcn_sched_barrier(0);
#pragma unroll
            for (int ai = 0; ai < 2; ++ai)
#pragma unroll
                for (int m = 0; m < 4; ++m) { const int row = row0 + ai * 128 + m * 16;
                    const f32x4 t0 = tt0[ai * 4 + m], t1 = tt1[ai * 4 + m];
#pragma unroll
                    for (int bj = 0; bj < 2; ++bj) {
                        if (pn == 40 && (bj == 1 || wc >= 2)) {
                            if (bj == 0 && wc == 2 && fq == 0) { float* IW = (float*)(ws + WS_IW);
                                *(f32x4*)(IW + (size_t)row * 8) = acc[ai][0][m][0] * IDX_SCALE; *(f32x4*)(IW + (size_t)row * 8 + 4) = acc[ai][0][m][1] * IDX_SCALE; }
                            continue; }
                        const f32x4 v0 = acc[ai][bj][m][0], v1 = acc[ai][bj][m][1];
                        const float o0 = v0[0] * t0[0] - v0[1] * t0[1], o1 = v0[1] * t0[0] + v0[0] * t0[1], o2 = v0[2] * t0[2] - v0[3] * t0[3], o3 = v0[3] * t0[2] + v0[2] * t0[3];
                        const float o4 = v1[0] * t1[0] - v1[1] * t1[1], o5 = v1[1] * t1[0] + v1[0] * t1[1], o6 = v1[2] * t1[2] - v1[3] * t1[3], o7 = v1[3] * t1[2] + v1[2] * t1[3];
                        u32x4 w; w.x = pk2(o0 * sc, o1 * sc); w.y = pk2(o2 * sc, o3 * sc); w.z = pk2(o4 * sc, o5 * sc); w.w = pk2(o6 * sc, o7 * sc);
                        *(u32x4*)(O + (size_t)row * pitch + cb + bj * 128 + colw) = w; } }
        } else if (pn == 5) {
            bf16_t* O = (bf16_t*)(ws + WS_AVT);
#pragma unroll
            for (int ai = 0; ai < 2; ++ai)
#pragma unroll
                for (int m = 0; m < 4; ++m) { const int row = row0 + ai * 128 + m * 16, b = row >> 12, s = row & 4095;
#pragma unroll
                    for (int bj = 0; bj < 2; ++bj)
#pragma unroll
                        for (int n = 0; n < 2; ++n)
#pragma unroll
                            for (int e = 0; e < 4; ++e) { const int d = colw + 4 * n + e; O[((size_t)((b * 2 + bj) * 128 + d)) * SEQ + s] = (bf16_t)(pk2(acc[ai][bj][m][n][e], 0.f) & 0xffffu); } }
        } else if (pn >= 12 && pn < 16) {
            float* LF = (float*)(ws + WS_LOGF); bf16_t* KFo = (bf16_t*)(ws + WS_KF);
            const int cb = (pn - 12) * 256;
            f32x4 lb[2][2];
#pragma unroll
            for (int bj = 0; bj < 2; ++bj)
#pragma unroll
                for (int n = 0; n < 2; ++n) { const int cc = cb + bj * 128 + colw + 4 * n; const f32x4 a0 = *(const f32x4*)(hglb + cc), a1 = *(const f32x4*)(hglb + 1024 + cc);
#pragma unroll
                    for (int e = 0; e < 4; ++e) lb[bj][n][e] = frcp(1.0f + fexp(a1[e] - a0[e])); }
#pragma unroll
            for (int ai = 0; ai < 2; ++ai)
#pragma unroll
                for (int m = 0; m < 4; ++m) { const int row = row0 + ai * 128 + m * 16;
#pragma unroll
                    for (int bj = 0; bj < 2; ++bj) { f32x4 lf[2], kf[2];
#pragma unroll
                        for (int n = 0; n < 2; ++n)
#pragma unroll
                            for (int e = 0; e < 4; ++e) { float xx = acc[ai][bj][m][n][e]; xx = fminf(fmaxf(xx, -30.f), 30.f); const float ee = fexp(-xx), sg = frcp(1.0f + ee), sgn = ee * sg; const float l = lb[bj][n][e];
                                const float f = l + (1.0f - l) * sg; lf[n][e] = __logf(f); kf[n][e] = (1.0f - l) * sgn; }
                        const size_t off = (size_t)row * 1024 + cb + bj * 128 + colw;
                        *(f32x4*)(LF + off) = lf[0]; *(f32x4*)(LF + off + 4) = lf[1];
                        u32x4 w; w.x = pk2(kf[0][0], kf[0][1]); w.y = pk2(kf[0][2], kf[0][3]); w.z = pk2(kf[1][0], kf[1][1]); w.w = pk2(kf[1][2], kf[1][3]);
                        *(u32x4*)(KFo + off) = w; } }
        } else {
            bf16_t* O; int pitch, cb, act;
            if (pn < 12) { O = (bf16_t*)(ws + WS_HQ); pitch = 1024; cb = (pn - 8) * 256; act = 1; }
            else if (pn < 20) { O = (bf16_t*)(ws + WS_HI); pitch = 1024; cb = (pn - 16) * 256; act = 0; }
            else if (pn < 24) { O = (bf16_t*)(ws + WS_HOG); pitch = 1024; cb = (pn - 20) * 256; act = 1; }
            else if (pn < 32) { O = (bf16_t*)(ws + WS_GA); pitch = 2048; cb = (pn - 24) * 256; act = 2; }
            else { O = (bf16_t*)(ws + WS_GH); pitch = 2048; cb = (pn - 32) * 256; act = 2; }
#pragma unroll
            for (int ai = 0; ai < 2; ++ai)
#pragma unroll
                for (int m = 0; m < 4; ++m) { const int row = row0 + ai * 128 + m * 16;
#pragma unroll
                    for (int bj = 0; bj < 2; ++bj) { f32x4 v0 = acc[ai][bj][m][0], v1 = acc[ai][bj][m][1];
                        if (act == 1) {
#pragma unroll
                            for (int e = 0; e < 4; ++e) { v0[e] = siluf_(v0[e]); v1[e] = siluf_(v1[e]); } }
                        else if (act == 2) {
#pragma unroll
                            for (int e = 0; e < 4; ++e) { v0[e] = sigmoidf_(v0[e]); v1[e] = sigmoidf_(v1[e]); } }
                        u32x4 w; w.x = pk2(v0[0], v0[1]); w.y = pk2(v0[2], v0[3]); w.z = pk2(v1[0], v1[1]); w.w = pk2(v1[2], v1[3]);
                        *(u32x4*)(O + (size_t)row * pitch + cb + bj * 128 + colw) = w; } }
        }
    }
};

__device__ __forceinline__ void p3_indexer(Frame& F) {
    const bf16_t* IQ = WSP(bf16_t, WS_IQ); const bf16_t* IK = WSP(bf16_t, WS_IK); const float* IW = WSP(float, WS_IW); float* SC = WSP(float, WS_SCORES);
    const int gw = F.bid * NWAVES + F.wave, NGW = F.G * NWAVES, lane = F.lane, q = lane & 15, quad = lane >> 4;
    for (int it = gw; it < 2 * 2176; it += NGW) {
        const int b = it / 2176; int r = it % 2176; int qg = 0; while (r >= 16 * (qg + 1)) { r -= 16 * (qg + 1); ++qg; }
        const int qi = 16 * qg + r / (qg + 1), ch = r % (qg + 1);
        const int kt0 = 16 * ch, kt1 = min(16 * ch + 16, qi + 1);
        const size_t qrow = (size_t)b * SEQ + 16 * qi + q;
        bf16x8 bq[8][2];
#pragma unroll
        for (int h = 0; h < 8; ++h)
#pragma unroll
            for (int ks = 0; ks < 2; ++ks) bq[h][ks] = *(const bf16x8*)(IQ + qrow * 512 + h * 64 + 32 * ks + 8 * quad);
        const f32x4 w0 = *(const f32x4*)(IW + qrow * 8), w1 = *(const f32x4*)(IW + qrow * 8 + 4);
        const float wv[8] = {w0[0], w0[1], w0[2], w0[3], w1[0], w1[1], w1[2], w1[3]};
        f32x4 scs[16];
        bf16x8 na[4][2];
        const bf16_t* kbase = IK + ((size_t)b * SEQ + q) * 64 + 8 * quad;
        const int ntl = kt1 - kt0, rot = (gw * 5 + (gw >> 4)) % ntl;
#define IX_TILE(j_) (kt0 + (((j_) + rot) % ntl))
#pragma unroll
        for (int j = 0; j < 4; ++j) { const int kt = IX_TILE(j); na[j][0] = *(const bf16x8*)(kbase + (size_t)kt * 1024); na[j][1] = *(const bf16x8*)(kbase + (size_t)kt * 1024 + 32); }
#define IX_BODY(j) { \
                const bf16x8 a0 = na[(j) & 3][0], a1 = na[(j) & 3][1]; \
                if ((j) + 4 < 16) { const int ktn = IX_TILE((j) + 4); na[(j) & 3][0] = *(const bf16x8*)(kbase + (size_t)ktn * 1024); na[(j) & 3][1] = *(const bf16x8*)(kbase + (size_t)ktn * 1024 + 32); } \
                f32x4 dh[8]; \
                _Pragma("unroll") for (int h = 0; h < 8; ++h) dh[h] = __builtin_amdgcn_mfma_f32_16x16x32_bf16(a0, bq[h][0], (f32x4){0.f, 0.f, 0.f, 0.f}, 0, 0, 0); \
                _Pragma("unroll") for (int h = 0; h < 8; ++h) dh[h] = __builtin_amdgcn_mfma_f32_16x16x32_bf16(a1, bq[h][1], dh[h], 0, 0, 0); \
                f32x4 sc = {0.f, 0.f, 0.f, 0.f}; \
                _Pragma("unroll") for (int h = 0; h < 8; ++h) _Pragma("unroll") for (int e = 0; e < 4; ++e) { const int bi = (int)__float_as_uint(dh[h][e]); sc[e] += wv[h] * __uint_as_float((unsigned)(bi > 0 ? bi : 0)); } \
                scs[j] = sc; }
        if (ntl == 16) {
#pragma unroll
            for (int j = 0; j < 16; ++j) IX_BODY(j)
        } else {
#pragma unroll
            for (int j = 0; j < 16; ++j) { scs[j] = (f32x4){0.f, 0.f, 0.f, 0.f}; if (j < ntl) IX_BODY(j) }
        }
#undef IX_BODY
#pragma unroll
        for (int j = 0; j < 16; ++j) { if (j < ntl) *(f32x4*)(SC + qrow * SEQ + 16 * IX_TILE(j) + 4 * quad) = scs[j]; }
#undef IX_TILE
    }
}

constexpr int HG_QD = 0, HG_KD = 17408, HG_VT = 34816, HG_KET = 53248, HG_ATT = 71680, HG_TOT = 80896, HG_O = 83968;

__device__ __forceinline__ void hg_cum(Frame& F, float (&cum)[16], float& cum_last) {
    LAS float* tot = (LAS float*)(F.lds + HG_TOT);
    const int seg = F.tid >> 7, k = F.tid & 127;
    float run = 0.f;
#pragma unroll
    for (int i = 0; i < 16; ++i) { run += cum[i]; cum[i] = run; }
    tot[seg * 128 + k] = run;
    __syncthreads();
    float pre = 0.f, all = 0.f;
#pragma unroll
    for (int s = 0; s < 4; ++s) { const float t = tot[s * 128 + k]; all += t; if (s < seg) pre += t; }
#pragma unroll
    for (int i = 0; i < 16; ++i) cum[i] += pre;
    cum_last = all;
}

__device__ __forceinline__ void p3_hgrn_upd(Frame& F) {
    const float* LOGF = WSP(float, WS_LOGF); const bf16_t* KF = WSP(bf16_t, WS_KF); const bf16_t* HI = WSP(bf16_t, WS_HI);
    float* UPDT = WSP(float, WS_UPDT); float* DEC = WSP(float, WS_DECAY);
    LAS bf16_t* VT = (LAS bf16_t*)(F.lds + HG_VT); LAS bf16_t* KET = (LAS bf16_t*)(F.lds + HG_KET);
    const int seg = F.tid >> 7, k = F.tid & 127, lane = F.lane, r32 = lane & 31, hi = lane >> 5;
    float lf[16]; bf16_t lk[16], lv[16];
#define HGU_LOAD(tile_) do { const int b_ = (tile_) >> 9, n_ = ((tile_) >> 3) & 63, h_ = (tile_) & 7; const size_t ob_ = ((size_t)b_ * SEQ + 64 * n_ + 16 * seg) * 1024 + h_ * 128 + k; \
        _Pragma("unroll") for (int i = 0; i < 16; ++i) { lf[i] = LOGF[ob_ + i * 1024]; lk[i] = KF[ob_ + i * 1024]; lv[i] = HI[ob_ + i * 1024]; } } while (0)
    if (F.bid < 1024) HGU_LOAD(F.bid);
    for (int tile = F.bid; tile < 1024; tile += F.G) {
        __syncthreads();
        float cum[16], cl;
#pragma unroll
        for (int i = 0; i < 16; ++i) cum[i] = lf[i];
        hg_cum(F, cum, cl);
        { unsigned pk[8], pv[8];
#pragma unroll
          for (int i = 0; i < 16; i += 2) {
              const float k0 = bf2f(lk[i]) * fexp(cl - cum[i]), k1 = bf2f(lk[i + 1]) * fexp(cl - cum[i + 1]); pk[i >> 1] = pk2(k0, k1);
              pv[i >> 1] = (unsigned)lv[i] | ((unsigned)lv[i + 1] << 16); }
          LAS u32x4* dk = (LAS u32x4*)(KET + k * 72 + 16 * seg); dk[0] = (u32x4){pk[0], pk[1], pk[2], pk[3]}; dk[1] = (u32x4){pk[4], pk[5], pk[6], pk[7]};
          LAS u32x4* dv = (LAS u32x4*)(VT + k * 72 + 16 * seg); dv[0] = (u32x4){pv[0], pv[1], pv[2], pv[3]}; dv[1] = (u32x4){pv[4], pv[5], pv[6], pv[7]};
          if (seg == 0) DEC[(size_t)tile * 128 + k] = fexp(cl); }
        __builtin_amdgcn_sched_barrier(0);
        if (tile + F.G < 1024) HGU_LOAD(tile + F.G);
        __syncthreads();
        const int vt = F.wave & 3, kt0 = (F.wave >> 2) * 2;
        f32x16 c0 = {}, c1 = {};
#pragma unroll
        for (int ks = 0; ks < 4; ++ks) { const bf16x8 a = *(const LAS bf16x8*)(VT + (vt * 32 + r32) * 72 + 16 * ks + 8 * hi);
            const bf16x8 b0 = *(const LAS bf16x8*)(KET + (kt0 * 32 + r32) * 72 + 16 * ks + 8 * hi), b1 = *(const LAS bf16x8*)(KET + (kt0 * 32 + 32 + r32) * 72 + 16 * ks + 8 * hi);
            c0 = mfma32(a, b0, c0); c1 = mfma32(a, b1, c1); }
        float* U = UPDT + (size_t)tile * 16384;
#pragma unroll
        for (int r = 0; r < 16; ++r) { const int v = vt * 32 + crow(r, hi); U[v * 128 + kt0 * 32 + r32] = c0[r]; U[v * 128 + kt0 * 32 + 32 + r32] = c1[r]; }
    }
#undef HGU_LOAD
}

__device__ __forceinline__ void p4_hgrn_scan(Frame& F) {
    const float* UPDT = WSP(float, WS_UPDT); const float* DEC = WSP(float, WS_DECAY); bf16_t* SP = WSP(bf16_t, WS_SPREVT);
    const int gt = F.bid * NTHREADS + F.tid, NGT = F.G * NTHREADS;
    for (int e = gt; e < 2 * 8 * 16384 / 2; e += NGT) {
        const int bh = e >> 13, vk = (e & 8191) * 2, b = bh >> 3, h = bh & 7, k = vk & 127;
        float s0 = 0.f, s1 = 0.f;
#pragma unroll 8
        for (int n = 0; n < 64; ++n) { const size_t tile = (size_t)(b * 64 + n) * 8 + h;
            const f32x2 u = *(const f32x2*)(UPDT + tile * 16384 + vk), d = *(const f32x2*)(DEC + tile * 128 + k);
            *(unsigned*)(SP + tile * 16384 + vk) = pk2(s0, s1);
            s0 = d.x * s0 + u.x; s1 = d.y * s1 + u.y; }
    }
}

__device__ __forceinline__ void p5_hgrn_out(Frame& F) {
    const float* LOGF = WSP(float, WS_LOGF); const bf16_t* KF = WSP(bf16_t, WS_KF); const bf16_t* HI = WSP(bf16_t, WS_HI); const bf16_t* HQ = WSP(bf16_t, WS_HQ);
    const bf16_t* HOG = WSP(bf16_t, WS_HOG); const bf16_t* SP = WSP(bf16_t, WS_SPREVT); bf16_t* YHG = WSP(bf16_t, WS_YHG);
    LAS bf16_t* QD = (LAS bf16_t*)(F.lds + HG_QD); LAS bf16_t* KD = (LAS bf16_t*)(F.lds + HG_KD); LAS bf16_t* VT = (LAS bf16_t*)(F.lds + HG_VT);
    LAS bf16_t* ATT = (LAS bf16_t*)(F.lds + HG_ATT); LAS float* OB = (LAS float*)(F.lds + HG_O);
    const int seg = F.tid >> 7, k = F.tid & 127, lane = F.lane, r32 = lane & 31, hi = lane >> 5;
    float lf[16]; bf16_t lq[16], lk[16], lv[16];
#define HGO_LOAD(tile_) do { const int b_ = (tile_) >> 9, n_ = ((tile_) >> 3) & 63, h_ = (tile_) & 7; const size_t ob_ = ((size_t)b_ * SEQ + 64 * n_ + 16 * seg) * 1024 + h_ * 128 + k; \
        _Pragma("unroll") for (int i = 0; i < 16; ++i) { lf[i] = LOGF[ob_ + i * 1024]; lq[i] = HQ[ob_ + i * 1024]; lk[i] = KF[ob_ + i * 1024]; lv[i] = HI[ob_ + i * 1024]; } } while (0)
    if (F.bid < 1024) HGO_LOAD(F.bid);
    for (int tile = F.bid; tile < 1024; tile += F.G) {
        const int b = tile >> 9, n = (tile >> 3) & 63, h = tile & 7; const size_t m0 = (size_t)b * SEQ + 64 * n;
        __syncthreads();
        float cum[16], cl;
#pragma unroll
        for (int i = 0; i < 16; ++i) cum[i] = lf[i];
        hg_cum(F, cum, cl);
        { unsigned pv[8];
          __builtin_amdgcn_sched_barrier(0);
#pragma unroll
          for (int i = 0; i < 16; ++i) {
              const float qd = bf2f(lq[i]) * fexp(cum[i]), kd = bf2f(lk[i]) * fexp(-cum[i]);
              QD[(16 * seg + i) * 136 + k] = (bf16_t)(pk2(qd, 0.f) & 0xffffu); KD[(16 * seg + i) * 136 + k] = (bf16_t)(pk2(kd, 0.f) & 0xffffu);
              if (i & 1) pv[i >> 1] |= ((unsigned)lv[i] << 16); else pv[i >> 1] = (unsigned)lv[i]; }
          LAS u32x4* dv = (LAS u32x4*)(VT + k * 72 + 16 * seg); dv[0] = (u32x4){pv[0], pv[1], pv[2], pv[3]}; dv[1] = (u32x4){pv[4], pv[5], pv[6], pv[7]}; }
        const int tt = F.wave >> 2, vt = F.wave & 3;
        bf16x8 sb[8];
        { const bf16_t* S = SP + (size_t)tile * 16384 + (size_t)(vt * 32 + r32) * 128;
#pragma unroll
          for (int ks = 0; ks < 8; ++ks) sb[ks] = *(const bf16x8*)(S + 16 * ks + 8 * hi); }
        __builtin_amdgcn_sched_barrier(0);
        if (tile + F.G < 1024) HGO_LOAD(tile + F.G);
        __syncthreads();
        if (F.wave < 4) { const int ta = F.wave >> 1, sa = F.wave & 1; f32x16 c = {};
            if (sa <= ta) {
#pragma unroll
                for (int ks = 0; ks < 8; ++ks) { const bf16x8 a = *(const LAS bf16x8*)(QD + (ta * 32 + r32) * 136 + 16 * ks + 8 * hi), bb = *(const LAS bf16x8*)(KD + (sa * 32 + r32) * 136 + 16 * ks + 8 * hi); c = mfma32(a, bb, c); } }
#pragma unroll
            for (int r = 0; r < 16; ++r) { const int t = ta * 32 + crow(r, hi), s = sa * 32 + r32; const float v = (s <= t) ? c[r] : 0.f; ATT[t * 72 + s] = (bf16_t)(pk2(v, 0.f) & 0xffffu); } }
        f32x16 o = {};
        {
#pragma unroll
          for (int ks = 0; ks < 8; ++ks) { const bf16x8 a = *(const LAS bf16x8*)(QD + (tt * 32 + r32) * 136 + 16 * ks + 8 * hi); o = mfma32(a, sb[ks], o); } }
        __syncthreads();
#pragma unroll
        for (int ks = 0; ks < 4; ++ks) { const bf16x8 a = *(const LAS bf16x8*)(ATT + (tt * 32 + r32) * 72 + 16 * ks + 8 * hi), bb = *(const LAS bf16x8*)(VT + (vt * 32 + r32) * 72 + 16 * ks + 8 * hi); o = mfma32(a, bb, o); }
#pragma unroll
        for (int r = 0; r < 16; ++r) OB[(tt * 32 + crow(r, hi)) * 132 + vt * 32 + r32] = o[r];
        __syncthreads();
        { const int t = F.tid >> 3, part = F.tid & 7; float v[16], ss = 0.f;
#pragma unroll
          for (int i = 0; i < 16; i += 4) { const f32x4 x = *(const LAS f32x4*)(OB + t * 132 + part * 16 + i); v[i] = x[0]; v[i + 1] = x[1]; v[i + 2] = x[2]; v[i + 3] = x[3]; ss += (x[0] * x[0] + x[1] * x[1]) + (x[2] * x[2] + x[3] * x[3]); }
          ss += __shfl_xor(ss, 1); ss += __shfl_xor(ss, 2); ss += __shfl_xor(ss, 4);
          const float rs = 1.0f / sqrtf(ss * (1.0f / 128.0f) + EPS);
          const size_t off = (m0 + t) * 1024 + h * 128 + part * 16; unsigned w[8];
          const u32x4 g0 = *(const u32x4*)(HOG + off), g1 = *(const u32x4*)(HOG + off + 8); const unsigned gg[8] = {g0.x, g0.y, g0.z, g0.w, g1.x, g1.y, g1.z, g1.w};
          const float* ghp = F.g_head + h * 128 + part * 16; const f32x4 gh0 = *(const f32x4*)ghp, gh1 = *(const f32x4*)(ghp + 4), gh2 = *(const f32x4*)(ghp + 8), gh3 = *(const f32x4*)(ghp + 12);
          const float ghv[16] = {gh0[0], gh0[1], gh0[2], gh0[3], gh1[0], gh1[1], gh1[2], gh1[3], gh2[0], gh2[1], gh2[2], gh2[3], gh3[0], gh3[1], gh3[2], gh3[3]};
#pragma unroll
          for (int i = 0; i < 8; ++i) { w[i] = pk2(v[2 * i] * rs * ghv[2 * i] * bf2f(gg[i] & 0xffffu), v[2 * i + 1] * rs * ghv[2 * i + 1] * bf2f(gg[i] >> 16)); }
          *(u32x4*)(YHG + off) = (u32x4){w[0], w[1], w[2], w[3]}; *(u32x4*)(YHG + off + 8) = (u32x4){w[4], w[5], w[6], w[7]}; }
    }
}

__device__ __forceinline__ unsigned f2ord(float f) { const unsigned u = __float_as_uint(f); return (u & 0x80000000u) ? ~u : (u | 0x80000000u); }
__device__ __forceinline__ void p4_sel_load(const float* SC, int row, int lane, unsigned (&nu)[64]) {
    const int t = row & (SEQ - 1);
    if (t >= TOPK) { const float* srow = SC + (size_t)row * SEQ; const int ng = (t >> 9) + 1;
#pragma unroll
        for (int g = 0; g < 8; ++g) {
            if (g < ng) {
#pragma unroll
                for (int j = 0; j < 8; ++j) nu[8 * g + j] = __float_as_uint(srow[64 * (8 * g + j) + lane]);
            }
        }
    }
}
__device__ __forceinline__ void p4_select(Frame& F) {
    const float* SC = WSP(float, WS_SCORES); unsigned long long* MASK = WSP(unsigned long long, WS_MASK);
    const int gw = F.bid * NWAVES + F.wave, NGW = F.G * NWAVES, lane = F.lane;
    constexpr int NPAIR = NBATCH * (SEQ / 2);
#define SEL_ROW(k_) ({ const int idx_ = gw + ((k_) >> 1) * NGW; const int b_ = idx_ / (SEQ / 2), p_ = idx_ % (SEQ / 2); b_ * SEQ + (((k_) & 1) ? (SEQ - 1 - p_) : p_); })
#define SEL_HAVE(k_) (gw + ((k_) >> 1) * NGW < NPAIR)
    unsigned nu[64];
#pragma unroll
    for (int i = 0; i < 64; ++i) nu[i] = 0u;
    int k = 0; bool have = SEL_HAVE(0); int row = have ? SEL_ROW(0) : 0;
    if (have) p4_sel_load(SC, row, lane, nu);
    while (have) {
        const int t = row & (SEQ - 1);
        unsigned long long mine = 0ull;
        unsigned u[64];
        const int ng = (t >> 9) + 1;
        if (t >= TOPK) {
#pragma unroll
            for (int g = 0; g < 8; ++g) {
                if (g < ng) {
#pragma unroll
                    for (int j = 0; j < 8; ++j) { const int i = 8 * g + j; const unsigned bits = nu[i]; u[i] = bits ^ ((unsigned)((int)bits >> 31) | 0x80000000u); }
                    if (g == ng - 1) {
#pragma unroll
                        for (int j = 0; j < 8; ++j) { const int i = 8 * g + j, s = 64 * i + lane; u[i] = (s <= t) ? u[i] : 0u; }
                    }
                } else {
#pragma unroll
                    for (int j = 0; j < 8; ++j) u[8 * g + j] = 0u;
                }
            }
        }
        __builtin_amdgcn_sched_barrier(0);
        ++k; const bool haveN = SEL_HAVE(k); const int rowN = haveN ? SEL_ROW(k) : 0;
        if (haveN) p4_sel_load(SC, rowN, lane, nu);
        __builtin_amdgcn_sched_barrier(0);
        if (t < TOPK) {
            const int lo = 64 * lane;
            mine = (t >= lo + 63) ? ~0ull : (t < lo ? 0ull : ((1ull << (t - lo + 1)) - 1ull));
        } else {
            const int ntot = 512 * ng;
            unsigned hp[32];
#pragma unroll
            for (int i = 0; i < 32; ++i) hp[i] = (u[2 * i] >> 16) | (u[2 * i + 1] & 0xffff0000u);
            unsigned T = 0u; bool exact = false; int geT = ntot;
            { const unsigned one2 = 0x00010001u; unsigned Th = 0u;
              for (int bit = 15; bit >= 0; --bit) {
                  const unsigned ch = Th | (1u << bit); unsigned c2 = ch | (ch << 16), acc2 = 0u;
                  asm volatile("" : "+v"(c2));
#pragma unroll
                  for (int g = 0; g < 8; ++g) {
                      if (g < ng) {
#pragma unroll
                          for (int j = 0; j < 4; ++j) { unsigned d;
                              asm("v_pk_sub_u16 %0, %1, %2 clamp" : "=v"(d) : "v"(c2), "v"(hp[4 * g + j]));
                              asm("v_pk_min_u16 %0, %1, %2" : "=v"(d) : "v"(d), "v"(one2));
                              asm("v_pk_add_u16 %0, %1, %2" : "=v"(acc2) : "v"(acc2), "v"(d)); }
                      }
                  }
                  const int ge = ntot - wave_sum_i_dpp((int)((acc2 & 0xffffu) + (acc2 >> 16)));
                  if (ge >= TOPK) { Th = ch; geT = ge; if (ge == TOPK) { exact = true; break; } }
              }
              T = Th << 16; }
            if (!exact) {
                for (int bit = 15; bit >= 0; --bit) {
                    unsigned cand = T | (1u << bit); int c = 0;
                    asm volatile("" : "+v"(cand));
#pragma unroll
                    for (int g = 0; g < 8; ++g) {
                        if (g < ng) {
#pragma unroll
                            for (int j = 0; j < 8; j += 2) { unsigned d0, d1;
                                asm("v_sub_u32_e64 %0, %1, %2 clamp" : "=v"(d0) : "v"(cand), "v"(u[8 * g + j]));
                                asm("v_sub_u32_e64 %0, %1, %2 clamp" : "=v"(d1) : "v"(cand), "v"(u[8 * g + j + 1]));
                                asm("v_min_u32_e32 %0, 1, %1" : "=v"(d0) : "v"(d0));
                                asm("v_min_u32_e32 %0, 1, %1" : "=v"(d1) : "v"(d1));
                                c += (int)(d0 + d1); }
                        }
                    }
                    const int ge = ntot - wave_sum_i_dpp(c);
                    if (ge >= TOPK) { T = cand; geT = ge; if (ge == TOPK) break; }
                }
            }
            const bool allties = (geT == TOPK);
            int need = 0;
            if (!allties) { int cg = 0;
#pragma unroll
                for (int g = 0; g < 8; ++g) {
                    if (g < ng) {
#pragma unroll
                        for (int j = 0; j < 8; ++j) cg += (u[8 * g + j] > T) ? 1 : 0;
                    }
                }
                need = TOPK - wave_sum_i_dpp(cg); }
            int running = 0; const unsigned long long lt = (1ull << lane) - 1ull;
#pragma unroll
            for (int g = 0; g < 8; ++g) {
                if (g < ng) {
#pragma unroll
                    for (int j = 0; j < 8; ++j) { const int i = 8 * g + j;
                        unsigned long long sb;
                        if (allties) sb = __ballot(u[i] >= T);
                        else { const bool eq = (u[i] == T); const unsigned long long bal = __ballot(eq);
                            const int rank = running + __popcll(bal & lt); running += __popcll(bal);
                            sb = __ballot((u[i] > T) || (eq && rank < need)); }
                        if (lane == i) mine = sb; }
                }
            }
        }
        MASK[(size_t)row * 64 + lane] = mine;
        row = rowN; have = haveN;
    }
#undef SEL_ROW
#undef SEL_HAVE
}

constexpr int AT_K = 0, AT_V = 34816, AT_END = 34816 + 34816;
constexpr int AT_MRG = 0, AT_STG = 69632;
__device__ __forceinline__ void p5_attention(Frame& F) {
    const bf16_t* AQ = WSP(bf16_t, WS_AQ); const bf16_t* AK = WSP(bf16_t, WS_AK); const bf16_t* AVT = WSP(bf16_t, WS_AVT); const unsigned* MASK = WSP(unsigned, WS_MASK); bf16_t* YATT = WSP(bf16_t, WS_YATT);
    const int lane = F.lane, r32 = lane & 31, hi = lane >> 5, w = F.wave, kp = w >> 2, tid = F.tid;
    LAS unsigned char* lds = F.lds;
    for (int item = F.bid; item < 256; item += F.G) {
        const int b = item >> 7, hk = (item >> 6) & 1, jj = item & 63;
        for (int uu = 0; uu < 2; ++uu) {
            const int j = uu ? 127 - jj : jj;
            const int head = hk * 4 + (w & 3);
            const size_t qrow = (size_t)b * SEQ + 32 * j + r32;
            const int NT = (j + 2) >> 1, NI = (NT + 1) >> 1;
            bf16x8 qf[8];
#pragma unroll
            for (int ks = 0; ks < 8; ++ks) qf[ks] = *(const bf16x8*)(AQ + qrow * 1024 + head * 128 + 16 * ks + 8 * hi);
            f32x16 o[4]; o[0] = f32x16{}; o[1] = f32x16{}; o[2] = f32x16{}; o[3] = f32x16{};
            float mrun = -INFINITY, lrun = 0.f;
            u32x4 sk[4], sv[4];
#pragma unroll
            for (int c = 0; c < 4; ++c) { sk[c] = (u32x4){0u, 0u, 0u, 0u}; sv[c] = (u32x4){0u, 0u, 0u, 0u}; }
            const bf16_t* Kg = AK + (size_t)b * SEQ * 256 + hk * 128;
            const bf16_t* Vg = AVT + (size_t)((b * 2 + hk) * 128) * SEQ;
#define AT_LOAD(it_) do { int tv = tid; asm volatile("" : "+v"(tv)); const unsigned kb2 = (unsigned)(it_) * 128u; \
                const unsigned ko = ((kb2 + (unsigned)(tv >> 4)) * 256u + (unsigned)(tv & 15) * 8u) * 2u; \
                const unsigned vo = ((unsigned)(tv >> 3) * (unsigned)SEQ + kb2 + (unsigned)(tv & 7) * 8u) * 2u; \
                _Pragma("unroll") for (int c = 0; c < 4; ++c) { \
                    sk[c] = *(const u32x4*)((const char*)Kg + ko + (unsigned)c * 32u * 512u); \
                    sv[c] = *(const u32x4*)((const char*)Vg + vo + (unsigned)(c & 1) * 64u * (unsigned)SEQ * 2u + (unsigned)(c >> 1) * 128u); } } while (0)
#define AT_STORE(bo_) do { \
                _Pragma("unroll") for (int c = 0; c < 4; ++c) { const int id = c * 512 + tid; const int key = id >> 4, ch = id & 15; \
                    *(LAS u32x4*)(lds + (bo_) + AT_K + key * 272 + ch * 16) = sk[c]; \
                    const int vd = (id >> 3) & 127, vp = id >> 10, vc = id & 7; \
                    LAS u32x2* dst = (LAS u32x2*)(lds + (bo_) + AT_V + vp * 17408 + vd * 136 + vc * 16); dst[0] = (u32x2){sv[c].x, sv[c].y}; dst[1] = (u32x2){sv[c].z, sv[c].w}; } } while (0)
            AT_LOAD(0);
            u32x2 mwn = (kp < NT) ? *(const u32x2*)(MASK + qrow * 128 + 2 * kp) : (u32x2){0u, 0u};
            __syncthreads();
            AT_STORE(0);
            if (NI > 1) AT_LOAD(1);
            __syncthreads();
            for (int it = 0; it < NI; ++it) {
                const int bo = (it & 1) * 69632;
                if (kp == 1 && it + 1 < NI) { AT_STORE(((it + 1) & 1) * 69632); if (it + 2 < NI) AT_LOAD(it + 2); }
                const int kt = 2 * it + kp;
                const u32x2 mw = mwn;
                if (kt + 2 < NT) mwn = *(const u32x2*)(MASK + qrow * 128 + 2 * (kt + 2));
                if (kt < NT) {
                    const LAS unsigned char* Kp = lds + bo + AT_K + kp * 17408; const LAS unsigned char* Vp = lds + bo + AT_V + kp * 17408;
                    f32x16 p0 = {}, p1 = {};
#pragma unroll
                    for (int ks = 0; ks < 8; ++ks) { const bf16x8 a0 = *(const LAS bf16x8*)(Kp + r32 * 272 + (16 * ks + 8 * hi) * 2), a1 = *(const LAS bf16x8*)(Kp + (32 + r32) * 272 + (16 * ks + 8 * hi) * 2);
                        p0 = mfma32(a0, qf[ks], p0); p1 = mfma32(a1, qf[ks], p1); }
                    __builtin_amdgcn_sched_barrier(0);
                    float rm = fmaxf(p0[0], p1[0]);
#pragma unroll
                    for (int r = 1; r < 16; ++r) rm = fmaxf(rm, fmaxf(p0[r], p1[r]));
                    rm = fmaxf(rm, __shfl_xor(rm, 32));
                    if (__any(rm > mrun + 8.0f)) { const float mnew = fmaxf(mrun, rm), alpha = __builtin_amdgcn_exp2f(mrun - mnew); lrun *= alpha; mrun = mnew;
#pragma unroll
                        for (int dt = 0; dt < 4; ++dt)
#pragma unroll
                            for (int r = 0; r < 16; ++r) o[dt][r] *= alpha; }
                    const int mx0 = (int)(mw.x >> (4 * hi)), mx1 = (int)(mw.y >> (4 * hi));
                    float ps = 0.f;
#pragma unroll
                    for (int r = 0; r < 16; ++r) { const int bp = (r & 3) + 8 * (r >> 2);
                        p0[r] = __uint_as_float(__float_as_uint(__builtin_amdgcn_exp2f(p0[r] - mrun)) & (unsigned)__builtin_amdgcn_sbfe(mx0, bp, 1));
                        p1[r] = __uint_as_float(__float_as_uint(__builtin_amdgcn_exp2f(p1[r] - mrun)) & (unsigned)__builtin_amdgcn_sbfe(mx1, bp, 1));
                        ps += p0[r] + p1[r]; }
                    lrun += ps;
                    bf16x8 pb[4];
#pragma unroll
                    for (int s = 0; s < 2; ++s) { u32x4 t0, t1;
                        t0.x = pk2(p0[8 * s + 0], p0[8 * s + 1]); t0.y = pk2(p0[8 * s + 2], p0[8 * s + 3]); t0.z = pk2(p0[8 * s + 4], p0[8 * s + 5]); t0.w = pk2(p0[8 * s + 6], p0[8 * s + 7]);
                        t1.x = pk2(p1[8 * s + 0], p1[8 * s + 1]); t1.y = pk2(p1[8 * s + 2], p1[8 * s + 3]); t1.z = pk2(p1[8 * s + 4], p1[8 * s + 5]); t1.w = pk2(p1[8 * s + 6], p1[8 * s + 7]);
                        pb[s] = __builtin_bit_cast(bf16x8, t0); pb[2 + s] = __builtin_bit_cast(bf16x8, t1); }
#pragma unroll
                    for (int dt = 0; dt < 4; ++dt) {
                        __builtin_amdgcn_sched_barrier(0);
#pragma unroll
                        for (int s = 0; s < 4; ++s) { const LAS unsigned char* vr = Vp + (dt * 32 + r32) * 136 + (16 * s + 4 * hi) * 2;
                            const u32x2 lo = *(const LAS u32x2*)vr, hh = *(const LAS u32x2*)(vr + 16);
                            const u32x4 av = {lo.x, lo.y, hh.x, hh.y};
                            o[dt] = mfma32(__builtin_bit_cast(bf16x8, av), pb[s], o[dt]); } }
                    __builtin_amdgcn_sched_barrier(0);
                }
                if (kp == 0 && it + 1 < NI) { AT_STORE(((it + 1) & 1) * 69632); if (it + 2 < NI) AT_LOAD(it + 2); }
                __syncthreads();
            }
            __syncthreads();
            LAS float* mg = (LAS float*)(lds + AT_MRG) + (w & 3) * 66 * 64;
            if (kp == 1) { mg[lane] = mrun; mg[64 + lane] = lrun;
#pragma unroll
                for (int dt = 0; dt < 4; ++dt)
#pragma unroll
                    for (int r = 0; r < 16; ++r) mg[(2 + dt * 16 + r) * 64 + lane] = o[dt][r]; }
            __syncthreads();
            if (kp == 0) {
                const float m1 = mg[lane], l1 = mg[64 + lane];
                const float mt = fmaxf(mrun, m1), mu = (mt == -INFINITY) ? 0.f : mt;
                const float a0 = __builtin_amdgcn_exp2f(mrun - mu), a1 = __builtin_amdgcn_exp2f(m1 - mu);
                float l = lrun * a0 + l1 * a1; l += __shfl_xor(l, 32);
                const float inv = 1.0f / l;
                LAS bf16_t* stg = (LAS bf16_t*)(lds + AT_STG) + (w & 3) * 32 * 136;
#pragma unroll
                for (int dt = 0; dt < 4; ++dt)
#pragma unroll
                    for (int r = 0; r < 16; ++r) { const float v = (o[dt][r] * a0 + mg[(2 + dt * 16 + r) * 64 + lane] * a1) * inv; stg[r32 * 136 + dt * 32 + crow(r, hi)] = (bf16_t)(pk2(v, 0.f) & 0xffffu); }
                LDS_WAIT();
#pragma unroll
                for (int i = 0; i < 8; ++i) { const int rr = i * 4 + (lane >> 4), ch = lane & 15; const u32x4 v = *(const LAS u32x4*)(stg + rr * 136 + ch * 8);
                    *(u32x4*)(YATT + ((size_t)b * SEQ + 32 * j + rr) * 1024 + head * 128 + ch * 8) = v; }
            }
        }
    }
#undef AT_LOAD
#undef AT_STORE
}

struct ProbMerge : ProbBase {
    static constexpr bool PERM = true;
    unsigned char* ws;
    __device__ __forceinline__ bool next(int i, U& u) const { u.aux = i & 1; return pg8::static_tile((i >> 1) * G + c, M / 256, DM / 256, u.pm, u.pn); }
    __device__ __forceinline__ void bases(const U& u, const char*& a, const char*& b) const {
        a = (const char*)(ws + (u.aux ? WS_YHG : WS_YATT)) + (size_t)u.pm * 256 * K * 2; b = (const char*)(ws + (u.aux ? WS_WHU_T : WS_WAU_T)) + (size_t)u.pn * 256 * K * 2; }
    __device__ __forceinline__ void lane_offs(const U&, const int (&stR)[2], const int (&stC)[2], unsigned (&va)[2][2]) const { lane_offs_plain(stR, stC, va); }
    __device__ __forceinline__ bool keep(const U& u) const { return u.aux == 0; }
    __device__ __forceinline__ void epi(f32x4 (&acc)[2][2][4][2], const U& u, int wr, int wc, int fr, int fq) const {
        const bf16_t* GA = (const bf16_t*)(ws + WS_GA); const bf16_t* GH = (const bf16_t*)(ws + WS_GH); bf16_t* O = (bf16_t*)(ws + WS_MERGED);
        const int row0 = u.pm * 256 + wr * 64 + fr, colw = u.pn * 256 + wc * 32 + 8 * fq;
#pragma unroll
        for (int ai = 0; ai < 2; ++ai) {
            u32x4 gh[4][2], ga[4][2];
#pragma unroll
            for (int m = 0; m < 4; ++m)
#pragma unroll
                for (int bj = 0; bj < 2; ++bj) { const size_t off = (size_t)(row0 + ai * 128 + m * 16) * DM + colw + bj * 128; gh[m][bj] = *(const u32x4*)(GH + off); if (u.aux == 0) ga[m][bj] = *(const u32x4*)(GA + off); else ga[m][bj] = gh[m][bj]; }
            __builtin_amdgcn_sched_barrier(0);
#pragma unroll
            for (int m = 0; m < 4; ++m)
#pragma unroll
                for (int bj = 0; bj < 2; ++bj) { const size_t off = (size_t)(row0 + ai * 128 + m * 16) * DM + colw + bj * 128;
                    const unsigned ghw[4] = {gh[m][bj].x, gh[m][bj].y, gh[m][bj].z, gh[m][bj].w}; const unsigned gaw[4] = {ga[m][bj].x, ga[m][bj].y, ga[m][bj].z, ga[m][bj].w};
                    if (u.aux == 0) {
#pragma unroll
                        for (int n = 0; n < 2; ++n)
#pragma unroll
                            for (int e = 0; e < 4; ++e) { const int wi = 2 * n + (e >> 1); const float a = (e & 1) ? bf2f(gaw[wi] >> 16) : bf2f(gaw[wi] & 0xffffu), h = (e & 1) ? bf2f(ghw[wi] >> 16) : bf2f(ghw[wi] & 0xffffu);
                                acc[ai][bj][m][n][e] *= a * frcp(fmaxf(h, 1e-20f)); } }
                    else { float v[8];
#pragma unroll
                        for (int n = 0; n < 2; ++n)
#pragma unroll
                            for (int e = 0; e < 4; ++e) { const int wi = 2 * n + (e >> 1); const float h = (e & 1) ? bf2f(ghw[wi] >> 16) : bf2f(ghw[wi] & 0xffffu); v[4 * n + e] = acc[ai][bj][m][n][e] * h; }
                        u32x4 w; w.x = pk2(v[0], v[1]); w.y = pk2(v[2], v[3]); w.z = pk2(v[4], v[5]); w.w = pk2(v[6], v[7]); *(u32x4*)(O + off) = w; } }
            __builtin_amdgcn_sched_barrier(0);
        }
    }
};

struct ProbOut : ProbBase {
    static constexpr bool PERM = false;
    unsigned char* ws; const float* x; float* out;
    __device__ __forceinline__ bool next(int i, U& u) const { u.aux = 0; return pg8::static_tile(i * G + c, M / 256, DM / 256, u.pm, u.pn); }
    __device__ __forceinline__ void bases(const U& u, const char*& a, const char*& b) const { a = (const char*)(ws + WS_MERGED) + (size_t)u.pm * 256 * K * 2; b = (const char*)(ws + WS_WOUT_T) + (size_t)u.pn * 256 * K * 2; }
    __device__ __forceinline__ void lane_offs(const U&, const int (&stR)[2], const int (&stC)[2], unsigned (&va)[2][2]) const { lane_offs_plain(stR, stC, va); }
    __device__ __forceinline__ void epi(f32x4 (&acc)[2][2][4][2], const U& u, int wr, int wc, int fr, int fq) const {
        const float* MOD = (const float*)(ws + WS_MOD);
        const int row0 = u.pm * 256 + wr * 64 + fr, col0 = u.pn * 256 + wc * 32 + 4 * fq, b = (u.pm * 256) >> 12;
#pragma unroll
        for (int bj = 0; bj < 2; ++bj)
#pragma unroll
            for (int n = 0; n < 2; ++n) { const int col = col0 + bj * 128 + n * 16; const f32x4 gt = *(const f32x4*)(MOD + b * 12288 + 2 * DM + col);
                f32x4 xv[8];
#pragma unroll
                for (int ai = 0; ai < 2; ++ai)
#pragma unroll
                    for (int m = 0; m < 4; ++m) xv[ai * 4 + m] = *(const f32x4*)(x + (size_t)(row0 + ai * 128 + m * 16) * DM + col);
                __builtin_amdgcn_sched_barrier(0);
#pragma unroll
                for (int ai = 0; ai < 2; ++ai)
#pragma unroll
                    for (int m = 0; m < 4; ++m) { const size_t off = (size_t)(row0 + ai * 128 + m * 16) * DM + col; *(f32x4*)(out + off) = xv[ai * 4 + m] + gt * acc[ai][bj][m][n]; }
                __builtin_amdgcn_sched_barrier(0); }
    }
};

__device__ __forceinline__ void p8_norm2_route(Frame& F) {
    LAS float* CA = (LAS float*)F.lds; LAS float* CB = CA + DM;
    LAS float* WB = CB + DM;
    LAS float* LOGI = WB + 2 * 9216;
    const float* MOD = WSP(float, WS_MOD); bf16_t* XN = WSP(bf16_t, WS_XN); const float* X1 = F.out;
    int* LIST = WSP(int, WS_LIST); float* LISTW = WSP(float, WS_LISTW);
    const int lane = F.lane, tid = F.tid;
#define RT_STAGE(j_, buf_) do { int lv_ = lane; asm volatile("" : "+v"(lv_)); _Pragma("unroll") for (int i_ = 0; i_ < 5; ++i_) { const int id0_ = i_ * 512 + F.wave * 64; if (id0_ < 2304) { const int id_ = id0_ + lv_, rho_ = id_ / 9, q_ = id_ - rho_ * 9; \
            const int k_ = (j_) * 256 + 4 * (rho_ & 63) + (rho_ >> 6); const float* src_ = (q_ == 0) ? (F.w_rg + (size_t)k_ * 4) : (F.w_re + (size_t)k_ * 32 + (q_ - 1) * 4); \
            __builtin_amdgcn_global_load_lds((const unsigned*)src_, (LAS unsigned*)(WB + (buf_) * 9216 + id0_ * 4), 16, 0, 0); } } } while (0)
    for (int rb = F.bid; rb < M / 32; rb += F.G) {
        const int b = (rb * 32) / SEQ;
        __syncthreads();
        for (int k = tid; k < DM; k += NTHREADS) { CA[k] = F.g_norm2[k] * (1.0f + MOD[b * 12288 + 4 * DM + k]); CB[k] = MOD[b * 12288 + 3 * DM + k]; }
        RT_STAGE(0, 0);
        __syncthreads();
        const int mb = rb * 32 + F.wave * 4;
        float rs[4];
#pragma unroll
        for (int r = 0; r < 4; ++r) { __builtin_amdgcn_sched_barrier(0); f32x4 v[8]; rs[r] = row_rstd(X1 + (size_t)(mb + r) * DM, lane, v);
#pragma unroll
            for (int j = 0; j < 8; ++j) { const int k = 4 * (lane + 64 * j); const f32x4 a = *(const LAS f32x4*)(CA + k), bb = *(const LAS f32x4*)(CB + k);
                const f32x4 h = v[j] * rs[r] * a + bb; u32x2 o; o.x = pk2(h.x, h.y); o.y = pk2(h.z, h.w); *(u32x2*)(XN + (size_t)(mb + r) * DM + k) = o; } }
        LAS float* red = WB + F.wave * 2304;
#pragma unroll 1
        for (int half = 0; half < 2; ++half) {
            const int m0 = mb + 2 * half;
            const float rs0 = half ? rs[2] : rs[0], rs1 = half ? rs[3] : rs[1];
            float acc[2][36];
#pragma unroll
            for (int r = 0; r < 2; ++r)
#pragma unroll
                for (int j = 0; j < 36; ++j) acc[r][j] = 0.f;
            if (half) { __syncthreads(); RT_STAGE(0, 0); }
            f32x4 xc[2];
            xc[0] = *(const f32x4*)(X1 + (size_t)m0 * DM + 4 * lane); xc[1] = *(const f32x4*)(X1 + (size_t)(m0 + 1) * DM + 4 * lane);
#pragma unroll 1
            for (int j = 0; j < 8; ++j) {
                __syncthreads();
                if (j < 7) RT_STAGE(j + 1, (j + 1) & 1);
                const f32x4 ca = *(const LAS f32x4*)(CA + 256 * j + 4 * lane), cb = *(const LAS f32x4*)(CB + 256 * j + 4 * lane);
                const f32x4 h0 = xc[0] * rs0 * ca + cb, h1 = xc[1] * rs1 * ca + cb;
                if (j < 7) { xc[0] = *(const f32x4*)(X1 + (size_t)m0 * DM + 256 * (j + 1) + 4 * lane); xc[1] = *(const f32x4*)(X1 + (size_t)(m0 + 1) * DM + 256 * (j + 1) + 4 * lane); }
                const LAS float* wb = WB + (j & 1) * 9216;
#pragma unroll
                for (int e = 0; e < 4; ++e)
#pragma unroll
                    for (int q = 0; q < 9; ++q) { const f32x4 wv = *(const LAS f32x4*)(wb + (e * 64 + lane) * 36 + q * 4);
#pragma unroll
                        for (int c = 0; c < 4; ++c) { acc[0][q * 4 + c] += h0[e] * wv[c]; acc[1][q * 4 + c] += h1[e] * wv[c]; } }
            }
            __syncthreads();
#pragma unroll
            for (int r = 0; r < 2; ++r) {
#pragma unroll
                for (int q = 0; q < 9; ++q) *(LAS f32x4*)(red + lane * 36 + q * 4) = (f32x4){acc[r][q * 4], acc[r][q * 4 + 1], acc[r][q * 4 + 2], acc[r][q * 4 + 3]};
                LDS_WAIT(); asm volatile("" ::: "memory");
                if (lane < 36) { float sm = 0.f;
#pragma unroll 16
                    for (int l = 0; l < 64; ++l) sm += red[l * 36 + lane];
                    LOGI[F.wave * 36 + lane] = sm + (lane < 4 ? F.b_rg[lane] : F.b_re[lane - 4]); }
                LDS_WAIT(); asm volatile("" ::: "memory");
                if (lane == 0) {
                    const LAS float* lg = LOGI + F.wave * 36;
                    int grp = 0; float gm = lg[0];
#pragma unroll
                    for (int g = 1; g < 4; ++g) if (lg[g] > gm) { gm = lg[g]; grp = g; }
                    float gs = 0.f;
#pragma unroll
                    for (int g = 0; g < 4; ++g) gs += expf(lg[g] - gm);
                    const float pgrp = 1.0f / gs;
                    const LAS float* el = lg + 4 + grp * 8;
                    int e0 = 0; float v0 = el[0];
#pragma unroll
                    for (int e = 1; e < 8; ++e) if (el[e] > v0) { v0 = el[e]; e0 = e; }
                    int e1 = -1; float v1 = -INFINITY;
#pragma unroll
                    for (int e = 0; e < 8; ++e) if (e != e0 && el[e] > v1) { v1 = el[e]; e1 = e; }
                    const float p1 = expf(v1 - v0), w0 = pgrp / (1.0f + p1), w1 = pgrp * p1 / (1.0f + p1);
                    const int m = m0 + r;
                    const int ea = grp * 8 + e0, eb = grp * 8 + e1;
                    const unsigned sa = __hip_atomic_fetch_add(F.ctl + CW_CNT + 16 * ea, 1u, RLX_AGENT); LIST[ea * M + sa] = 2 * m; LISTW[ea * M + sa] = w0;
                    const unsigned sb = __hip_atomic_fetch_add(F.ctl + CW_CNT + 16 * eb, 1u, RLX_AGENT); LIST[eb * M + sb] = 2 * m + 1; LISTW[eb * M + sb] = w1;
                }
                LDS_WAIT(); asm volatile("" ::: "memory");
            }
        }
    }
#undef RT_STAGE
}

__device__ __forceinline__ void p8_expert_weights(Frame& F) {
    const int lane = F.lane;
    {
        __syncthreads();
        LAS float* scr = (LAS float*)(F.lds + F.wave * 16384);
        const int gw = F.bid * NWAVES + F.wave, NGW = F.G * NWAVES;
#define P8_DESC(it, d) do { const int e_ = (it) / 1536; const int r_ = (it) % 1536; \
            if (r_ < 512) { d.W = F.w_eg + (size_t)e_ * DM * EFF; d.K = DM; d.N = EFF; d.WT = WSP(bf16_t, WS_WGU_T) + (size_t)e_ * 1024 * DM; d.kind = 2; d.item = r_; } \
            else if (r_ < 1024) { d.W = F.w_eu + (size_t)e_ * DM * EFF; d.K = DM; d.N = EFF; d.WT = WSP(bf16_t, WS_WGU_T) + (size_t)e_ * 1024 * DM; d.kind = 3; d.item = r_ - 512; } \
            else { d.W = F.w_ed + (size_t)e_ * EFF * DM; d.K = EFF; d.N = DM; d.WT = WSP(bf16_t, WS_WD_T) + (size_t)e_ * DM * EFF; d.kind = 0; d.item = r_ - 1024; } } while (0)
        TD_STREAM(gw, NGW, NEXP * 1536, P8_DESC, lane, scr);
#undef P8_DESC
    }
}

constexpr int MOE_TAB_OFF = LDSCTL_OFF + 2048;
struct ProbMoe : ProbBase {
    unsigned char* ws; const LAS int* tab; int nct; unsigned* done;
    __device__ __forceinline__ bool decode(int L, U& u) const {
        const int l = (int)(threadIdx.x & 31); const bool in = (L >= tab[65 + l]) && (L < tab[66 + l]);
        const unsigned long long bal = __ballot(in);
        if (bal == 0ull) return false;
        const int e = __builtin_ctzll(bal); const int rem = L - tab[65 + e];
        u.aux = e; u.pm = rem / nct; u.pn = rem - u.pm * nct; return true;
    }
    __device__ __forceinline__ int rowbase(int e) const { return tab[32 + e]; }
    __device__ __forceinline__ int count(int e) const { return tab[e]; }
};
__device__ __forceinline__ void moe_table(LAS unsigned char* lds, const unsigned* cnt, int nct) {
    LAS int* tab = (LAS int*)(lds + MOE_TAB_OFF);
    __syncthreads();
    if (threadIdx.x < NEXP) tab[threadIdx.x] = (int)__hip_atomic_load(cnt + 16 * threadIdx.x, __ATOMIC_RELAXED, __HIP_MEMORY_SCOPE_AGENT);
    __syncthreads();
    if (threadIdx.x == 0) { int rb = 0, st = 0; for (int e = 0; e < NEXP; ++e) { tab[32 + e] = rb; tab[65 + e] = st; const int nrt = (tab[e] + 255) >> 8; rb += nrt * 256; st += nrt * nct; } tab[64] = rb; tab[97] = st; }
    __syncthreads();
}
struct ProbMoe1 : ProbMoe {
    static constexpr bool PERM = true;
    __device__ __forceinline__ bool next(int i, U& u) const { return decode(i * G + c, u); }
    __device__ __forceinline__ void bases(const U& u, const char*& a, const char*& b) const { a = (const char*)(ws + WS_XN); b = (const char*)(ws + WS_WGU_T) + ((size_t)u.aux * 1024 + u.pn * 256) * K * 2; }
    __device__ __forceinline__ void lane_offs(const U& u, const int (&stR)[2], const int (&stC)[2], unsigned (&va)[2][2]) const {
        const int* LIST = (const int*)(ws + WS_LIST); const int n = count(u.aux);
#pragma unroll
        for (int h = 0; h < 2; ++h)
#pragma unroll
            for (int i = 0; i < 2; ++i) { const int sl = u.pm * 256 + h * 128 + stR[i]; const int tok = LIST[u.aux * M + (sl < n ? sl : 0)] >> 1; va[h][i] = (unsigned)(tok * K + stC[i]) * 2u; }
    }
    __device__ __forceinline__ void epi(f32x4 (&acc)[2][2][4][2], const U& u, int wr, int wc, int fr, int fq) const {
        const float* LISTW = (const float*)(ws + WS_LISTW); bf16_t* ACT = (bf16_t*)(ws + WS_ACT);
        const int n = count(u.aux), rb = rowbase(u.aux);
        const int f0 = u.pn * 128 + wc * 16 + 4 * fq;
        float wts[8];
#pragma unroll
        for (int ai = 0; ai < 2; ++ai)
#pragma unroll
            for (int m = 0; m < 4; ++m) { const int sl = u.pm * 256 + ai * 128 + wr * 64 + m * 16 + fr; wts[ai * 4 + m] = LISTW[u.aux * M + (sl < n ? sl : 0)]; }
        __builtin_amdgcn_sched_barrier(0);
#pragma unroll
        for (int ai = 0; ai < 2; ++ai)
#pragma unroll
            for (int m = 0; m < 4; ++m) { const int sl = u.pm * 256 + ai * 128 + wr * 64 + m * 16 + fr;
                if (sl < n) { const float wt = wts[ai * 4 + m];
#pragma unroll
                    for (int bj = 0; bj < 2; ++bj) { const f32x4 g = acc[ai][bj][m][0], uu = acc[ai][bj][m][1]; float v[4];
#pragma unroll
                        for (int e = 0; e < 4; ++e) v[e] = siluf_(g[e]) * uu[e] * wt;
                        const unsigned long long w = (unsigned long long)pk2(v[0], v[1]) | ((unsigned long long)pk2(v[2], v[3]) << 32);
                        __hip_atomic_store((unsigned long long*)(ACT + (size_t)(rb + sl) * EFF + f0 + bj * 64), w, RLX_AGENT); } } }
        asm volatile("s_waitcnt vmcnt(0)" ::: "memory");
        if ((threadIdx.x & 63) == 0) __hip_atomic_fetch_add(done + 16 * ((rb >> 8) + u.pm), 1u, RLX_AGENT);
    }
};
struct ProbMoe2 : ProbMoe {
    static constexpr bool PERM = true;
    __device__ __forceinline__ void ready(const U& u, bool me) const {
        if (me) { unsigned* p = done + 16 * ((rowbase(u.aux) >> 8) + u.pm); unsigned sp = 0;
            while (__hip_atomic_load(p, RLX_AGENT) < 32u) { __builtin_amdgcn_s_sleep(2); if (++sp > (1u << 20)) break; }
            __builtin_amdgcn_fence(__ATOMIC_ACQUIRE, "agent"); asm volatile("s_waitcnt vmcnt(0)" ::: "memory"); }
    }
    __device__ __forceinline__ bool next(int i, U& u) const {
        const int u1 = tab[97] >> 1;
        const int base = u1 / G, rem = u1 - base * G, tot = tab[97];
        int n_early = 2 * base * G; if (n_early > tot) n_early = tot;
        int L;
        if (c >= rem) { const int W = G - rem, first = c - rem; const int ce = (n_early > first) ? (n_early - first + W - 1) / W : 0;
            L = (i < ce) ? (i * W + first) : (n_early + (i - ce) * G + c); }
        else L = n_early + i * G + c;
        return decode(L, u);
    }
    __device__ __forceinline__ void bases(const U& u, const char*& a, const char*& b) const { a = (const char*)(ws + WS_ACT) + (size_t)(rowbase(u.aux) + u.pm * 256) * K * 2; b = (const char*)(ws + WS_WD_T) + ((size_t)u.aux * DM + u.pn * 256) * K * 2; }
    __device__ __forceinline__ void lane_offs(const U&, const int (&stR)[2], const int (&stC)[2], unsigned (&va)[2][2]) const { lane_offs_plain(stR, stC, va); }
    __device__ __forceinline__ void epi(f32x4 (&acc)[2][2][4][2], const U& u, int wr, int wc, int fr, int fq) const {
        const int* LIST = (const int*)(ws + WS_LIST); bf16_t* YS = (bf16_t*)(ws + WS_YS);
        const int n = count(u.aux);
        const int colw = u.pn * 256 + wc * 32 + 8 * fq;
        int slots[8];
#pragma unroll
        for (int ai = 0; ai < 2; ++ai)
#pragma unroll
            for (int m = 0; m < 4; ++m) { const int sl = u.pm * 256 + ai * 128 + wr * 64 + m * 16 + fr; slots[ai * 4 + m] = LIST[u.aux * M + (sl < n ? sl : 0)]; }
        __builtin_amdgcn_sched_barrier(0);
#pragma unroll
        for (int ai = 0; ai < 2; ++ai)
#pragma unroll
            for (int m = 0; m < 4; ++m) { const int sl = u.pm * 256 + ai * 128 + wr * 64 + m * 16 + fr;
                if (sl < n) { const int slot = slots[ai * 4 + m];
#pragma unroll
                    for (int bj = 0; bj < 2; ++bj) { const f32x4 v0 = acc[ai][bj][m][0], v1 = acc[ai][bj][m][1];
                        u32x4 w; w.x = pk2(v0[0], v0[1]); w.y = pk2(v0[2], v0[3]); w.z = pk2(v1[0], v1[1]); w.w = pk2(v1[2], v1[3]);
                        *(u32x4*)(YS + (size_t)slot * DM + colw + bj * 128) = w; } } }
    }
};

__device__ __forceinline__ void p11_final(Frame& F, float* dst) {
    const float* MOD = WSP(float, WS_MOD); const bf16_t* YS = WSP(bf16_t, WS_YS);
    const int gw = F.bid * NWAVES + F.wave, NGW = F.G * NWAVES, lane = F.lane;
    for (int m = gw; m < M; m += NGW) {
        const int b = m >> 12; const float* row = F.out + (size_t)m * DM; float* orow = dst + (size_t)m * DM; f32x4 v[8]; float s = 0.f;
#pragma unroll
        for (int j = 0; j < 8; ++j) { const int k = 4 * (lane + 64 * j); const f32x4 xv = *(const f32x4*)(row + k), gt = *(const f32x4*)(MOD + b * 12288 + 5 * DM + k);
            const u32x2 y0 = *(const u32x2*)(YS + (size_t)(2 * m) * DM + k), y1 = *(const u32x2*)(YS + (size_t)(2 * m + 1) * DM + k);
            f32x4 y; y.x = bf2f(y0.x & 0xffffu) + bf2f(y1.x & 0xffffu); y.y = bf2f(y0.x >> 16) + bf2f(y1.x >> 16); y.z = bf2f(y0.y & 0xffffu) + bf2f(y1.y & 0xffffu); y.w = bf2f(y0.y >> 16) + bf2f(y1.y >> 16);
            v[j] = xv + gt * y; s += (v[j].x * v[j].x + v[j].y * v[j].y) + (v[j].z * v[j].z + v[j].w * v[j].w); }
        f32x4 gf[8];
#pragma unroll
        for (int j = 0; j < 8; ++j) gf[j] = *(const f32x4*)(F.g_final + 4 * (lane + 64 * j));
        const float rs = 1.0f / sqrtf(wave_sum(s) * (1.0f / DM) + EPS);
#pragma unroll
        for (int j = 0; j < 8; ++j) { const int k = 4 * (lane + 64 * j); *(f32x4*)(orow + k) = v[j] * rs * gf[j]; }
    }
}

constexpr int NPHASE = 12;
struct Args { const void* in[21]; float* out; unsigned char* ws; int ph_lo, ph_hi; };
__global__ void __launch_bounds__(NTHREADS, 2) hybrid_block_fwd(Args args) {
    extern __shared__ __attribute__((aligned(16))) unsigned char lds_raw[];
    Frame F;
    F.lds = (LAS unsigned char*)lds_raw;
    F.tid = threadIdx.x; F.lane = F.tid & 63; F.wave = __builtin_amdgcn_readfirstlane(F.tid >> 6); F.G = gridDim.x; F.bid = blockIdx.x;
    F.ws = args.ws; F.ctl = (unsigned*)(args.ws + WS_CTL); F.out = args.out;
    F.x = (const float*)args.in[0]; F.c = (const float*)args.in[1]; F.positions = (const int*)args.in[2]; F.w_ada = (const float*)args.in[3]; F.b_ada = (const float*)args.in[4];
    F.g_norm1 = (const float*)args.in[5]; F.w_in = (const float*)args.in[6]; F.g_head = (const float*)args.in[7]; F.hglb = (const float*)args.in[8]; F.w_attn_up = (const float*)args.in[9];
    F.w_hgrn_up = (const float*)args.in[10]; F.w_out = (const float*)args.in[11]; F.g_norm2 = (const float*)args.in[12]; F.w_rg = (const float*)args.in[13]; F.b_rg = (const float*)args.in[14];
    F.w_re = (const float*)args.in[15]; F.b_re = (const float*)args.in[16]; F.w_eg = (const float*)args.in[17]; F.w_eu = (const float*)args.in[18]; F.w_ed = (const float*)args.in[19]; F.g_final = (const float*)args.in[20];
    volatile LAS unsigned* MISC = (volatile LAS unsigned*)(F.lds + MISC_OFF);
    for (int u = F.tid; u < (LDS_EXTRA - LDSCTL_OFF) / 4; u += NTHREADS) ((LAS unsigned*)(F.lds + LDSCTL_OFF))[u] = 0u;
    __syncthreads();
    const int lo = args.ph_lo, hi = args.ph_hi;
    XcdBarrier bar; bar.bar = F.ctl + CW_BAR; bar.x = 0; bar.st = nullptr;
    if (hi - lo > 1) bar = xcd_barrier_post(F.ctl + CW_BAR, MISC + 8);
#ifndef PHMASK
#define PHMASK 0xfff
#endif
#define IN(k) (((PHMASK >> (k)) & 1) && lo <= (k) && (k) < hi)
#define SEAM(k) do { if (IN(k) && IN((k) + 1)) xcd_barrier(bar); } while (0)
#ifndef REPMASK
#define REPMASK 0
#endif
#define RUN2(k, BODY) do { if (IN(k)) { BODY } if (((REPMASK >> (k)) & 1) && IN(k)) { xcd_barrier(bar); BODY } } while (0)
    RUN2(0, p0_prologue(F);); SEAM(0);
    RUN2(1, p1_norm1(F);); SEAM(1);
#define BODY2 { ProbWin P; P.K = DM; P.G = F.G; P.c = F.bid; P.A = (const char*)(F.ws + WS_XN); P.B = (const char*)(F.ws + WS_WIN_T); P.ws = F.ws; P.hglb = F.hglb; pg8::gemm_phase(F.lds, P); }
    RUN2(2, BODY2); SEAM(2);
    RUN2(3, p3_indexer(F); p3_hgrn_upd(F);); if ((REPMASK >> 20) & 1) { xcd_barrier(bar); p3_indexer(F); } if ((REPMASK >> 21) & 1) { xcd_barrier(bar); p3_hgrn_upd(F); } SEAM(3);
    RUN2(4, p4_select(F); p4_hgrn_scan(F);); if ((REPMASK >> 15) & 1) { xcd_barrier(bar); p4_select(F); } if ((REPMASK >> 16) & 1) { xcd_barrier(bar); p4_hgrn_scan(F); } SEAM(4);
    RUN2(5, p5_attention(F); p5_hgrn_out(F);); if ((REPMASK >> 13) & 1) { xcd_barrier(bar); p5_attention(F); } if ((REPMASK >> 14) & 1) { xcd_barrier(bar); p5_hgrn_out(F); } SEAM(5);
#define BODY6 { ProbMerge P; P.K = 1024; P.G = F.G; P.c = F.bid; P.ws = F.ws; pg8::gemm_phase(F.lds, P); }
    RUN2(6, BODY6); SEAM(6);
#define BODY7 { ProbOut P; P.K = DM; P.G = F.G; P.c = F.bid; P.ws = F.ws; P.x = F.x; P.out = F.out; pg8::gemm_phase(F.lds, P); }
    RUN2(7, BODY7); SEAM(7);
    if (IN(8)) { p8_norm2_route(F); if ((REPMASK >> 17) & 1) { xcd_barrier(bar); if (F.bid == 0 && F.tid < 32) __hip_atomic_store(F.ctl + CW_CNT + 16 * F.tid, 0u, RLX_AGENT); xcd_barrier(bar); p8_norm2_route(F); } p8_expert_weights(F); if ((REPMASK >> 12) & 1) { xcd_barrier(bar); p8_expert_weights(F); } } SEAM(8);
#define BODY9 { moe_table(F.lds, F.ctl + CW_CNT, 4); ProbMoe1 P; P.K = DM; P.G = F.G; P.c = F.bid; P.ws = F.ws; P.tab = (const LAS int*)(F.lds + MOE_TAB_OFF); P.nct = 4; P.done = F.ctl + CW_DONE; pg8::gemm_phase(F.lds, P); }
    if (IN(9)) BODY9;
#if MK_MULTI
    SEAM(9);
#endif
#define BODY10 { moe_table(F.lds, F.ctl + CW_CNT, 8); ProbMoe2 P; P.K = EFF; P.G = F.G; P.c = F.bid; P.ws = F.ws; P.tab = (const LAS int*)(F.lds + MOE_TAB_OFF); P.nct = 8; P.done = F.ctl + CW_DONE; pg8::gemm_phase(F.lds, P); }
    if (IN(10)) BODY10; SEAM(10);
    if (IN(11)) { if ((REPMASK >> 18) & 1) { p11_final(F, WSP(float, WS_UPDT)); xcd_barrier(bar); } p11_final(F, F.out); }
    if ((REPMASK >> 19) & 1) { xcd_barrier(bar); BODY2 }
#undef IN
#undef SEAM
}

extern "C" void kernel_launch(void* const* d_in, const int* in_sizes, int n_in, void* d_out, int out_size, void* d_ws, size_t ws_size, hipStream_t stream) {
    static int grid = 0;
    if (grid == 0) {
        if (n_in != 21 || in_sizes[0] != M * DM || out_size != M * DM || ws_size < WS_END) { fprintf(stderr, "kernel_launch: unexpected shapes/workspace (n_in %d, in0 %d, out %d, ws %zu)\n", n_in, n_in > 0 ? in_sizes[0] : -1, out_size, ws_size); grid = -1; return; }
        int dev = 0, cus = 0, per_cu = 0;
        if (hipGetDevice(&dev) != hipSuccess || hipDeviceGetAttribute(&cus, hipDeviceAttributeMultiprocessorCount, dev) != hipSuccess) { grid = -1; return; }
        if (hipFuncSetAttribute((const void*)hybrid_block_fwd, hipFuncAttributeMaxDynamicSharedMemorySize, LDS_BYTES) != hipSuccess) { fprintf(stderr, "kernel_launch: hipFuncSetAttribute failed\n"); grid = -1; return; }
        if (hipOccupancyMaxActiveBlocksPerMultiprocessor(&per_cu, (const void*)hybrid_block_fwd, NTHREADS, LDS_BYTES) != hipSuccess || per_cu < 1) fprintf(stderr, "kernel_launch: occupancy query reports %d\n", per_cu);
        (void)hipGetLastError();
        grid = cus;
    }
    if (grid < 0) return;
    (void)hipMemsetAsync((char*)d_ws + WS_CTL, 0, CTL_ZERO_BYTES, stream);
    Args a{};
    for (int i = 0; i < 21; ++i) a.in[i] = d_in[i];
    a.out = (float*)d_out; a.ws = (unsigned char*)d_ws;
#if MK_MULTI
    for (int p = 0; p < NPHASE; ++p) { a.ph_lo = p; a.ph_hi = p + 1; hipLaunchKernelGGL(hybrid_block_fwd, dim3(grid), dim3(NTHREADS), LDS_BYTES, stream, a); }
#else
    a.ph_lo = 0; a.ph_hi = NPHASE; hipLaunchKernelGGL(hybrid_block_fwd, dim3(grid), dim3(NTHREADS), LDS_BYTES, stream, a);
#endif
}
```

```cpp
#include <hip/hip_runtime.h>
#include <cstdio>
#include <cstdint>

#define REPMASK 0x0
#ifndef MK_MULTI
#define MK_MULTI 0
#endif

#define GAS __attribute__((address_space(1)))
#define LAS __attribute__((address_space(3)))
typedef unsigned short bf16_t;
typedef short bf16x8 __attribute__((ext_vector_type(8)));
typedef short s16x4 __attribute__((ext_vector_type(4)));
typedef short v4i16_t __attribute__((ext_vector_type(4)));
typedef float f32x4 __attribute__((ext_vector_type(4)));
typedef float f32x2 __attribute__((ext_vector_type(2)));
typedef float f32x16 __attribute__((ext_vector_type(16)));
typedef unsigned u32x4 __attribute__((ext_vector_type(4)));
typedef unsigned u32x2 __attribute__((ext_vector_type(2)));

constexpr int DM = 2048, NBATCH = 2, SEQ = 4096, M = NBATCH * SEQ;
constexpr int NLOG = 10312, NPHYS = 10240;
constexpr int NEXP = 32, EFF = 512;
constexpr float EPS = 1e-6f;
constexpr float ATT_SCALE_L2E = 0.08838834764831845f * 1.4426950408889634f;
constexpr float IDX_SCALE = 0.04419417382415922f;
constexpr int TOPK = 256;

constexpr size_t MiB = 1u << 20;
constexpr size_t WS_CTL = 0, CTL_ZERO_BYTES = 1 * MiB;
constexpr size_t WS_WIN_T = 1 * MiB, WS_WAU_T = 42 * MiB, WS_WHU_T = 46 * MiB, WS_WOUT_T = 50 * MiB;
constexpr size_t WS_XN = 58 * MiB, WS_MODP = 90 * MiB, WS_MOD = 92 * MiB, WS_TABA = 93 * MiB, WS_TABI = 97 * MiB, WS_MASK = 99 * MiB;
constexpr size_t WS_W40T = 104 * MiB;
constexpr size_t WS_DECAY = 103 * MiB, WS_LIST = 105 * MiB, WS_LISTW = 106 * MiB, WS_SPREVT = 107 * MiB, WS_YATT = 139 * MiB, WS_YHG = 155 * MiB, WS_UPDT = 171 * MiB;
constexpr size_t WS_AQ = 235 * MiB, WS_AK = 251 * MiB, WS_AVT = 255 * MiB, WS_IQ = 259 * MiB, WS_IK = 267 * MiB, WS_IW = 268 * MiB, WS_HQ = 269 * MiB, WS_LOGF = 285 * MiB,
                 WS_KF = 317 * MiB, WS_HI = 333 * MiB, WS_HOG = 349 * MiB, WS_GA = 365 * MiB, WS_GH = 397 * MiB;
constexpr size_t WS_WGU_T = 235 * MiB, WS_WD_T = 363 * MiB;
constexpr size_t WS_SCORES = 429 * MiB;
constexpr size_t WS_MERGED = 429 * MiB, WS_YS = 461 * MiB, WS_ACT = 557 * MiB;
constexpr size_t WS_END = 581 * MiB;
constexpr int CW_BAR = 4096, CW_CNT = 16384, CW_DONE = 32768;

constexpr int RING_BYTES = 139264, LDSCTL_OFF = RING_BYTES, MISC_OFF = LDSCTL_OFF + 320, LDS_EXTRA = 147456, LDS_BYTES = 163840;
constexpr int NWAVES = 8, NTHREADS = 512;

#define RLX_AGENT __ATOMIC_RELAXED, __HIP_MEMORY_SCOPE_AGENT
#define LDS_WAIT() asm volatile("s_waitcnt lgkmcnt(0)" ::: "memory")
#define VM_WAIT() asm volatile("s_waitcnt vmcnt(0)" ::: "memory")
__device__ __forceinline__ float bf2f(unsigned b) { return __uint_as_float(b << 16); }
__device__ __forceinline__ unsigned pk2(float lo, float hi) { unsigned r; asm("v_cvt_pk_bf16_f32 %0, %1, %2" : "=v"(r) : "v"(lo), "v"(hi)); return r; }
__device__ __forceinline__ float fexp(float x) { return __builtin_amdgcn_exp2f(x * 1.4426950408889634f); }
__device__ __forceinline__ float frcp(float x) { return __builtin_amdgcn_rcpf(x); }
__device__ __forceinline__ float sigmoidf_(float x) { return frcp(1.0f + fexp(-x)); }
__device__ __forceinline__ float siluf_(float x) { return x * sigmoidf_(x); }
__device__ __forceinline__ float wave_sum(float v) {
#pragma unroll
    for (int o = 1; o < 64; o <<= 1) v += __shfl_xor(v, o);
    return v;
}
__device__ __forceinline__ int wave_sum_i_dpp(int v) {
    v += __builtin_amdgcn_update_dpp(0, v, 0xB1, 0xF, 0xF, false);
    v += __builtin_amdgcn_update_dpp(0, v, 0x4E, 0xF, 0xF, false);
    v += __builtin_amdgcn_update_dpp(0, v, 0x124, 0xF, 0xF, false);
    v += __builtin_amdgcn_update_dpp(0, v, 0x128, 0xF, 0xF, false);
    return __builtin_amdgcn_readlane(v, 0) + __builtin_amdgcn_readlane(v, 16) + __builtin_amdgcn_readlane(v, 32) + __builtin_amdgcn_readlane(v, 48);
}
__device__ __forceinline__ int wave_sum_i(int v) {
#pragma unroll
    for (int o = 1; o < 64; o <<= 1) v += __shfl_xor(v, o);
    return v;
}

#define XB_TMO      128
#define XB_XCNT(j)  (256  + 64 * (j))
#define XB_XSUB(j)  (1280 + 64 * (j))
#define XB_XGEN(j)  (2304 + 64 * (j))
#define XB_TOP      3328
#define XB_TOPGEN   3392
#define XCD_BAR_WORDS 3456
#define XB_SPIN_CAP (1u << 18)
__device__ __forceinline__ unsigned xb_ld(unsigned* p)              { return __hip_atomic_load(p, __ATOMIC_RELAXED, __HIP_MEMORY_SCOPE_AGENT); }
__device__ __forceinline__ unsigned xb_add(unsigned* p, unsigned v) { return __hip_atomic_fetch_add(p, v, __ATOMIC_RELAXED, __HIP_MEMORY_SCOPE_AGENT); }
__device__ __forceinline__ unsigned xb_xcc_id() { return (unsigned)__builtin_amdgcn_s_getreg((3 << 11) | 20) & 0xFu; }
#define XB_SPIN(cond, bar) do { unsigned _sp = 0; while (cond) { __builtin_amdgcn_s_sleep(1); \
    if ((++_sp & 255u) == 0u) { if (xb_ld(&(bar)[XB_TMO])) break; if (_sp > XB_SPIN_CAP) { atomicAdd(&(bar)[XB_TMO], 1u); break; } } } } while (0)
struct XcdBarrier { unsigned* bar; unsigned x; volatile LAS unsigned* st; };
__device__ __forceinline__ XcdBarrier xcd_barrier_post(unsigned* bar, volatile LAS unsigned* st) {
    XcdBarrier b; b.bar = bar; b.x = xb_xcc_id(); b.st = st;
    if (threadIdx.x == 0) (void)xb_add(&bar[XB_XCNT(b.x)], 1u);
    return b;
}
__device__ __forceinline__ void xcd_barrier_complete(unsigned* bar, unsigned x, unsigned& nloc, unsigned& nx) {
    const unsigned G = gridDim.x * gridDim.y * gridDim.z;
    unsigned sum, cnt, mine, sp = 0u;
    for (;;) {
        sum = 0u; cnt = 0u; mine = 0u;
#pragma unroll
        for (unsigned j = 0; j < 16; ++j) { const unsigned c = xb_ld(&bar[XB_XCNT(j)]); sum += c; cnt += (c > 0u) ? 1u : 0u; mine = (j == x) ? c : mine; }
        if (sum == G) break;
        __builtin_amdgcn_s_sleep(1);
        if ((++sp & 255u) == 0u) { if (xb_ld(&bar[XB_TMO])) break; if (sp > XB_SPIN_CAP) { atomicAdd(&bar[XB_TMO], 1u); break; } }
    }
    nloc = mine > 0u ? mine : 1u; nx = cnt > 0u ? cnt : 1u;
}
__device__ __forceinline__ void xcd_barrier(const XcdBarrier& b) {
    asm volatile("s_waitcnt vmcnt(0)" ::: "memory");
    __syncthreads();
    if (threadIdx.x == 0) {
        unsigned* bar = b.bar;
        __builtin_amdgcn_s_waitcnt(0);
        unsigned nloc = b.st[0], nx = b.st[1];
        if (nloc == 0u) { xcd_barrier_complete(bar, b.x, nloc, nx); b.st[0] = nloc; b.st[1] = nx; }
        const unsigned old = xb_add(&bar[XB_XSUB(b.x)], 1u);
        const unsigned gen = old / nloc;
        if (old + 1u == (gen + 1u) * nloc) {
            __builtin_amdgcn_fence(__ATOMIC_RELEASE, "agent");
            asm volatile("s_waitcnt vmcnt(0)" ::: "memory");
            const unsigned og = xb_add(&bar[XB_TOP], 1u);
            const unsigned tg = og / nx;
            if (og + 1u == (tg + 1u) * nx) xb_add(&bar[XB_TOPGEN], 1u);
            else XB_SPIN(xb_ld(&bar[XB_TOPGEN]) == tg, bar);
            __builtin_amdgcn_fence(__ATOMIC_ACQUIRE, "agent");
            xb_add(&bar[XB_XGEN(b.x)], 1u);
            asm volatile("s_waitcnt vmcnt(0)" ::: "memory");
        } else {
            XB_SPIN(xb_ld(&bar[XB_XGEN(b.x)]) == gen, bar);
            __builtin_amdgcn_fence(__ATOMIC_ACQUIRE, "agent");
            asm volatile("s_waitcnt vmcnt(0)" ::: "memory");
        }
    }
    __syncthreads();
}

namespace pg8 {
constexpr int BM = 256, BK = 64, HALF = 128, HTB = HALF * BK * 2, NXCD = 8, WGM = 8;
__host__ __device__ __forceinline__ int lds_byte(int r, int c) { const int st = (r >> 4) * 2 + (c >> 5), rr = r & 15, cc = c & 31, ob = rr * 64 + cc * 2; return st * 1024 + (ob ^ (((ob >> 9) & 1) << 5)); }
__host__ __device__ __forceinline__ void stage_rc(int b, int& R, int& C) { const int st = b / 1024, sb = b % 1024, swz = sb ^ (((sb >> 9) & 1) << 5); R = (st >> 1) * 16 + swz / 64; C = (st & 1) * 32 + (swz % 64) / 2; }
__host__ __device__ __forceinline__ int perm32(int rho) { const int n = rho >> 4, i = rho & 15; return 8 * (i >> 2) + 4 * n + (i & 3); }

__device__ __forceinline__ bool static_tile(int L, int nM, int nN, int& pm, int& pn) {
    const int nwg = nM * nN; if (L >= nwg) return false;
    int wgid = L; { const int q = nwg / NXCD, r = nwg % NXCD, xcd = wgid % NXCD, off = wgid / NXCD; wgid = (xcd < r ? xcd * (q + 1) : r * (q + 1) + (xcd - r) * q) + off; }
    const int nig = WGM * nN, gid = wgid / nig, fm = gid * WGM, gsz = (nM - fm) < WGM ? (nM - fm) : WGM;
    pm = fm + ((wgid % nig) % gsz); pn = (wgid % nig) / gsz; return true;
}

template <class P>
__device__ __forceinline__ void gemm_phase(LAS unsigned char* lds, P& prob) {
    typedef typename P::U Unit;
    const int tid = threadIdx.x, wid = __builtin_amdgcn_readfirstlane(tid >> 6), lane = tid & 63, wr = wid >> 2, wc = wid & 3, fr = lane & 15, fq = lane >> 4;
    const int K = prob.K, nt = K / BK;
    unsigned voffB[2]; int stR[2], stC[2];
#pragma unroll
    for (int i = 0; i < 2; ++i) { int R, C; stage_rc(tid * 16 + i * 8192, R, C); stR[i] = R; stC[i] = C; const int Rb = P::PERM ? ((R & ~31) + perm32(R & 31)) : R; voffB[i] = (unsigned)(Rb * K + C) * 2u; }
    const size_t kstep = (size_t)(BK * 2);
    const size_t hstep = (size_t)HALF * K * 2;
    const unsigned ldsw = (unsigned)wid * 1024u;
    const int aoff = lds_byte(wr * 64 + fr, fq * 8), boff = lds_byte(wc * 32 + fr, fq * 8);
#define PG8_SA(b, h) (((b) * 2 + (h)) * HTB)
#define PG8_SB(b, h) ((4 + (b) * 2 + (h)) * HTB)
#define PG8_STAGE2(bufoff, gbase, o0, o1) do { \
        __builtin_amdgcn_global_load_lds((const unsigned*)((const char*)(gbase) + (o0)), (LAS unsigned*)(lds + (bufoff) + ldsw), 16, 0, 0); \
        __builtin_amdgcn_global_load_lds((const unsigned*)((const char*)(gbase) + (o1)), (LAS unsigned*)(lds + (bufoff) + ldsw + 8192), 16, 0, 0); } while (0)
#define PG8_STAGE_B(bufoff, gbase, h) PG8_STAGE2(bufoff, (gbase) + (h) * hstep, voffB[0], voffB[1])
#define PG8_LDA(dst, b, h) do { _Pragma("unroll") for (int m = 0; m < 4; ++m) _Pragma("unroll") for (int k = 0; k < 2; ++k) dst[m][k] = *(const LAS bf16x8*)(lds + PG8_SA(b, h) + aoff + m * 2048 + k * 1024); } while (0)
#define PG8_LDB(dst, b, h) do { _Pragma("unroll") for (int n = 0; n < 2; ++n) _Pragma("unroll") for (int k = 0; k < 2; ++k) dst[n][k] = *(const LAS bf16x8*)(lds + PG8_SB(b, h) + boff + n * 2048 + k * 1024); } while (0)
#define PG8_MMA(ai, bj, At, Bt) do { __builtin_amdgcn_s_setprio(1); _Pragma("unroll") for (int m = 0; m < 4; ++m) _Pragma("unroll") for (int n = 0; n < 2; ++n) _Pragma("unroll") for (int k = 0; k < 2; ++k) \
        acc[ai][bj][m][n] = __builtin_amdgcn_mfma_f32_16x16x32_bf16(Bt[n][k], At[m][k], acc[ai][bj][m][n], 0, 0, 0); __builtin_amdgcn_s_setprio(0); } while (0)
#define PG8_WAIT_V(n) asm volatile("s_waitcnt vmcnt(" #n ")" ::: "memory")
#define PG8_WAIT_L(n) asm volatile("s_waitcnt lgkmcnt(" #n ")" ::: "memory")
#define PG8_BAR __builtin_amdgcn_s_barrier()
#define PG8_SCHED __builtin_amdgcn_sched_barrier(0)
    Unit cur, nxt; int ui = 0;
    if (!prob.next(0, cur)) return;
    f32x4 acc[2][2][4][2];
#pragma unroll
    for (int a = 0; a < 2; ++a)
#pragma unroll
        for (int b = 0; b < 2; ++b)
#pragma unroll
            for (int m = 0; m < 4; ++m)
#pragma unroll
                for (int n = 0; n < 2; ++n) acc[a][b][m][n] = (f32x4){0.f, 0.f, 0.f, 0.f};
    bf16x8 At[4][2], B0[2][2], B1[2][2];
    const char* cA; const char* cB; unsigned vc[2][2], vn[2][2];
    prob.ready(cur, true);
    prob.bases(cur, cA, cB); prob.lane_offs(cur, stR, stC, vc);
    PG8_STAGE_B(PG8_SB(0, 0), cB, 0); PG8_STAGE_B(PG8_SB(0, 1), cB, 1); PG8_STAGE2(PG8_SA(0, 0), cA, vc[0][0], vc[0][1]); PG8_STAGE2(PG8_SA(0, 1), cA, vc[1][0], vc[1][1]);
    if (wr == 1) PG8_BAR;
    PG8_WAIT_V(2); PG8_BAR;
    PG8_STAGE_B(PG8_SB(1, 0), cB + kstep, 0); PG8_STAGE2(PG8_SA(1, 0), cA + kstep, vc[0][0], vc[0][1]); PG8_STAGE_B(PG8_SB(1, 1), cB + kstep, 1);
    PG8_WAIT_V(6); PG8_BAR;
    for (;;) {
        const bool has_next = prob.next(ui + 1, nxt);
        const char* nA = cA; const char* nB = cB;
#pragma unroll
        for (int h = 0; h < 2; ++h) { vn[h][0] = vc[h][0]; vn[h][1] = vc[h][1]; }
        if (has_next) { prob.bases(nxt, nA, nB); prob.lane_offs(nxt, stR, stC, vn); }
        for (int t = 0; t < nt; t += 2) {
            const bool last = (t == nt - 2);
            if (last && has_next) prob.ready(nxt, wid == 0);
            const char* a1 = cA + (size_t)(t + 1) * kstep;
            const char* a2 = last ? nA : cA + (size_t)(t + 2) * kstep; const char* b2 = last ? nB : cB + (size_t)(t + 2) * kstep;
            const char* a3 = a2 + kstep; const char* b3 = b2 + kstep;
            const unsigned v00 = last ? vn[0][0] : vc[0][0], v01 = last ? vn[0][1] : vc[0][1], v10 = last ? vn[1][0] : vc[1][0], v11 = last ? vn[1][1] : vc[1][1];
            PG8_LDB(B0, 0, 0); PG8_LDB(B1, 0, 1); PG8_SCHED; PG8_LDA(At, 0, 0); PG8_STAGE2(PG8_SA(1, 1), a1, vc[1][0], vc[1][1]);
            PG8_WAIT_V(8); PG8_WAIT_L(0); PG8_BAR; PG8_MMA(0, 0, At, B0); PG8_MMA(0, 1, At, B1); PG8_BAR; PG8_SCHED;
            PG8_LDA(At, 0, 1); PG8_STAGE_B(PG8_SB(0, 0), b2, 0); PG8_STAGE_B(PG8_SB(0, 1), b2, 1); PG8_STAGE2(PG8_SA(0, 0), a2, v00, v01);
            PG8_WAIT_V(8); PG8_WAIT_L(0); PG8_BAR; PG8_MMA(1, 0, At, B0); PG8_MMA(1, 1, At, B1); PG8_BAR; PG8_SCHED;
            PG8_LDB(B0, 1, 0); PG8_LDB(B1, 1, 1); PG8_SCHED; PG8_LDA(At, 1, 0); PG8_STAGE2(PG8_SA(0, 1), a2, v10, v11);
            PG8_WAIT_V(8); PG8_WAIT_L(0); PG8_BAR; PG8_MMA(0, 0, At, B0); PG8_MMA(0, 1, At, B1); PG8_BAR; PG8_SCHED;
            PG8_LDA(At, 1, 1); PG8_STAGE_B(PG8_SB(1, 0), b3, 0); PG8_STAGE_B(PG8_SB(1, 1), b3, 1); PG8_STAGE2(PG8_SA(1, 0), a3, v00, v01);
            PG8_WAIT_V(8); PG8_WAIT_L(0); PG8_BAR; PG8_MMA(1, 0, At, B0); PG8_MMA(1, 1, At, B1); PG8_BAR; PG8_SCHED;
        }
        if (wr == 0) PG8_BAR;
        prob.epi(acc, cur, wr, wc, fr, fq);
        if (!has_next) break;
        if (!prob.keep(cur)) {
#pragma unroll
            for (int a = 0; a < 2; ++a)
#pragma unroll
                for (int b = 0; b < 2; ++b)
#pragma unroll
                    for (int m = 0; m < 4; ++m)
#pragma unroll
                        for (int n = 0; n < 2; ++n) acc[a][b][m][n] = (f32x4){0.f, 0.f, 0.f, 0.f};
        }
        cur = nxt; cA = nA; cB = nB; ++ui;
#pragma unroll
        for (int h = 0; h < 2; ++h) { vc[h][0] = vn[h][0]; vc[h][1] = vn[h][1]; }
        if (wr == 1) PG8_BAR;
    }
    PG8_WAIT_V(0);
    PG8_BAR;
#undef PG8_SA
#undef PG8_SB
#undef PG8_STAGE2
#undef PG8_STAGE_B
#undef PG8_LDA
#undef PG8_LDB
#undef PG8_MMA
#undef PG8_WAIT_V
#undef PG8_WAIT_L
#undef PG8_BAR
#undef PG8_SCHED
}
}

struct Frame {
    LAS unsigned char* lds;
    unsigned* ctl;
    unsigned char* ws;
    int tid, lane, wave, G, bid;
    const float *x, *c, *w_ada, *b_ada, *g_norm1, *w_in, *g_head, *hglb, *w_attn_up, *w_hgrn_up, *w_out, *g_norm2, *w_rg, *b_rg, *w_re, *b_re, *w_eg, *w_eu, *w_ed, *g_final;
    const int* positions;
    float* out;
};
#define WSP(T, off) ((T*)(F.ws + (off)))

__device__ __forceinline__ int win_phys(int n) {
    if (n < 1280) { const int head = n >> 7, j = n & 127; return head * 128 + (j < 64 ? 2 * j : 2 * (j - 64) + 1); }
    if (n < 1536) return n;
    if (n < 2048) { const int q = n - 1536, head = q >> 6, j = q & 63; return 1536 + head * 64 + (j < 32 ? 2 * j : 2 * (j - 32) + 1); }
    if (n < 2120) return -1;
    return n - 2120 + 2048;
}
struct RmWin { __device__ __forceinline__ int operator()(int n) const { return win_phys(n); } };
struct RmId  { __device__ __forceinline__ int operator()(int n) const { return n; } };
struct RmGate { int up; __device__ __forceinline__ int operator()(int f) const { return 8 * (f >> 2) + 4 * up + (f & 3); } };
template <class RM>
__device__ __forceinline__ void transpose_item(const float* W, int K, int N, bf16_t* WT, LAS float* scr, int item, int lane, RM rm) {
    const int nblk = (N + 31) / 32, kb = item / nblk, nb = item % nblk, k0 = 64 * kb, n0 = 32 * nb;
    const int nn = n0 + (lane & 31);
    float tv[32];
#pragma unroll
    for (int i = 0; i < 32; ++i) { const int kk = 2 * i + (lane >> 5); tv[i] = (nn < N) ? W[(size_t)(k0 + kk) * N + nn] : 0.f; }
#pragma unroll
    for (int i = 0; i < 32; ++i) { const int kk = 2 * i + (lane >> 5); scr[kk * 33 + (lane & 31)] = tv[i]; }
    LDS_WAIT(); asm volatile("" ::: "memory");
    const int c = lane & 7;
#pragma unroll
    for (int j = 0; j < 4; ++j) { const int n = (lane >> 3) + 8 * j; const LAS float* s = scr + (8 * c) * 33 + n;
        u32x4 o; o.x = pk2(s[0 * 33], s[1 * 33]); o.y = pk2(s[2 * 33], s[3 * 33]); o.z = pk2(s[4 * 33], s[5 * 33]); o.w = pk2(s[6 * 33], s[7 * 33]);
        if (n0 + n < N) { const int rr = rm(n0 + n); if (rr >= 0) *(u32x4*)(WT + (size_t)rr * K + k0 + 8 * c) = o; } }
    LDS_WAIT(); asm volatile("" ::: "memory");
}

struct TDesc { const float* W; bf16_t* WT; int K, N, kind, item; };
__device__ __forceinline__ int td_row(int kind, int n) { return kind == 0 ? n : kind == 1 ? win_phys(n) : (8 * (n >> 2) + 4 * (kind - 2) + (n & 3)); }
__device__ __forceinline__ void td_load(const TDesc& d, int lane, float (&tv)[32]) {
    const int nblk = (d.N + 31) / 32, kb = d.item / nblk, nb = d.item % nblk, k0 = 64 * kb, n0 = 32 * nb;
    int nn = n0 + (lane & 31); nn = nn < d.N ? nn : d.N - 1;
    const float* p = d.W + (size_t)(k0 + (lane >> 5)) * d.N + nn;
#pragma unroll
    for (int i = 0; i < 32; ++i) tv[i] = p[(size_t)(2 * i) * d.N];
}
__device__ __forceinline__ void td_lds(const float (&tv)[32], int lane, LAS float* scr) {
#pragma unroll
    for (int i = 0; i < 32; ++i) { const int kk = 2 * i + (lane >> 5); scr[kk * 33 + (lane & 31)] = tv[i]; }
}
__device__ __forceinline__ void td_store(const TDesc& d, int lane, LAS float* scr) {
    const int nblk = (d.N + 31) / 32, kb = d.item / nblk, nb = d.item % nblk, k0 = 64 * kb, n0 = 32 * nb;
    const int c = lane & 7;
#pragma unroll
    for (int j = 0; j < 4; ++j) { const int n = (lane >> 3) + 8 * j; const LAS float* sp = scr + (8 * c) * 33 + n;
        u32x4 o; o.x = pk2(sp[0 * 33], sp[1 * 33]); o.y = pk2(sp[2 * 33], sp[3 * 33]); o.z = pk2(sp[4 * 33], sp[5 * 33]); o.w = pk2(sp[6 * 33], sp[7 * 33]);
        if (n0 + n < d.N) { const int rr = td_row(d.kind, n0 + n); if (rr >= 0) *(u32x4*)(d.WT + (size_t)rr * d.K + k0 + 8 * c) = o; } }
}
#define TD_STREAM(it0_, stride_, total_, DESC, lane_, scr_) do { float tv_[32]; TDesc dc_, dn_; int it_ = (it0_); \
    if (it_ < (total_)) { DESC(it_, dc_); td_load(dc_, (lane_), tv_); } \
    for (; it_ < (total_); it_ += (stride_)) { td_lds(tv_, (lane_), (scr_)); __builtin_amdgcn_sched_barrier(0); \
        const bool hn_ = it_ + (stride_) < (total_); if (hn_) { DESC(it_ + (stride_), dn_); td_load(dn_, (lane_), tv_); } \
        LDS_WAIT(); asm volatile("" ::: "memory"); td_store(dc_, (lane_), (scr_)); LDS_WAIT(); asm volatile("" ::: "memory"); if (hn_) dc_ = dn_; } } while (0)

__device__ __forceinline__ void p0_prologue(Frame& F) {
    const int gw = F.bid * NWAVES + F.wave, NGW = F.G * NWAVES;
    {
        LAS float* red = (LAS float*)F.lds;
        float* MODP = WSP(float, WS_MODP);
        for (int task = F.bid; task < 48 * 16; task += F.G) {
            const int cg = task % 48, ks = task / 48;
            f32x4 a0 = {0.f, 0.f, 0.f, 0.f}, a1 = {0.f, 0.f, 0.f, 0.f};
            const int kb = ks * 128 + F.wave * 16;
#pragma unroll 16
            for (int i = 0; i < 16; ++i) { const int k = kb + i; const f32x4 wv = *(const f32x4*)(F.w_ada + (size_t)k * 12288 + cg * 256 + 4 * F.lane);
                const float s0 = siluf_(F.c[k]), s1 = siluf_(F.c[DM + k]); a0 += wv * s0; a1 += wv * s1; }
            *(LAS f32x4*)(red + (F.wave * 2 + 0) * 256 + 4 * F.lane) = a0; *(LAS f32x4*)(red + (F.wave * 2 + 1) * 256 + 4 * F.lane) = a1;
            __syncthreads();
            { const int b = F.tid >> 8, col = F.tid & 255; float s = 0.f;
#pragma unroll
              for (int w = 0; w < 8; ++w) s += red[(w * 2 + b) * 256 + col];
              MODP[((size_t)ks * 2 + b) * 12288 + cg * 256 + col] = s; }
            __syncthreads();
        }
    }
    {
        LAS float* scr = (LAS float*)(F.lds + F.wave * 16384);
        constexpr int I_IN = 32 * 323, I_AU = 16 * 64, I_HU = 16 * 64, I_OUT = 32 * 64;
        constexpr int NITEMS = I_IN + I_AU + I_HU + I_OUT;
#define P0_DESC(it, d) do { int r_ = (it); \
            if (r_ < I_IN) { d.W = F.w_in; d.K = DM; d.N = NLOG; d.WT = WSP(bf16_t, WS_WIN_T); d.kind = 1; d.item = r_; } \
            else if ((r_ -= I_IN) < I_AU) { d.W = F.w_attn_up; d.K = 1024; d.N = DM; d.WT = WSP(bf16_t, WS_WAU_T); d.kind = 0; d.item = r_; } \
            else if ((r_ -= I_AU) < I_HU) { d.W = F.w_hgrn_up; d.K = 1024; d.N = DM; d.WT = WSP(bf16_t, WS_WHU_T); d.kind = 0; d.item = r_; } \
            else { r_ -= I_HU; d.W = F.w_out; d.K = DM; d.N = DM; d.WT = WSP(bf16_t, WS_WOUT_T); d.kind = 0; d.item = r_; } } while (0)
        TD_STREAM(gw, NGW, NITEMS, P0_DESC, F.lane, scr);
#undef P0_DESC
        { bf16_t* W40 = WSP(bf16_t, WS_W40T); const int gt = F.bid * NTHREADS + F.tid, NGT = F.G * NTHREADS;
          for (int e = gt; e < 96 * 256; e += NGT) { const int n = e >> 8, k0 = (e & 255) * 8; u32x4 o = {0u, 0u, 0u, 0u};
              if (n < 72) { const int col = (n < 64) ? (2048 + (n >> 1) + 32 * (n & 1)) : (2112 + (n - 64)); const float* p = F.w_in + (size_t)k0 * NLOG + col;
                  o.x = pk2(p[0], p[NLOG]); o.y = pk2(p[2 * (size_t)NLOG], p[3 * (size_t)NLOG]); o.z = pk2(p[4 * (size_t)NLOG], p[5 * (size_t)NLOG]); o.w = pk2(p[6 * (size_t)NLOG], p[7 * (size_t)NLOG]); }
              *(u32x4*)(W40 + (size_t)n * DM + k0) = o; } }
    }
    {
        f32x2* TA = WSP(f32x2, WS_TABA); f32x2* TI = WSP(f32x2, WS_TABI);
        const int gt = F.bid * NTHREADS + F.tid, NGT = F.G * NTHREADS;
        for (int e = gt; e < M * 96; e += NGT) {
            const int m = e / 96, r = e % 96; const float pos = (float)F.positions[m];
            float inv; if (r < 64) inv = powf(10000.0f, -(float)(2 * r) / 128.0f); else inv = powf(10000.0f, -(float)(2 * (r - 64)) / 64.0f);
            const float ang = pos * inv; float sn, cs; sincosf(ang, &sn, &cs);
            if (r < 64) TA[(size_t)m * 64 + r] = (f32x2){cs, sn}; else TI[(size_t)m * 32 + (r - 64)] = (f32x2){cs, sn};
        }
    }
}

__device__ __forceinline__ float row_rstd(const float* xrow, int lane, f32x4 (&v)[8]) {
    float s = 0.f;
#pragma unroll
    for (int j = 0; j < 8; ++j) { v[j] = ((const f32x4*)xrow)[lane + 64 * j]; s += (v[j].x * v[j].x + v[j].y * v[j].y) + (v[j].z * v[j].z + v[j].w * v[j].w); }
    return 1.0f / sqrtf(wave_sum(s) * (1.0f / DM) + EPS);
}

__device__ __forceinline__ f32x16 mfma32(bf16x8 a, bf16x8 b, f32x16 c) { return __builtin_amdgcn_mfma_f32_32x32x16_bf16(a, b, c, 0, 0, 0); }
__device__ __forceinline__ int crow(int r, int hi) { return (r & 3) + 8 * (r >> 2) + 4 * hi; }
__device__ __forceinline__ void p1_norm1(Frame& F) {
    LAS float* CA = (LAS float*)(F.lds + LDS_EXTRA); LAS float* CB = CA + DM;
    LAS unsigned char* HB = F.lds;
    const float* MODP = WSP(float, WS_MODP); float* MOD = WSP(float, WS_MOD);
    const int lane = F.lane, r32 = lane & 31, hi = lane >> 5;
    for (int idx = F.bid * NTHREADS + F.tid; idx < 2 * 12288; idx += F.G * NTHREADS) { const int b = idx / 12288, j = idx % 12288; float s = F.b_ada[j]; float pv[16];
#pragma unroll
        for (int ks = 0; ks < 16; ++ks) pv[ks] = MODP[((size_t)ks * 2 + b) * 12288 + j];
        __builtin_amdgcn_sched_barrier(0);
#pragma unroll
        for (int ks = 0; ks < 16; ++ks) s += pv[ks];
        MOD[idx] = s; }
    for (int rb = F.bid; rb < M / 32; rb += F.G) {
        const int b = (rb * 32) / SEQ;
        __syncthreads();
#pragma unroll
        for (int kk = 0; kk < DM / NTHREADS; ++kk) { __builtin_amdgcn_sched_barrier(0); const int k = F.tid + kk * NTHREADS; float sh = F.b_ada[k], sc = F.b_ada[DM + k]; const float gn = F.g_norm1[k]; float p0[16], p1[16];
#pragma unroll
            for (int ks = 0; ks < 16; ++ks) { p0[ks] = MODP[((size_t)ks * 2 + b) * 12288 + k]; p1[ks] = MODP[((size_t)ks * 2 + b) * 12288 + DM + k]; }
            __builtin_amdgcn_sched_barrier(0);
#pragma unroll
            for (int ks = 0; ks < 16; ++ks) { sh += p0[ks]; sc += p1[ks]; }
            CA[k] = gn * (1.0f + sc); CB[k] = sh; }
        __syncthreads();
        bf16_t* XN = WSP(bf16_t, WS_XN);
#pragma unroll 1
        for (int r = 0; r < 4; ++r) { const int rl = F.wave * 4 + r, m = rb * 32 + rl; f32x4 v[8]; const float rs = row_rstd(F.x + (size_t)m * DM, lane, v);
#pragma unroll
            for (int j = 0; j < 8; ++j) { const int k = 4 * (lane + 64 * j); const f32x4 a = *(const LAS f32x4*)(CA + k), bb = *(const LAS f32x4*)(CB + k);
                const f32x4 h = v[j] * rs * a + bb; u32x2 o; o.x = pk2(h.x, h.y); o.y = pk2(h.z, h.w); *(u32x2*)(XN + (size_t)m * DM + k) = o; *(LAS u32x2*)(HB + rl * 4112 + k * 2) = o; } }
        __syncthreads();
        f32x16 acc[3]; acc[0] = f32x16{}; acc[1] = f32x16{}; acc[2] = f32x16{};
        { const bf16_t* W40 = WSP(bf16_t, WS_W40T) + (size_t)r32 * DM + 256 * F.wave + 8 * hi;
#pragma unroll
          for (int kb = 0; kb < 8; ++kb) { bf16x8 bq[2][3];
#pragma unroll
              for (int ks = 0; ks < 2; ++ks)
#pragma unroll
                  for (int nt = 0; nt < 3; ++nt) bq[ks][nt] = *(const bf16x8*)(W40 + (size_t)nt * 32 * DM + 16 * (2 * kb + ks));
              __builtin_amdgcn_sched_barrier(0);
#pragma unroll
              for (int ks = 0; ks < 2; ++ks) { const bf16x8 a = *(const LAS bf16x8*)(HB + r32 * 4112 + (256 * F.wave + 16 * (2 * kb + ks) + 8 * hi) * 2);
#pragma unroll
                  for (int nt = 0; nt < 3; ++nt) acc[nt] = mfma32(a, bq[ks][nt], acc[nt]); }
              __builtin_amdgcn_sched_barrier(0); } }
        __syncthreads();
        LAS float* PS = (LAS float*)HB;
#pragma unroll
        for (int nt = 0; nt < 3; ++nt)
#pragma unroll
            for (int r = 0; r < 16; ++r) PS[(F.wave * 96 + nt * 32 + r32) * 33 + crow(r, hi)] = acc[nt][r];
        __syncthreads();
        { bf16_t* IK = WSP(bf16_t, WS_IK); float* IW = WSP(float, WS_IW); const f32x2* TI = WSP(f32x2, WS_TABI);
          int tv = F.tid; asm volatile("" : "+v"(tv));
#pragma unroll
          for (int j = 0; j < 2; ++j) { const int idx = tv + 512 * j, row = idx >> 5, i = idx & 31; float x1 = 0.f, x2 = 0.f;
#pragma unroll
              for (int w = 0; w < 8; ++w) { x1 += PS[(w * 96 + 2 * i) * 33 + row]; x2 += PS[(w * 96 + 2 * i + 1) * 33 + row]; }
              const int m = rb * 32 + row; const f32x2 cs = TI[(size_t)m * 32 + i];
              *(unsigned*)(IK + (size_t)m * 64 + 2 * i) = pk2(x1 * cs.x - x2 * cs.y, x2 * cs.x + x1 * cs.y); }
          if (F.tid < 256) { const int row = F.tid >> 3, hh = F.tid & 7; float v = 0.f;
#pragma unroll
              for (int w = 0; w < 8; ++w) v += PS[(w * 96 + 64 + hh) * 33 + row];
              IW[(size_t)(rb * 32 + row) * 8 + hh] = v * IDX_SCALE; } }
    }
}

struct UnitT { int pm, pn, aux; };
struct ProbBase {
    typedef UnitT U;
    int K, G, c;
    __device__ __forceinline__ void lane_offs_plain(const int (&stR)[2], const int (&stC)[2], unsigned (&va)[2][2]) const {
#pragma unroll
        for (int h = 0; h < 2; ++h)
#pragma unroll
            for (int i = 0; i < 2; ++i) va[h][i] = (unsigned)((h * 128 + stR[i]) * K + stC[i]) * 2u;
    }
    __device__ __forceinline__ bool keep(const U&) const { return false; }
    __device__ __forceinline__ void ready(const U&, bool) const {}
};

struct ProbWin : ProbBase {
    static constexpr bool PERM = true;
    const char* A; const char* B; unsigned char* ws; const float* hglb;
    __device__ __forceinline__ bool next(int i, U& u) const { u.aux = 0; return pg8::static_tile(i * G + c, M / 256, NPHYS / 256, u.pm, u.pn); }
    __device__ __forceinline__ void bases(const U& u, const char*& a, const char*& b) const { a = A + (size_t)u.pm * 256 * K * 2; b = B + (size_t)u.pn * 256 * K * 2; }
    __device__ __forceinline__ void lane_offs(const U&, const int (&stR)[2], const int (&stC)[2], unsigned (&va)[2][2]) const { lane_offs_plain(stR, stC, va); }
    __device__ __forceinline__ void epi(f32x4 (&acc)[2][2][4][2], const U& u, int wr, int wc, int fr, int fq) const {
        const int pn = u.pn, row0 = u.pm * 256 + wr * 64 + fr, colw = wc * 32 + 8 * fq;
        if (pn <= 4 || pn == 6 || pn == 7 || pn == 40) {
            const bool d128 = (pn <= 4);
            const float* tab = d128 ? (const float*)(ws + WS_TABA) : (const float*)(ws + WS_TABI);
            const int tp = d128 ? 128 : 64;
            const int i0 = d128 ? (colw >> 1) : (((wc & 1) * 32 + 8 * fq) >> 1);
            bf16_t* O; int pitch, cb; float sc = 1.f;
            if (pn < 4) { O = (bf16_t*)(ws + WS_AQ); pitch = 1024; cb = pn * 256; sc = ATT_SCALE_L2E; }
            else if (pn == 4) { O = (bf16_t*)(ws + WS_AK); pitch = 256; cb = 0; }
            else if (pn < 8) { O = (bf16_t*)(ws + WS_IQ); pitch = 512; cb = (pn - 6) * 256; }
            else { O = (bf16_t*)(ws + WS_IK); pitch = 64; cb = 0; }
            f32x4 tt0[8], tt1[8];
#pragma unroll
            for (int ai = 0; ai < 2; ++ai)
#pragma unroll
                for (int m = 0; m < 4; ++m) { const int row = row0 + ai * 128 + m * 16; tt0[ai * 4 + m] = *(const f32x4*)(tab + (size_t)row * tp + 2 * i0); tt1[ai * 4 + m] = *(const f32x4*)(tab + (size_t)row * tp + 2 * i0 + 4); }
            __builtin_amdgcn_sched_barrier(0);
#pragma unroll
            for (int ai = 0; ai < 2; ++ai)
#pragma unroll
                for (int m = 0; m < 4; ++m) { const int row = row0 + ai * 128 + m * 16;
                    const f32x4 t0 = tt0[ai * 4 + m], t1 = tt1[ai * 4 + m];
#pragma unroll
                    for (int bj = 0; bj < 2; ++bj) {
                        if (pn == 40 && (bj == 1 || wc >= 2)) {
                            if (bj == 0 && wc == 2 && fq == 0) { float* IW = (float*)(ws + WS_IW);
                                *(f32x4*)(IW + (size_t)row * 8) = acc[ai][0][m][0] * IDX_SCALE; *(f32x4*)(IW + (size_t)row * 8 + 4) = acc[ai][0][m][1] * IDX_SCALE; }
                            continue; }
                        const f32x4 v0 = acc[ai][bj][m][0], v1 = acc[ai][bj][m][1];
                        const float o0 = v0[0] * t0[0] - v0[1] * t0[1], o1 = v0[1] * t0[0] + v0[0] * t0[1], o2 = v0[2] * t0[2] - v0[3] * t0[3], o3 = v0[3] * t0[2] + v0[2] * t0[3];
                        const float o4 = v1[0] * t1[0] - v1[1] * t1[1], o5 = v1[1] * t1[0] + v1[0] * t1[1], o6 = v1[2] * t1[2] - v1[3] * t1[3], o7 = v1[3] * t1[2] + v1[2] * t1[3];
                        u32x4 w; w.x = pk2(o0 * sc, o1 * sc); w.y = pk2(o2 * sc, o3 * sc); w.z = pk2(o4 * sc, o5 * sc); w.w = pk2(o6 * sc, o7 * sc);
                        *(u32x4*)(O + (size_t)row * pitch + cb + bj * 128 + colw) = w; } }
        } else if (pn == 5) {
            bf16_t* O = (bf16_t*)(ws + WS_AVT);
#pragma unroll
            for (int ai = 0; ai < 2; ++ai)
#pragma unroll
                for (int m = 0; m < 4; ++m) { const int row = row0 + ai * 128 + m * 16, b = row >> 12, s = row & 4095;
#pragma unroll
                    for (int bj = 0; bj < 2; ++bj)
#pragma unroll
                        for (int n = 0; n < 2; ++n)
#pragma unroll
                            for (int e = 0; e < 4; ++e) { const int d = colw + 4 * n + e; O[((size_t)((b * 2 + bj) * 128 + d)) * SEQ + s] = (bf16_t)(pk2(acc[ai][bj][m][n][e], 0.f) & 0xffffu); } }
        } else if (pn >= 12 && pn < 16) {
            float* LF = (float*)(ws + WS_LOGF); bf16_t* KFo = (bf16_t*)(ws + WS_KF);
            const int cb = (pn - 12) * 256;
            f32x4 lb[2][2];
#pragma unroll
            for (int bj = 0; bj < 2; ++bj)
#pragma unroll
                for (int n = 0; n < 2; ++n) { const int cc = cb + bj * 128 + colw + 4 * n; const f32x4 a0 = *(const f32x4*)(hglb + cc), a1 = *(const f32x4*)(hglb + 1024 + cc);
#pragma unroll
                    for (int e = 0; e < 4; ++e) lb[bj][n][e] = frcp(1.0f + fexp(a1[e] - a0[e])); }
#pragma unroll
            for (int ai = 0; ai < 2; ++ai)
#pragma unroll
                for (int m = 0; m < 4; ++m) { const int row = row0 + ai * 128 + m * 16;
#pragma unroll
                    for (int bj = 0; bj < 2; ++bj) { f32x4 lf[2], kf[2];
#pragma unroll
                        for (int n = 0; n < 2; ++n)
#pragma unroll
                            for (int e = 0; e < 4; ++e) { float xx = acc[ai][bj][m][n][e]; xx = fminf(fmaxf(xx, -30.f), 30.f); const float ee = fexp(-xx), sg = frcp(1.0f + ee), sgn = ee * sg; const float l = lb[bj][n][e];
                                const float f = l + (1.0f - l) * sg; lf[n][e] = __logf(f); kf[n][e] = (1.0f - l) * sgn; }
                        const size_t off = (size_t)row * 1024 + cb + bj * 128 + colw;
                        *(f32x4*)(LF + off) = lf[0]; *(f32x4*)(LF + off + 4) = lf[1];
                        u32x4 w; w.x = pk2(kf[0][0], kf[0][1]); w.y = pk2(kf[0][2], kf[0][3]); w.z = pk2(kf[1][0], kf[1][1]); w.w = pk2(kf[1][2], kf[1][3]);
                        *(u32x4*)(KFo + off) = w; } }
        } else {
            bf16_t* O; int pitch, cb, act;
            if (pn < 12) { O = (bf16_t*)(ws + WS_HQ); pitch = 1024; cb = (pn - 8) * 256; act = 1; }
            else if (pn < 20) { O = (bf16_t*)(ws + WS_HI); pitch = 1024; cb = (pn - 16) * 256; act = 0; }
            else if (pn < 24) { O = (bf16_t*)(ws + WS_HOG); pitch = 1024; cb = (pn - 20) * 256; act = 1; }
            else if (pn < 32) { O = (bf16_t*)(ws + WS_GA); pitch = 2048; cb = (pn - 24) * 256; act = 2; }
            else { O = (bf16_t*)(ws + WS_GH); pitch = 2048; cb = (pn - 32) * 256; act = 2; }
#pragma unroll
            for (int ai = 0; ai < 2; ++ai)
#pragma unroll
                for (int m = 0; m < 4; ++m) { const int row = row0 + ai * 128 + m * 16;
#pragma unroll
                    for (int bj = 0; bj < 2; ++bj) { f32x4 v0 = acc[ai][bj][m][0], v1 = acc[ai][bj][m][1];
                        if (act == 1) {
#pragma unroll
                            for (int e = 0; e < 4; ++e) { v0[e] = siluf_(v0[e]); v1[e] = siluf_(v1[e]); } }
                        else if (act == 2) {
#pragma unroll
                            for (int e = 0; e < 4; ++e) { v0[e] = sigmoidf_(v0[e]); v1[e] = sigmoidf_(v1[e]); } }
                        u32x4 w; w.x = pk2(v0[0], v0[1]); w.y = pk2(v0[2], v0[3]); w.z = pk2(v1[0], v1[1]); w.w = pk2(v1[2], v1[3]);
                        *(u32x4*)(O + (size_t)row * pitch + cb + bj * 128 + colw) = w; } }
        }
    }
};

__device__ __forceinline__ void p3_indexer(Frame& F) {
    const bf16_t* IQ = WSP(bf16_t, WS_IQ); const bf16_t* IK = WSP(bf16_t, WS_IK); const float* IW = WSP(float, WS_IW); float* SC = WSP(float, WS_SCORES);
    const int gw = F.bid * NWAVES + F.wave, NGW = F.G * NWAVES, lane = F.lane, q = lane & 15, quad = lane >> 4;
    for (int it = gw; it < 2 * 2176; it += NGW) {
        const int b = it / 2176; int r = it % 2176; int qg = 0; while (r >= 16 * (qg + 1)) { r -= 16 * (qg + 1); ++qg; }
        const int qi = 16 * qg + r / (qg + 1), ch = r % (qg + 1);
        const int kt0 = 16 * ch, kt1 = min(16 * ch + 16, qi + 1);
        const size_t qrow = (size_t)b * SEQ + 16 * qi + q;
        bf16x8 bq[8][2];
#pragma unroll
        for (int h = 0; h < 8; ++h)
#pragma unroll
            for (int ks = 0; ks < 2; ++ks) bq[h][ks] = *(const bf16x8*)(IQ + qrow * 512 + h * 64 + 32 * ks + 8 * quad);
        const f32x4 w0 = *(const f32x4*)(IW + qrow * 8), w1 = *(const f32x4*)(IW + qrow * 8 + 4);
        const float wv[8] = {w0[0], w0[1], w0[2], w0[3], w1[0], w1[1], w1[2], w1[3]};
        f32x4 scs[16];
        bf16x8 na[4][2];
        const bf16_t* kbase = IK + ((size_t)b * SEQ + q) * 64 + 8 * quad;
        const int ntl = kt1 - kt0, rot = (gw * 5 + (gw >> 4)) % ntl;
#define IX_TILE(j_) (kt0 + (((j_) + rot) % ntl))
#pragma unroll
        for (int j = 0; j < 4; ++j) { const int kt = IX_TILE(j); na[j][0] = *(const bf16x8*)(kbase + (size_t)kt * 1024); na[j][1] = *(const bf16x8*)(kbase + (size_t)kt * 1024 + 32); }
#define IX_BODY(j) { \
                const bf16x8 a0 = na[(j) & 3][0], a1 = na[(j) & 3][1]; \
                if ((j) + 4 < 16) { const int ktn = IX_TILE((j) + 4); na[(j) & 3][0] = *(const bf16x8*)(kbase + (size_t)ktn * 1024); na[(j) & 3][1] = *(const bf16x8*)(kbase + (size_t)ktn * 1024 + 32); } \
                f32x4 dh[8]; \
                _Pragma("unroll") for (int h = 0; h < 8; ++h) dh[h] = __builtin_amdgcn_mfma_f32_16x16x32_bf16(a0, bq[h][0], (f32x4){0.f, 0.f, 0.f, 0.f}, 0, 0, 0); \
                _Pragma("unroll") for (int h = 0; h < 8; ++h) dh[h] = __builtin_amdgcn_mfma_f32_16x16x32_bf16(a1, bq[h][1], dh[h], 0, 0, 0); \
                f32x4 sc = {0.f, 0.f, 0.f, 0.f}; \
                _Pragma("unroll") for (int h = 0; h < 8; ++h) _Pragma("unroll") for (int e = 0; e < 4; ++e) { const int bi = (int)__float_as_uint(dh[h][e]); sc[e] += wv[h] * __uint_as_float((unsigned)(bi > 0 ? bi : 0)); } \
                scs[j] = sc; }
        if (ntl == 16) {
#pragma unroll
            for (int j = 0; j < 16; ++j) IX_BODY(j)
        } else {
#pragma unroll
            for (int j = 0; j < 16; ++j) { scs[j] = (f32x4){0.f, 0.f, 0.f, 0.f}; if (j < ntl) IX_BODY(j) }
        }
#undef IX_BODY
#pragma unroll
        for (int j = 0; j < 16; ++j) { if (j < ntl) *(f32x4*)(SC + qrow * SEQ + 16 * IX_TILE(j) + 4 * quad) = scs[j]; }
#undef IX_TILE
    }
}

constexpr int HG_QD = 0, HG_KD = 17408, HG_VT = 34816, HG_KET = 53248, HG_ATT = 71680, HG_TOT = 80896, HG_O = 83968;

__device__ __forceinline__ void hg_cum(Frame& F, float (&cum)[16], float& cum_last) {
    LAS float* tot = (LAS float*)(F.lds + HG_TOT);
    const int seg = F.tid >> 7, k = F.tid & 127;
    float run = 0.f;
#pragma unroll
    for (int i = 0; i < 16; ++i) { run += cum[i]; cum[i] = run; }
    tot[seg * 128 + k] = run;
    __syncthreads();
    float pre = 0.f, all = 0.f;
#pragma unroll
    for (int s = 0; s < 4; ++s) { const float t = tot[s * 128 + k]; all += t; if (s < seg) pre += t; }
#pragma unroll
    for (int i = 0; i < 16; ++i) cum[i] += pre;
    cum_last = all;
}

__device__ __forceinline__ void p3_hgrn_upd(Frame& F) {
    const float* LOGF = WSP(float, WS_LOGF); const bf16_t* KF = WSP(bf16_t, WS_KF); const bf16_t* HI = WSP(bf16_t, WS_HI);
    float* UPDT = WSP(float, WS_UPDT); float* DEC = WSP(float, WS_DECAY);
    LAS bf16_t* VT = (LAS bf16_t*)(F.lds + HG_VT); LAS bf16_t* KET = (LAS bf16_t*)(F.lds + HG_KET);
    const int seg = F.tid >> 7, k = F.tid & 127, lane = F.lane, r32 = lane & 31, hi = lane >> 5;
    float lf[16]; bf16_t lk[16], lv[16];
#define HGU_LOAD(tile_) do { const int b_ = (tile_) >> 9, n_ = ((tile_) >> 3) & 63, h_ = (tile_) & 7; const size_t ob_ = ((size_t)b_ * SEQ + 64 * n_ + 16 * seg) * 1024 + h_ * 128 + k; \
        _Pragma("unroll") for (int i = 0; i < 16; ++i) { lf[i] = LOGF[ob_ + i * 1024]; lk[i] = KF[ob_ + i * 1024]; lv[i] = HI[ob_ + i * 1024]; } } while (0)
    if (F.bid < 1024) HGU_LOAD(F.bid);
    for (int tile = F.bid; tile < 1024; tile += F.G) {
        __syncthreads();
        float cum[16], cl;
#pragma unroll
        for (int i = 0; i < 16; ++i) cum[i] = lf[i];
        hg_cum(F, cum, cl);
        { unsigned pk[8], pv[8];
#pragma unroll
          for (int i = 0; i < 16; i += 2) {
              const float k0 = bf2f(lk[i]) * fexp(cl - cum[i]), k1 = bf2f(lk[i + 1]) * fexp(cl - cum[i + 1]); pk[i >> 1] = pk2(k0, k1);
              pv[i >> 1] = (unsigned)lv[i] | ((unsigned)lv[i + 1] << 16); }
          LAS u32x4* dk = (LAS u32x4*)(KET + k * 72 + 16 * seg); dk[0] = (u32x4){pk[0], pk[1], pk[2], pk[3]}; dk[1] = (u32x4){pk[4], pk[5], pk[6], pk[7]};
          LAS u32x4* dv = (LAS u32x4*)(VT + k * 72 + 16 * seg); dv[0] = (u32x4){pv[0], pv[1], pv[2], pv[3]}; dv[1] = (u32x4){pv[4], pv[5], pv[6], pv[7]};
          if (seg == 0) DEC[(size_t)tile * 128 + k] = fexp(cl); }
        __builtin_amdgcn_sched_barrier(0);
        if (tile + F.G < 1024) HGU_LOAD(tile + F.G);
        __syncthreads();
        const int vt = F.wave & 3, kt0 = (F.wave >> 2) * 2;
        f32x16 c0 = {}, c1 = {};
#pragma unroll
        for (int ks = 0; ks < 4; ++ks) { const bf16x8 a = *(const LAS bf16x8*)(VT + (vt * 32 + r32) * 72 + 16 * ks + 8 * hi);
            const bf16x8 b0 = *(const LAS bf16x8*)(KET + (kt0 * 32 + r32) * 72 + 16 * ks + 8 * hi), b1 = *(const LAS bf16x8*)(KET + (kt0 * 32 + 32 + r32) * 72 + 16 * ks + 8 * hi);
            c0 = mfma32(a, b0, c0); c1 = mfma32(a, b1, c1); }
        float* U = UPDT + (size_t)tile * 16384;
#pragma unroll
        for (int r = 0; r < 16; ++r) { const int v = vt * 32 + crow(r, hi); U[v * 128 + kt0 * 32 + r32] = c0[r]; U[v * 128 + kt0 * 32 + 32 + r32] = c1[r]; }
    }
#undef HGU_LOAD
}

__device__ __forceinline__ void p4_hgrn_scan(Frame& F) {
    const float* UPDT = WSP(float, WS_UPDT); const float* DEC = WSP(float, WS_DECAY); bf16_t* SP = WSP(bf16_t, WS_SPREVT);
    const int gt = F.bid * NTHREADS + F.tid, NGT = F.G * NTHREADS;
    for (int e = gt; e < 2 * 8 * 16384 / 2; e += NGT) {
        const int bh = e >> 13, vk = (e & 8191) * 2, b = bh >> 3, h = bh & 7, k = vk & 127;
        float s0 = 0.f, s1 = 0.f;
#pragma unroll 8
        for (int n = 0; n < 64; ++n) { const size_t tile = (size_t)(b * 64 + n) * 8 + h;
            const f32x2 u = *(const f32x2*)(UPDT + tile * 16384 + vk), d = *(const f32x2*)(DEC + tile * 128 + k);
            *(unsigned*)(SP + tile * 16384 + vk) = pk2(s0, s1);
            s0 = d.x * s0 + u.x; s1 = d.y * s1 + u.y; }
    }
}

__device__ __forceinline__ void p5_hgrn_out(Frame& F) {
    const float* LOGF = WSP(float, WS_LOGF); const bf16_t* KF = WSP(bf16_t, WS_KF); const bf16_t* HI = WSP(bf16_t, WS_HI); const bf16_t* HQ = WSP(bf16_t, WS_HQ);
    const bf16_t* HOG = WSP(bf16_t, WS_HOG); const bf16_t* SP = WSP(bf16_t, WS_SPREVT); bf16_t* YHG = WSP(bf16_t, WS_YHG);
    LAS bf16_t* QD = (LAS bf16_t*)(F.lds + HG_QD); LAS bf16_t* KD = (LAS bf16_t*)(F.lds + HG_KD); LAS bf16_t* VT = (LAS bf16_t*)(F.lds + HG_VT);
    LAS bf16_t* ATT = (LAS bf16_t*)(F.lds + HG_ATT); LAS float* OB = (LAS float*)(F.lds + HG_O);
    const int seg = F.tid >> 7, k = F.tid & 127, lane = F.lane, r32 = lane & 31, hi = lane >> 5;
    float lf[16]; bf16_t lq[16], lk[16], lv[16];
#define HGO_LOAD(tile_) do { const int b_ = (tile_) >> 9, n_ = ((tile_) >> 3) & 63, h_ = (tile_) & 7; const size_t ob_ = ((size_t)b_ * SEQ + 64 * n_ + 16 * seg) * 1024 + h_ * 128 + k; \
        _Pragma("unroll") for (int i = 0; i < 16; ++i) { lf[i] = LOGF[ob_ + i * 1024]; lq[i] = HQ[ob_ + i * 1024]; lk[i] = KF[ob_ + i * 1024]; lv[i] = HI[ob_ + i * 1024]; } } while (0)
    if (F.bid < 1024) HGO_LOAD(F.bid);
    for (int tile = F.bid; tile < 1024; tile += F.G) {
        const int b = tile >> 9, n = (tile >> 3) & 63, h = tile & 7; const size_t m0 = (size_t)b * SEQ + 64 * n;
        __syncthreads();
        float cum[16], cl;
#pragma unroll
        for (int i = 0; i < 16; ++i) cum[i] = lf[i];
        hg_cum(F, cum, cl);
        { unsigned pv[8];
          __builtin_amdgcn_sched_barrier(0);
#pragma unroll
          for (int i = 0; i < 16; ++i) {
              const float qd = bf2f(lq[i]) * fexp(cum[i]), kd = bf2f(lk[i]) * fexp(-cum[i]);
              QD[(16 * seg + i) * 136 + k] = (bf16_t)(pk2(qd, 0.f) & 0xffffu); KD[(16 * seg + i) * 136 + k] = (bf16_t)(pk2(kd, 0.f) & 0xffffu);
              if (i & 1) pv[i >> 1] |= ((unsigned)lv[i] << 16); else pv[i >> 1] = (unsigned)lv[i]; }
          LAS u32x4* dv = (LAS u32x4*)(VT + k * 72 + 16 * seg); dv[0] = (u32x4){pv[0], pv[1], pv[2], pv[3]}; dv[1] = (u32x4){pv[4], pv[5], pv[6], pv[7]}; }
        const int tt = F.wave >> 2, vt = F.wave & 3;
        bf16x8 sb[8];
        { const bf16_t* S = SP + (size_t)tile * 16384 + (size_t)(vt * 32 + r32) * 128;
#pragma unroll
          for (int ks = 0; ks < 8; ++ks) sb[ks] = *(const bf16x8*)(S + 16 * ks + 8 * hi); }
        __builtin_amdgcn_sched_barrier(0);
        if (tile + F.G < 1024) HGO_LOAD(tile + F.G);
        __syncthreads();
        if (F.wave < 4) { const int ta = F.wave >> 1, sa = F.wave & 1; f32x16 c = {};
            if (sa <= ta) {
#pragma unroll
                for (int ks = 0; ks < 8; ++ks) { const bf16x8 a = *(const LAS bf16x8*)(QD + (ta * 32 + r32) * 136 + 16 * ks + 8 * hi), bb = *(const LAS bf16x8*)(KD + (sa * 32 + r32) * 136 + 16 * ks + 8 * hi); c = mfma32(a, bb, c); } }
#pragma unroll
            for (int r = 0; r < 16; ++r) { const int t = ta * 32 + crow(r, hi), s = sa * 32 + r32; const float v = (s <= t) ? c[r] : 0.f; ATT[t * 72 + s] = (bf16_t)(pk2(v, 0.f) & 0xffffu); } }
        f32x16 o = {};
        {
#pragma unroll
          for (int ks = 0; ks < 8; ++ks) { const bf16x8 a = *(const LAS bf16x8*)(QD + (tt * 32 + r32) * 136 + 16 * ks + 8 * hi); o = mfma32(a, sb[ks], o); } }
        __syncthreads();
#pragma unroll
        for (int ks = 0; ks < 4; ++ks) { const bf16x8 a = *(const LAS bf16x8*)(ATT + (tt * 32 + r32) * 72 + 16 * ks + 8 * hi), bb = *(const LAS bf16x8*)(VT + (vt * 32 + r32) * 72 + 16 * ks + 8 * hi); o = mfma32(a, bb, o); }
#pragma unroll
        for (int r = 0; r < 16; ++r) OB[(tt * 32 + crow(r, hi)) * 132 + vt * 32 + r32] = o[r];
        __syncthreads();
        { const int t = F.tid >> 3, part = F.tid & 7; float v[16], ss = 0.f;
#pragma unroll
          for (int i = 0; i < 16; i += 4) { const f32x4 x = *(const LAS f32x4*)(OB + t * 132 + part * 16 + i); v[i] = x[0]; v[i + 1] = x[1]; v[i + 2] = x[2]; v[i + 3] = x[3]; ss += (x[0] * x[0] + x[1] * x[1]) + (x[2] * x[2] + x[3] * x[3]); }
          ss += __shfl_xor(ss, 1); ss += __shfl_xor(ss, 2); ss += __shfl_xor(ss, 4);
          const float rs = 1.0f / sqrtf(ss * (1.0f / 128.0f) + EPS);
          const size_t off = (m0 + t) * 1024 + h * 128 + part * 16; unsigned w[8];
          const u32x4 g0 = *(const u32x4*)(HOG + off), g1 = *(const u32x4*)(HOG + off + 8); const unsigned gg[8] = {g0.x, g0.y, g0.z, g0.w, g1.x, g1.y, g1.z, g1.w};
          const float* ghp = F.g_head + h * 128 + part * 16; const f32x4 gh0 = *(const f32x4*)ghp, gh1 = *(const f32x4*)(ghp + 4), gh2 = *(const f32x4*)(ghp + 8), gh3 = *(const f32x4*)(ghp + 12);
          const float ghv[16] = {gh0[0], gh0[1], gh0[2], gh0[3], gh1[0], gh1[1], gh1[2], gh1[3], gh2[0], gh2[1], gh2[2], gh2[3], gh3[0], gh3[1], gh3[2], gh3[3]};
#pragma unroll
          for (int i = 0; i < 8; ++i) { w[i] = pk2(v[2 * i] * rs * ghv[2 * i] * bf2f(gg[i] & 0xffffu), v[2 * i + 1] * rs * ghv[2 * i + 1] * bf2f(gg[i] >> 16)); }
          *(u32x4*)(YHG + off) = (u32x4){w[0], w[1], w[2], w[3]}; *(u32x4*)(YHG + off + 8) = (u32x4){w[4], w[5], w[6], w[7]}; }
    }
}

__device__ __forceinline__ unsigned f2ord(float f) { const unsigned u = __float_as_uint(f); return (u & 0x80000000u) ? ~u : (u | 0x80000000u); }
__device__ __forceinline__ void p4_sel_load(const float* SC, int row, int lane, unsigned (&nu)[64]) {
    const int t = row & (SEQ - 1);
    if (t >= TOPK) { const float* srow = SC + (size_t)row * SEQ; const int ng = (t >> 9) + 1;
#pragma unroll
        for (int g = 0; g < 8; ++g) {
            if (g < ng) {
#pragma unroll
                for (int j = 0; j < 8; ++j) nu[8 * g + j] = __float_as_uint(srow[64 * (8 * g + j) + lane]);
            }
        }
    }
}
__device__ __forceinline__ void p4_select(Frame& F) {
    const float* SC = WSP(float, WS_SCORES); unsigned long long* MASK = WSP(unsigned long long, WS_MASK);
    const int gw = F.bid * NWAVES + F.wave, NGW = F.G * NWAVES, lane = F.lane;
    constexpr int NPAIR = NBATCH * (SEQ / 2);
#define SEL_ROW(k_) ({ const int idx_ = gw + ((k_) >> 1) * NGW; const int b_ = idx_ / (SEQ / 2), p_ = idx_ % (SEQ / 2); b_ * SEQ + (((k_) & 1) ? (SEQ - 1 - p_) : p_); })
#define SEL_HAVE(k_) (gw + ((k_) >> 1) * NGW < NPAIR)
    unsigned nu[64];
#pragma unroll
    for (int i = 0; i < 64; ++i) nu[i] = 0u;
    int k = 0; bool have = SEL_HAVE(0); int row = have ? SEL_ROW(0) : 0;
    if (have) p4_sel_load(SC, row, lane, nu);
    while (have) {
        const int t = row & (SEQ - 1);
        unsigned long long mine = 0ull;
        unsigned u[64];
        const int ng = (t >> 9) + 1;
        if (t >= TOPK) {
#pragma unroll
            for (int g = 0; g < 8; ++g) {
                if (g < ng) {
#pragma unroll
                    for (int j = 0; j < 8; ++j) { const int i = 8 * g + j; const unsigned bits = nu[i]; u[i] = bits ^ ((unsigned)((int)bits >> 31) | 0x80000000u); }
                    if (g == ng - 1) {
#pragma unroll
                        for (int j = 0; j < 8; ++j) { const int i = 8 * g + j, s = 64 * i + lane; u[i] = (s <= t) ? u[i] : 0u; }
                    }
                } else {
#pragma unroll
                    for (int j = 0; j < 8; ++j) u[8 * g + j] = 0u;
                }
            }
        }
        __builtin_amdgcn_sched_barrier(0);
        ++k; const bool haveN = SEL_HAVE(k); const int rowN = haveN ? SEL_ROW(k) : 0;
        if (haveN) p4_sel_load(SC, rowN, lane, nu);
        __builtin_amdgcn_sched_barrier(0);
        if (t < TOPK) {
            const int lo = 64 * lane;
            mine = (t >= lo + 63) ? ~0ull : (t < lo ? 0ull : ((1ull << (t - lo + 1)) - 1ull));
        } else {
            const int ntot = 512 * ng;
            unsigned hp[32];
#pragma unroll
            for (int i = 0; i < 32; ++i) hp[i] = (u[2 * i] >> 16) | (u[2 * i + 1] & 0xffff0000u);
            unsigned T = 0u; bool exact = false; int geT = ntot;
            { const unsigned one2 = 0x00010001u; unsigned Th = 0u;
              for (int bit = 15; bit >= 0; --bit) {
                  const unsigned ch = Th | (1u << bit); unsigned c2 = ch | (ch << 16), acc2 = 0u;
                  asm volatile("" : "+v"(c2));
#pragma unroll
                  for (int g = 0; g < 8; ++g) {
                      if (g < ng) {
#pragma unroll
                          for (int j = 0; j < 4; ++j) { unsigned d;
                              asm("v_pk_sub_u16 %0, %1, %2 clamp" : "=v"(d) : "v"(c2), "v"(hp[4 * g + j]));
                              asm("v_pk_min_u16 %0, %1, %2" : "=v"(d) : "v"(d), "v"(one2));
                              asm("v_pk_add_u16 %0, %1, %2" : "=v"(acc2) : "v"(acc2), "v"(d)); }
                      }
                  }
                  const int ge = ntot - wave_sum_i_dpp((int)((acc2 & 0xffffu) + (acc2 >> 16)));
                  if (ge >= TOPK) { Th = ch; geT = ge; if (ge == TOPK) { exact = true; break; } }
              }
              T = Th << 16; }
            if (!exact) {
                for (int bit = 15; bit >= 0; --bit) {
                    unsigned cand = T | (1u << bit); int c = 0;
                    asm volatile("" : "+v"(cand));
#pragma unroll
                    for (int g = 0; g < 8; ++g) {
                        if (g < ng) {
#pragma unroll
                            for (int j = 0; j < 8; j += 2) { unsigned d0, d1;
                                asm("v_sub_u32_e64 %0, %1, %2 clamp" : "=v"(d0) : "v"(cand), "v"(u[8 * g + j]));
                                asm("v_sub_u32_e64 %0, %1, %2 clamp" : "=v"(d1) : "v"(cand), "v"(u[8 * g + j + 1]));
                                asm("v_min_u32_e32 %0, 1, %1" : "=v"(d0) : "v"(d0));
                                asm("v_min_u32_e32 %0, 1, %1" : "=v"(d1) : "v"(d1));
                                c += (int)(d0 + d1); }
                        }
                    }
                    const int ge = ntot - wave_sum_i_dpp(c);
                    if (ge >= TOPK) { T = cand; geT = ge; if (ge == TOPK) break; }
                }
            }
            const bool allties = (geT == TOPK);
            int need = 0;
            if (!allties) { int cg = 0;
#pragma unroll
                for (int g = 0; g < 8; ++g) {
                    if (g < ng) {
#pragma unroll
                        for (int j = 0; j < 8; ++j) cg += (u[8 * g + j] > T) ? 1 : 0;
                    }
                }
                need = TOPK - wave_sum_i_dpp(cg); }
            int running = 0; const unsigned long long lt = (1ull << lane) - 1ull;
#pragma unroll
            for (int g = 0; g < 8; ++g) {
                if (g < ng) {
#pragma unroll
                    for (int j = 0; j < 8; ++j) { const int i = 8 * g + j;
                        unsigned long long sb;
                        if (allties) sb = __ballot(u[i] >= T);
                        else { const bool eq = (u[i] == T); const unsigned long long bal = __ballot(eq);
                            const int rank = running + __popcll(bal & lt); running += __popcll(bal);
                            sb = __ballot((u[i] > T) || (eq && rank < need)); }
                        if (lane == i) mine = sb; }
                }
            }
        }
        MASK[(size_t)row * 64 + lane] = mine;
        row = rowN; have = haveN;
    }
#undef SEL_ROW
#undef SEL_HAVE
}

constexpr int AT_K = 0, AT_V = 34816, AT_END = 34816 + 34816;
constexpr int AT_MRG = 0, AT_STG = 69632;
__device__ __forceinline__ void p5_attention(Frame& F) {
    const bf16_t* AQ = WSP(bf16_t, WS_AQ); const bf16_t* AK = WSP(bf16_t, WS_AK); const bf16_t* AVT = WSP(bf16_t, WS_AVT); const unsigned* MASK = WSP(unsigned, WS_MASK); bf16_t* YATT = WSP(bf16_t, WS_YATT);
    const int lane = F.lane, r32 = lane & 31, hi = lane >> 5, w = F.wave, kp = w >> 2, tid = F.tid;
    LAS unsigned char* lds = F.lds;
    for (int item = F.bid; item < 256; item += F.G) {
        const int b = item >> 7, hk = (item >> 6) & 1, jj = item & 63;
        for (int uu = 0; uu < 2; ++uu) {
            const int j = uu ? 127 - jj : jj;
            const int head = hk * 4 + (w & 3);
            const size_t qrow = (size_t)b * SEQ + 32 * j + r32;
            const int NT = (j + 2) >> 1, NI = (NT + 1) >> 1;
            bf16x8 qf[8];
#pragma unroll
            for (int ks = 0; ks < 8; ++ks) qf[ks] = *(const bf16x8*)(AQ + qrow * 1024 + head * 128 + 16 * ks + 8 * hi);
            f32x16 o[4]; o[0] = f32x16{}; o[1] = f32x16{}; o[2] = f32x16{}; o[3] = f32x16{};
            float mrun = -INFINITY, lrun = 0.f;
            u32x4 sk[4], sv[4];
#pragma unroll
            for (int c = 0; c < 4; ++c) { sk[c] = (u32x4){0u, 0u, 0u, 0u}; sv[c] = (u32x4){0u, 0u, 0u, 0u}; }
            const bf16_t* Kg = AK + (size_t)b * SEQ * 256 + hk * 128;
            const bf16_t* Vg = AVT + (size_t)((b * 2 + hk) * 128) * SEQ;
#define AT_LOAD(it_) do { int tv = tid; asm volatile("" : "+v"(tv)); const unsigned kb2 = (unsigned)(it_) * 128u; \
                const unsigned ko = ((kb2 + (unsigned)(tv >> 4)) * 256u + (unsigned)(tv & 15) * 8u) * 2u; \
                const unsigned vo = ((unsigned)(tv >> 3) * (unsigned)SEQ + kb2 + (unsigned)(tv & 7) * 8u) * 2u; \
                _Pragma("unroll") for (int c = 0; c < 4; ++c) { \
                    sk[c] = *(const u32x4*)((const char*)Kg + ko + (unsigned)c * 32u * 512u); \
                    sv[c] = *(const u32x4*)((const char*)Vg + vo + (unsigned)(c & 1) * 64u * (unsigned)SEQ * 2u + (unsigned)(c >> 1) * 128u); } } while (0)
#define AT_STORE(bo_) do { \
                _Pragma("unroll") for (int c = 0; c < 4; ++c) { const int id = c * 512 + tid; const int key = id >> 4, ch = id & 15; \
                    *(LAS u32x4*)(lds + (bo_) + AT_K + key * 272 + ch * 16) = sk[c]; \
                    const int vd = (id >> 3) & 127, vp = id >> 10, vc = id & 7; \
                    LAS u32x2* dst = (LAS u32x2*)(lds + (bo_) + AT_V + vp * 17408 + vd * 136 + vc * 16); dst[0] = (u32x2){sv[c].x, sv[c].y}; dst[1] = (u32x2){sv[c].z, sv[c].w}; } } while (0)
            AT_LOAD(0);
            u32x2 mwn = (kp < NT) ? *(const u32x2*)(MASK + qrow * 128 + 2 * kp) : (u32x2){0u, 0u};
            __syncthreads();
            AT_STORE(0);
            if (NI > 1) AT_LOAD(1);
            __syncthreads();
            for (int it = 0; it < NI; ++it) {
                const int bo = (it & 1) * 69632;
                if (kp == 1 && it + 1 < NI) { AT_STORE(((it + 1) & 1) * 69632); if (it + 2 < NI) AT_LOAD(it + 2); }
                const int kt = 2 * it + kp;
                const u32x2 mw = mwn;
                if (kt + 2 < NT) mwn = *(const u32x2*)(MASK + qrow * 128 + 2 * (kt + 2));
                if (kt < NT) {
                    const LAS unsigned char* Kp = lds + bo + AT_K + kp * 17408; const LAS unsigned char* Vp = lds + bo + AT_V + kp * 17408;
                    f32x16 p0 = {}, p1 = {};
                    { bf16x8 kf[2][2][2];
#define AT_KLOAD(ks_, buf_) do { kf[buf_][(ks_) & 1][0] = *(const LAS bf16x8*)(Kp + r32 * 272 + (16 * (ks_) + 8 * hi) * 2); kf[buf_][(ks_) & 1][1] = *(const LAS bf16x8*)(Kp + (32 + r32) * 272 + (16 * (ks_) + 8 * hi) * 2); } while (0)
                      AT_KLOAD(0, 0); AT_KLOAD(1, 0);
#pragma unroll
                      for (int kk = 0; kk < 4; ++kk) {
                          __builtin_amdgcn_sched_barrier(0);
                          if (kk < 3) { AT_KLOAD(2 * kk + 2, (kk + 1) & 1); AT_KLOAD(2 * kk + 3, (kk + 1) & 1); }
#pragma unroll
                          for (int k2 = 0; k2 < 2; ++k2) { p0 = mfma32(kf[kk & 1][k2][0], qf[2 * kk + k2], p0); p1 = mfma32(kf[kk & 1][k2][1], qf[2 * kk + k2], p1); } }
#undef AT_KLOAD
                    }
                    __builtin_amdgcn_sched_barrier(0);
                    u32x4 vf[2][4];
#define AT_VLOAD(dt_, buf_) do { _Pragma("unroll") for (int s = 0; s < 4; ++s) { const LAS unsigned char* vr = Vp + ((dt_) * 32 + r32) * 136 + (16 * s + 4 * hi) * 2; \
                        const u32x2 lo = *(const LAS u32x2*)vr, hh = *(const LAS u32x2*)(vr + 16); vf[buf_][s] = (u32x4){lo.x, lo.y, hh.x, hh.y}; } } while (0)
                    AT_VLOAD(0, 0);
                    float rm = fmaxf(p0[0], p1[0]);
#pragma unroll
                    for (int r = 1; r < 16; ++r) rm = fmaxf(rm, fmaxf(p0[r], p1[r]));
                    rm = fmaxf(rm, __shfl_xor(rm, 32));
                    if (__any(rm > mrun + 8.0f)) { const float mnew = fmaxf(mrun, rm), alpha = __builtin_amdgcn_exp2f(mrun - mnew); lrun *= alpha; mrun = mnew;
#pragma unroll
                        for (int dt = 0; dt < 4; ++dt)
#pragma unroll
                            for (int r = 0; r < 16; ++r) o[dt][r] *= alpha; }
                    const int mx0 = (int)(mw.x >> (4 * hi)), mx1 = (int)(mw.y >> (4 * hi));
                    float ps = 0.f;
#pragma unroll
                    for (int r = 0; r < 16; ++r) { const int bp = (r & 3) + 8 * (r >> 2);
                        int k0 = __builtin_amdgcn_sbfe(mx0, bp, 1), k1 = __builtin_amdgcn_sbfe(mx1, bp, 1);
                        asm volatile("" : "+v"(k0), "+v"(k1));
                        p0[r] = __uint_as_float(__float_as_uint(__builtin_amdgcn_exp2f(p0[r] - mrun)) & (unsigned)k0);
                        p1[r] = __uint_as_float(__float_as_uint(__builtin_amdgcn_exp2f(p1[r] - mrun)) & (unsigned)k1);
                        ps += p0[r] + p1[r]; }
                    lrun += ps;
                    bf16x8 pb[4];
#pragma unroll
                    for (int s = 0; s < 2; ++s) { u32x4 t0, t1;
                        t0.x = pk2(p0[8 * s + 0], p0[8 * s + 1]); t0.y = pk2(p0[8 * s + 2], p0[8 * s + 3]); t0.z = pk2(p0[8 * s + 4], p0[8 * s + 5]); t0.w = pk2(p0[8 * s + 6], p0[8 * s + 7]);
                        t1.x = pk2(p1[8 * s + 0], p1[8 * s + 1]); t1.y = pk2(p1[8 * s + 2], p1[8 * s + 3]); t1.z = pk2(p1[8 * s + 4], p1[8 * s + 5]); t1.w = pk2(p1[8 * s + 6], p1[8 * s + 7]);
                        pb[s] = __builtin_bit_cast(bf16x8, t0); pb[2 + s] = __builtin_bit_cast(bf16x8, t1); }
#pragma unroll
                    for (int dt = 0; dt < 4; ++dt) {
                        __builtin_amdgcn_sched_barrier(0);
                        if (dt < 3) AT_VLOAD(dt + 1, (dt + 1) & 1);
#pragma unroll
                        for (int s = 0; s < 4; ++s) o[dt] = mfma32(__builtin_bit_cast(bf16x8, vf[dt & 1][s]), pb[s], o[dt]); }
#undef AT_VLOAD
                    __builtin_amdgcn_sched_barrier(0);
                }
                if (kp == 0 && it + 1 < NI) { AT_STORE(((it + 1) & 1) * 69632); if (it + 2 < NI) AT_LOAD(it + 2); }
                __syncthreads();
            }
            __syncthreads();
            LAS float* mg = (LAS float*)(lds + AT_MRG) + (w & 3) * 66 * 64;
            if (kp == 1) { mg[lane] = mrun; mg[64 + lane] = lrun;
#pragma unroll
                for (int dt = 0; dt < 4; ++dt)
#pragma unroll
                    for (int r = 0; r < 16; ++r) mg[(2 + dt * 16 + r) * 64 + lane] = o[dt][r]; }
            __syncthreads();
            if (kp == 0) {
                const float m1 = mg[lane], l1 = mg[64 + lane];
                const float mt = fmaxf(mrun, m1), mu = (mt == -INFINITY) ? 0.f : mt;
                const float a0 = __builtin_amdgcn_exp2f(mrun - mu), a1 = __builtin_amdgcn_exp2f(m1 - mu);
                float l = lrun * a0 + l1 * a1; l += __shfl_xor(l, 32);
                const float inv = 1.0f / l;
                LAS bf16_t* stg = (LAS bf16_t*)(lds + AT_STG) + (w & 3) * 32 * 136;
#pragma unroll
                for (int dt = 0; dt < 4; ++dt)
#pragma unroll
                    for (int r = 0; r < 16; ++r) { const float v = (o[dt][r] * a0 + mg[(2 + dt * 16 + r) * 64 + lane] * a1) * inv; stg[r32 * 136 + dt * 32 + crow(r, hi)] = (bf16_t)(pk2(v, 0.f) & 0xffffu); }
                LDS_WAIT();
#pragma unroll
                for (int i = 0; i < 8; ++i) { const int rr = i * 4 + (lane >> 4), ch = lane & 15; const u32x4 v = *(const LAS u32x4*)(stg + rr * 136 + ch * 8);
                    *(u32x4*)(YATT + ((size_t)b * SEQ + 32 * j + rr) * 1024 + head * 128 + ch * 8) = v; }
            }
        }
    }
#undef AT_LOAD
#undef AT_STORE
}

struct ProbMerge : ProbBase {
    static constexpr bool PERM = true;
    unsigned char* ws;
    __device__ __forceinline__ bool next(int i, U& u) const { u.aux = i & 1; return pg8::static_tile((i >> 1) * G + c, M / 256, DM / 256, u.pm, u.pn); }
    __device__ __forceinline__ void bases(const U& u, const char*& a, const char*& b) const {
        a = (const char*)(ws + (u.aux ? WS_YHG : WS_YATT)) + (size_t)u.pm * 256 * K * 2; b = (const char*)(ws + (u.aux ? WS_WHU_T : WS_WAU_T)) + (size_t)u.pn * 256 * K * 2; }
    __device__ __forceinline__ void lane_offs(const U&, const int (&stR)[2], const int (&stC)[2], unsigned (&va)[2][2]) const { lane_offs_plain(stR, stC, va); }
    __device__ __forceinline__ bool keep(const U& u) const { return u.aux == 0; }
    __device__ __forceinline__ void epi(f32x4 (&acc)[2][2][4][2], const U& u, int wr, int wc, int fr, int fq) const {
        const bf16_t* GA = (const bf16_t*)(ws + WS_GA); const bf16_t* GH = (const bf16_t*)(ws + WS_GH); bf16_t* O = (bf16_t*)(ws + WS_MERGED);
        const int row0 = u.pm * 256 + wr * 64 + fr, colw = u.pn * 256 + wc * 32 + 8 * fq;
#pragma unroll
        for (int ai = 0; ai < 2; ++ai) {
            u32x4 gh[4][2], ga[4][2];
#pragma unroll
            for (int m = 0; m < 4; ++m)
#pragma unroll
                for (int bj = 0; bj < 2; ++bj) { const size_t off = (size_t)(row0 + ai * 128 + m * 16) * DM + colw + bj * 128; gh[m][bj] = *(const u32x4*)(GH + off); if (u.aux == 0) ga[m][bj] = *(const u32x4*)(GA + off); else ga[m][bj] = gh[m][bj]; }
            __builtin_amdgcn_sched_barrier(0);
#pragma unroll
            for (int m = 0; m < 4; ++m)
#pragma unroll
                for (int bj = 0; bj < 2; ++bj) { const size_t off = (size_t)(row0 + ai * 128 + m * 16) * DM + colw + bj * 128;
                    const unsigned ghw[4] = {gh[m][bj].x, gh[m][bj].y, gh[m][bj].z, gh[m][bj].w}; const unsigned gaw[4] = {ga[m][bj].x, ga[m][bj].y, ga[m][bj].z, ga[m][bj].w};
                    if (u.aux == 0) {
#pragma unroll
                        for (int n = 0; n < 2; ++n)
#pragma unroll
                            for (int e = 0; e < 4; ++e) { const int wi = 2 * n + (e >> 1); const float a = (e & 1) ? bf2f(gaw[wi] >> 16) : bf2f(gaw[wi] & 0xffffu), h = (e & 1) ? bf2f(ghw[wi] >> 16) : bf2f(ghw[wi] & 0xffffu);
                                acc[ai][bj][m][n][e] *= a * frcp(fmaxf(h, 1e-20f)); } }
                    else { float v[8];
#pragma unroll
                        for (int n = 0; n < 2; ++n)
#pragma unroll
                            for (int e = 0; e < 4; ++e) { const int wi = 2 * n + (e >> 1); const float h = (e & 1) ? bf2f(ghw[wi] >> 16) : bf2f(ghw[wi] & 0xffffu); v[4 * n + e] = acc[ai][bj][m][n][e] * h; }
                        u32x4 w; w.x = pk2(v[0], v[1]); w.y = pk2(v[2], v[3]); w.z = pk2(v[4], v[5]); w.w = pk2(v[6], v[7]); *(u32x4*)(O + off) = w; } }
            __builtin_amdgcn_sched_barrier(0);
        }
    }
};

struct ProbOut : ProbBase {
    static constexpr bool PERM = false;
    unsigned char* ws; const float* x; float* out;
    __device__ __forceinline__ bool next(int i, U& u) const { u.aux = 0; return pg8::static_tile(i * G + c, M / 256, DM / 256, u.pm, u.pn); }
    __device__ __forceinline__ void bases(const U& u, const char*& a, const char*& b) const { a = (const char*)(ws + WS_MERGED) + (size_t)u.pm * 256 * K * 2; b = (const char*)(ws + WS_WOUT_T) + (size_t)u.pn * 256 * K * 2; }
    __device__ __forceinline__ void lane_offs(const U&, const int (&stR)[2], const int (&stC)[2], unsigned (&va)[2][2]) const { lane_offs_plain(stR, stC, va); }
    __device__ __forceinline__ void epi(f32x4 (&acc)[2][2][4][2], const U& u, int wr, int wc, int fr, int fq) const {
        const float* MOD = (const float*)(ws + WS_MOD);
        const int row0 = u.pm * 256 + wr * 64 + fr, col0 = u.pn * 256 + wc * 32 + 4 * fq, b = (u.pm * 256) >> 12;
#pragma unroll
        for (int bj = 0; bj < 2; ++bj)
#pragma unroll
            for (int n = 0; n < 2; ++n) { const int col = col0 + bj * 128 + n * 16; const f32x4 gt = *(const f32x4*)(MOD + b * 12288 + 2 * DM + col);
                f32x4 xv[8];
#pragma unroll
                for (int ai = 0; ai < 2; ++ai)
#pragma unroll
                    for (int m = 0; m < 4; ++m) xv[ai * 4 + m] = *(const f32x4*)(x + (size_t)(row0 + ai * 128 + m * 16) * DM + col);
                __builtin_amdgcn_sched_barrier(0);
#pragma unroll
                for (int ai = 0; ai < 2; ++ai)
#pragma unroll
                    for (int m = 0; m < 4; ++m) { const size_t off = (size_t)(row0 + ai * 128 + m * 16) * DM + col; *(f32x4*)(out + off) = xv[ai * 4 + m] + gt * acc[ai][bj][m][n]; }
                __builtin_amdgcn_sched_barrier(0); }
    }
};

__device__ __forceinline__ void p8_norm2_route(Frame& F) {
    LAS float* CA = (LAS float*)F.lds; LAS float* CB = CA + DM;
    LAS float* WB = CB + DM;
    LAS float* LOGI = WB + 2 * 9216;
    const float* MOD = WSP(float, WS_MOD); bf16_t* XN = WSP(bf16_t, WS_XN); const float* X1 = F.out;
    int* LIST = WSP(int, WS_LIST); float* LISTW = WSP(float, WS_LISTW);
    const int lane = F.lane, tid = F.tid;
#define RT_STAGE(j_, buf_) do { int lv_ = lane; asm volatile("" : "+v"(lv_)); _Pragma("unroll") for (int i_ = 0; i_ < 5; ++i_) { const int id0_ = i_ * 512 + F.wave * 64; if (id0_ < 2304) { const int id_ = id0_ + lv_, rho_ = id_ / 9, q_ = id_ - rho_ * 9; \
            const int k_ = (j_) * 256 + 4 * (rho_ & 63) + (rho_ >> 6); const float* src_ = (q_ == 0) ? (F.w_rg + (size_t)k_ * 4) : (F.w_re + (size_t)k_ * 32 + (q_ - 1) * 4); \
            __builtin_amdgcn_global_load_lds((const unsigned*)src_, (LAS unsigned*)(WB + (buf_) * 9216 + id0_ * 4), 16, 0, 0); } } } while (0)
    for (int rb = F.bid; rb < M / 32; rb += F.G) {
        const int b = (rb * 32) / SEQ;
        __syncthreads();
        for (int k = tid; k < DM; k += NTHREADS) { CA[k] = F.g_norm2[k] * (1.0f + MOD[b * 12288 + 4 * DM + k]); CB[k] = MOD[b * 12288 + 3 * DM + k]; }
        RT_STAGE(0, 0);
        __syncthreads();
        const int mb = rb * 32 + F.wave * 4;
        float rs[4];
#pragma unroll
        for (int r = 0; r < 4; ++r) { __builtin_amdgcn_sched_barrier(0); f32x4 v[8]; rs[r] = row_rstd(X1 + (size_t)(mb + r) * DM, lane, v);
#pragma unroll
            for (int j = 0; j < 8; ++j) { const int k = 4 * (lane + 64 * j); const f32x4 a = *(const LAS f32x4*)(CA + k), bb = *(const LAS f32x4*)(CB + k);
                const f32x4 h = v[j] * rs[r] * a + bb; u32x2 o; o.x = pk2(h.x, h.y); o.y = pk2(h.z, h.w); *(u32x2*)(XN + (size_t)(mb + r) * DM + k) = o; } }
        LAS float* red = WB + F.wave * 2304;
#pragma unroll 1
        for (int half = 0; half < 2; ++half) {
            const int m0 = mb + 2 * half;
            const float rs0 = half ? rs[2] : rs[0], rs1 = half ? rs[3] : rs[1];
            float acc[2][36];
#pragma unroll
            for (int r = 0; r < 2; ++r)
#pragma unroll
                for (int j = 0; j < 36; ++j) acc[r][j] = 0.f;
            if (half) { __syncthreads(); RT_STAGE(0, 0); }
            f32x4 xc[2];
            xc[0] = *(const f32x4*)(X1 + (size_t)m0 * DM + 4 * lane); xc[1] = *(const f32x4*)(X1 + (size_t)(m0 + 1) * DM + 4 * lane);
#pragma unroll 1
            for (int j = 0; j < 8; ++j) {
                __syncthreads();
                if (j < 7) RT_STAGE(j + 1, (j + 1) & 1);
                const f32x4 ca = *(const LAS f32x4*)(CA + 256 * j + 4 * lane), cb = *(const LAS f32x4*)(CB + 256 * j + 4 * lane);
                const f32x4 h0 = xc[0] * rs0 * ca + cb, h1 = xc[1] * rs1 * ca + cb;
                if (j < 7) { xc[0] = *(const f32x4*)(X1 + (size_t)m0 * DM + 256 * (j + 1) + 4 * lane); xc[1] = *(const f32x4*)(X1 + (size_t)(m0 + 1) * DM + 256 * (j + 1) + 4 * lane); }
                const LAS float* wb = WB + (j & 1) * 9216;
#pragma unroll
                for (int e = 0; e < 4; ++e)
#pragma unroll
                    for (int q = 0; q < 9; ++q) { const f32x4 wv = *(const LAS f32x4*)(wb + (e * 64 + lane) * 36 + q * 4);
#pragma unroll
                        for (int c = 0; c < 4; ++c) { acc[0][q * 4 + c] += h0[e] * wv[c]; acc[1][q * 4 + c] += h1[e] * wv[c]; } }
            }
            __syncthreads();
#pragma unroll
            for (int r = 0; r < 2; ++r) {
#pragma unroll
                for (int q = 0; q < 9; ++q) *(LAS f32x4*)(red + lane * 36 + q * 4) = (f32x4){acc[r][q * 4], acc[r][q * 4 + 1], acc[r][q * 4 + 2], acc[r][q * 4 + 3]};
                LDS_WAIT(); asm volatile("" ::: "memory");
                if (lane < 36) { float sm = 0.f;
#pragma unroll 16
                    for (int l = 0; l < 64; ++l) sm += red[l * 36 + lane];
                    LOGI[(F.wave * 2 + r) * 36 + lane] = sm + (lane < 4 ? F.b_rg[lane] : F.b_re[lane - 4]); }
                LDS_WAIT(); asm volatile("" ::: "memory");
            }
            if (lane < 2) {
                const LAS float* lg = LOGI + (F.wave * 2 + lane) * 36;
                int grp = 0; float gm = lg[0];
#pragma unroll
                for (int g = 1; g < 4; ++g) if (lg[g] > gm) { gm = lg[g]; grp = g; }
                float gs = 0.f;
#pragma unroll
                for (int g = 0; g < 4; ++g) gs += expf(lg[g] - gm);
                const float pgrp = 1.0f / gs;
                float el[8];
#pragma unroll
                for (int e = 0; e < 8; ++e) { el[e] = lg[4 + e]; if (grp == 1) el[e] = lg[12 + e]; if (grp == 2) el[e] = lg[20 + e]; if (grp == 3) el[e] = lg[28 + e]; }
                int e0 = 0; float v0 = el[0];
#pragma unroll
                for (int e = 1; e < 8; ++e) if (el[e] > v0) { v0 = el[e]; e0 = e; }
                int e1 = -1; float v1 = -INFINITY;
#pragma unroll
                for (int e = 0; e < 8; ++e) if (e != e0 && el[e] > v1) { v1 = el[e]; e1 = e; }
                const float p1 = expf(v1 - v0), w0 = pgrp / (1.0f + p1), w1 = pgrp * p1 / (1.0f + p1);
                const int m = m0 + lane;
                const int ea = grp * 8 + e0, eb = grp * 8 + e1;
                const unsigned sa = __hip_atomic_fetch_add(F.ctl + CW_CNT + 16 * ea, 1u, RLX_AGENT);
                const unsigned sb = __hip_atomic_fetch_add(F.ctl + CW_CNT + 16 * eb, 1u, RLX_AGENT);
                LIST[ea * M + sa] = 2 * m; LISTW[ea * M + sa] = w0;
                LIST[eb * M + sb] = 2 * m + 1; LISTW[eb * M + sb] = w1;
            }
            LDS_WAIT(); asm volatile("" ::: "memory");
        }
    }
#undef RT_STAGE
}

__device__ __forceinline__ void p8_expert_weights(Frame& F) {
    const int lane = F.lane;
    {
        __syncthreads();
        LAS float* scr = (LAS float*)(F.lds + F.wave * 16384);
        const int gw = F.bid * NWAVES + F.wave, NGW = F.G * NWAVES;
#define P8_DESC(it, d) do { const int e_ = (it) / 1536; const int r_ = (it) % 1536; \
            if (r_ < 512) { d.W = F.w_eg + (size_t)e_ * DM * EFF; d.K = DM; d.N = EFF; d.WT = WSP(bf16_t, WS_WGU_T) + (size_t)e_ * 1024 * DM; d.kind = 2; d.item = r_; } \
            else if (r_ < 1024) { d.W = F.w_eu + (size_t)e_ * DM * EFF; d.K = DM; d.N = EFF; d.WT = WSP(bf16_t, WS_WGU_T) + (size_t)e_ * 1024 * DM; d.kind = 3; d.item = r_ - 512; } \
            else { d.W = F.w_ed + (size_t)e_ * EFF * DM; d.K = EFF; d.N = DM; d.WT = WSP(bf16_t, WS_WD_T) + (size_t)e_ * DM * EFF; d.kind = 0; d.item = r_ - 1024; } } while (0)
        TD_STREAM(gw, NGW, NEXP * 1536, P8_DESC, lane, scr);
#undef P8_DESC
    }
}

constexpr int MOE_TAB_OFF = LDSCTL_OFF + 2048;
struct ProbMoe : ProbBase {
    unsigned char* ws; const LAS int* tab; int nct; unsigned* done;
    __device__ __forceinline__ bool decode(int L, U& u) const {
        const int l = (int)(threadIdx.x & 31); const bool in = (L >= tab[65 + l]) && (L < tab[66 + l]);
        const unsigned long long bal = __ballot(in);
        if (bal == 0ull) return false;
        const int e = __builtin_ctzll(bal); const int rem = L - tab[65 + e];
        u.aux = e; u.pm = rem / nct; u.pn = rem - u.pm * nct; return true;
    }
    __device__ __forceinline__ int rowbase(int e) const { return tab[32 + e]; }
    __device__ __forceinline__ int count(int e) const { return tab[e]; }
};
__device__ __forceinline__ void moe_table(LAS unsigned char* lds, const unsigned* cnt, int nct) {
    LAS int* tab = (LAS int*)(lds + MOE_TAB_OFF);
    __syncthreads();
    if (threadIdx.x < NEXP) tab[threadIdx.x] = (int)__hip_atomic_load(cnt + 16 * threadIdx.x, __ATOMIC_RELAXED, __HIP_MEMORY_SCOPE_AGENT);
    __syncthreads();
    if (threadIdx.x == 0) { int rb = 0, st = 0; for (int e = 0; e < NEXP; ++e) { tab[32 + e] = rb; tab[65 + e] = st; const int nrt = (tab[e] + 255) >> 8; rb += nrt * 256; st += nrt * nct; } tab[64] = rb; tab[97] = st; }
    __syncthreads();
}
struct ProbMoe1 : ProbMoe {
    static constexpr bool PERM = true;
    __device__ __forceinline__ bool next(int i, U& u) const { return decode(i * G + c, u); }
    __device__ __forceinline__ void bases(const U& u, const char*& a, const char*& b) const { a = (const char*)(ws + WS_XN); b = (const char*)(ws + WS_WGU_T) + ((size_t)u.aux * 1024 + u.pn * 256) * K * 2; }
    __device__ __forceinline__ void lane_offs(const U& u, const int (&stR)[2], const int (&stC)[2], unsigned (&va)[2][2]) const {
        const int* LIST = (const int*)(ws + WS_LIST); const int n = count(u.aux);
#pragma unroll
        for (int h = 0; h < 2; ++h)
#pragma unroll
            for (int i = 0; i < 2; ++i) { const int sl = u.pm * 256 + h * 128 + stR[i]; const int tok = LIST[u.aux * M + (sl < n ? sl : 0)] >> 1; va[h][i] = (unsigned)(tok * K + stC[i]) * 2u; }
    }
    __device__ __forceinline__ void epi(f32x4 (&acc)[2][2][4][2], const U& u, int wr, int wc, int fr, int fq) const {
        const float* LISTW = (const float*)(ws + WS_LISTW); bf16_t* ACT = (bf16_t*)(ws + WS_ACT);
        const int n = count(u.aux), rb = rowbase(u.aux);
        const int f0 = u.pn * 128 + wc * 16 + 4 * fq;
        float wts[8];
#pragma unroll
        for (int ai = 0; ai < 2; ++ai)
#pragma unroll
            for (int m = 0; m < 4; ++m) { const int sl = u.pm * 256 + ai * 128 + wr * 64 + m * 16 + fr; wts[ai * 4 + m] = LISTW[u.aux * M + (sl < n ? sl : 0)]; }
        __builtin_amdgcn_sched_barrier(0);
#pragma unroll
        for (int ai = 0; ai < 2; ++ai)
#pragma unroll
            for (int m = 0; m < 4; ++m) { const int sl = u.pm * 256 + ai * 128 + wr * 64 + m * 16 + fr;
                if (sl < n) { const float wt = wts[ai * 4 + m];
#pragma unroll
                    for (int bj = 0; bj < 2; ++bj) { const f32x4 g = acc[ai][bj][m][0], uu = acc[ai][bj][m][1]; float v[4];
#pragma unroll
                        for (int e = 0; e < 4; ++e) v[e] = siluf_(g[e]) * uu[e] * wt;
                        const unsigned long long w = (unsigned long long)pk2(v[0], v[1]) | ((unsigned long long)pk2(v[2], v[3]) << 32);
                        __hip_atomic_store((unsigned long long*)(ACT + (size_t)(rb + sl) * EFF + f0 + bj * 64), w, RLX_AGENT); } } }
        asm volatile("s_waitcnt vmcnt(0)" ::: "memory");
        if ((threadIdx.x & 63) == 0) __hip_atomic_fetch_add(done + 16 * ((rb >> 8) + u.pm), 1u, RLX_AGENT);
    }
};
struct ProbMoe2 : ProbMoe {
    static constexpr bool PERM = true;
    __device__ __forceinline__ void ready(const U& u, bool me) const {
        if (me) { unsigned* p = done + 16 * ((rowbase(u.aux) >> 8) + u.pm); unsigned sp = 0;
            while (__hip_atomic_load(p, RLX_AGENT) < 32u) { __builtin_amdgcn_s_sleep(2); if (++sp > (1u << 20)) break; }
            __builtin_amdgcn_fence(__ATOMIC_ACQUIRE, "agent"); asm volatile("s_waitcnt vmcnt(0)" ::: "memory"); }
    }
    __device__ __forceinline__ bool next(int i, U& u) const {
        const int u1 = tab[97] >> 1;
        const int base = u1 / G, rem = u1 - base * G, tot = tab[97];
        int n_early = 2 * base * G; if (n_early > tot) n_early = tot;
        int L;
        if (c >= rem) { const int W = G - rem, first = c - rem; const int ce = (n_early > first) ? (n_early - first + W - 1) / W : 0;
            L = (i < ce) ? (i * W + first) : (n_early + (i - ce) * G + c); }
        else L = n_early + i * G + c;
        return decode(L, u);
    }
    __device__ __forceinline__ void bases(const U& u, const char*& a, const char*& b) const { a = (const char*)(ws + WS_ACT) + (size_t)(rowbase(u.aux) + u.pm * 256) * K * 2; b = (const char*)(ws + WS_WD_T) + ((size_t)u.aux * DM + u.pn * 256) * K * 2; }
    __device__ __forceinline__ void lane_offs(const U&, const int (&stR)[2], const int (&stC)[2], unsigned (&va)[2][2]) const { lane_offs_plain(stR, stC, va); }
    __device__ __forceinline__ void epi(f32x4 (&acc)[2][2][4][2], const U& u, int wr, int wc, int fr, int fq) const {
        const int* LIST = (const int*)(ws + WS_LIST); bf16_t* YS = (bf16_t*)(ws + WS_YS);
        const int n = count(u.aux);
        const int colw = u.pn * 256 + wc * 32 + 8 * fq;
        int slots[8];
#pragma unroll
        for (int ai = 0; ai < 2; ++ai)
#pragma unroll
            for (int m = 0; m < 4; ++m) { const int sl = u.pm * 256 + ai * 128 + wr * 64 + m * 16 + fr; slots[ai * 4 + m] = LIST[u.aux * M + (sl < n ? sl : 0)]; }
        __builtin_amdgcn_sched_barrier(0);
#pragma unroll
        for (int ai = 0; ai < 2; ++ai)
#pragma unroll
            for (int m = 0; m < 4; ++m) { const int sl = u.pm * 256 + ai * 128 + wr * 64 + m * 16 + fr;
                if (sl < n) { const int slot = slots[ai * 4 + m];
#pragma unroll
                    for (int bj = 0; bj < 2; ++bj) { const f32x4 v0 = acc[ai][bj][m][0], v1 = acc[ai][bj][m][1];
                        u32x4 w; w.x = pk2(v0[0], v0[1]); w.y = pk2(v0[2], v0[3]); w.z = pk2(v1[0], v1[1]); w.w = pk2(v1[2], v1[3]);
                        *(u32x4*)(YS + (size_t)slot * DM + colw + bj * 128) = w; } } }
    }
};

__device__ __forceinline__ void p11_final(Frame& F, float* dst) {
    const float* MOD = WSP(float, WS_MOD); const bf16_t* YS = WSP(bf16_t, WS_YS);
    const int gw = F.bid * NWAVES + F.wave, NGW = F.G * NWAVES, lane = F.lane;
    for (int m = gw; m < M; m += NGW) {
        const int b = m >> 12; const float* row = F.out + (size_t)m * DM; float* orow = dst + (size_t)m * DM; f32x4 v[8]; float s = 0.f;
#pragma unroll
        for (int j = 0; j < 8; ++j) { const int k = 4 * (lane + 64 * j); const f32x4 xv = *(const f32x4*)(row + k), gt = *(const f32x4*)(MOD + b * 12288 + 5 * DM + k);
            const u32x2 y0 = *(const u32x2*)(YS + (size_t)(2 * m) * DM + k), y1 = *(const u32x2*)(YS + (size_t)(2 * m + 1) * DM + k);
            f32x4 y; y.x = bf2f(y0.x & 0xffffu) + bf2f(y1.x & 0xffffu); y.y = bf2f(y0.x >> 16) + bf2f(y1.x >> 16); y.z = bf2f(y0.y & 0xffffu) + bf2f(y1.y & 0xffffu); y.w = bf2f(y0.y >> 16) + bf2f(y1.y >> 16);
            v[j] = xv + gt * y; s += (v[j].x * v[j].x + v[j].y * v[j].y) + (v[j].z * v[j].z + v[j].w * v[j].w); }
        f32x4 gf[8];
#pragma unroll
        for (int j = 0; j < 8; ++j) gf[j] = *(const f32x4*)(F.g_final + 4 * (lane + 64 * j));
        const float rs = 1.0f / sqrtf(wave_sum(s) * (1.0f / DM) + EPS);
#pragma unroll
        for (int j = 0; j < 8; ++j) { const int k = 4 * (lane + 64 * j); *(f32x4*)(orow + k) = v[j] * rs * gf[j]; }
    }
}

constexpr int NPHASE = 12;
struct Args { const void* in[21]; float* out; unsigned char* ws; int ph_lo, ph_hi; };
__global__ void __launch_bounds__(NTHREADS, 2) hybrid_block_fwd(Args args) {
    extern __shared__ __attribute__((aligned(16))) unsigned char lds_raw[];
    Frame F;
    F.lds = (LAS unsigned char*)lds_raw;
    F.tid = threadIdx.x; F.lane = F.tid & 63; F.wave = __builtin_amdgcn_readfirstlane(F.tid >> 6); F.G = gridDim.x; F.bid = blockIdx.x;
    F.ws = args.ws; F.ctl = (unsigned*)(args.ws + WS_CTL); F.out = args.out;
    F.x = (const float*)args.in[0]; F.c = (const float*)args.in[1]; F.positions = (const int*)args.in[2]; F.w_ada = (const float*)args.in[3]; F.b_ada = (const float*)args.in[4];
    F.g_norm1 = (const float*)args.in[5]; F.w_in = (const float*)args.in[6]; F.g_head = (const float*)args.in[7]; F.hglb = (const float*)args.in[8]; F.w_attn_up = (const float*)args.in[9];
    F.w_hgrn_up = (const float*)args.in[10]; F.w_out = (const float*)args.in[11]; F.g_norm2 = (const float*)args.in[12]; F.w_rg = (const float*)args.in[13]; F.b_rg = (const float*)args.in[14];
    F.w_re = (const float*)args.in[15]; F.b_re = (const float*)args.in[16]; F.w_eg = (const float*)args.in[17]; F.w_eu = (const float*)args.in[18]; F.w_ed = (const float*)args.in[19]; F.g_final = (const float*)args.in[20];
    volatile LAS unsigned* MISC = (volatile LAS unsigned*)(F.lds + MISC_OFF);
    for (int u = F.tid; u < (LDS_EXTRA - LDSCTL_OFF) / 4; u += NTHREADS) ((LAS unsigned*)(F.lds + LDSCTL_OFF))[u] = 0u;
    __syncthreads();
    const int lo = args.ph_lo, hi = args.ph_hi;
    XcdBarrier bar; bar.bar = F.ctl + CW_BAR; bar.x = 0; bar.st = nullptr;
    if (hi - lo > 1) bar = xcd_barrier_post(F.ctl + CW_BAR, MISC + 8);
#ifndef PHMASK
#define PHMASK 0xfff
#endif
#define IN(k) (((PHMASK >> (k)) & 1) && lo <= (k) && (k) < hi)
#define SEAM(k) do { if (IN(k) && IN((k) + 1)) xcd_barrier(bar); } while (0)
#ifndef REPMASK
#define REPMASK 0
#endif
#define RUN2(k, BODY) do { if (IN(k)) { BODY } if (((REPMASK >> (k)) & 1) && IN(k)) { xcd_barrier(bar); BODY } } while (0)
    RUN2(0, p0_prologue(F);); SEAM(0);
    RUN2(1, p1_norm1(F);); SEAM(1);
#define BODY2 { ProbWin P; P.K = DM; P.G = F.G; P.c = F.bid; P.A = (const char*)(F.ws + WS_XN); P.B = (const char*)(F.ws + WS_WIN_T); P.ws = F.ws; P.hglb = F.hglb; pg8::gemm_phase(F.lds, P); }
    RUN2(2, BODY2); SEAM(2);
    RUN2(3, p3_indexer(F); p3_hgrn_upd(F);); if ((REPMASK >> 20) & 1) { xcd_barrier(bar); p3_indexer(F); } if ((REPMASK >> 21) & 1) { xcd_barrier(bar); p3_hgrn_upd(F); } SEAM(3);
    RUN2(4, p4_select(F); p4_hgrn_scan(F);); if ((REPMASK >> 15) & 1) { xcd_barrier(bar); p4_select(F); } if ((REPMASK >> 16) & 1) { xcd_barrier(bar); p4_hgrn_scan(F); } SEAM(4);
    RUN2(5, p5_attention(F); p5_hgrn_out(F);); if ((REPMASK >> 13) & 1) { xcd_barrier(bar); p5_attention(F); } if ((REPMASK >> 14) & 1) { xcd_barrier(bar); p5_hgrn_out(F); } SEAM(5);
#define BODY6 { ProbMerge P; P.K = 1024; P.G = F.G; P.c = F.bid; P.ws = F.ws; pg8::gemm_phase(F.lds, P); }
    RUN2(6, BODY6); SEAM(6);
#define BODY7 { ProbOut P; P.K = DM; P.G = F.G; P.c = F.bid; P.ws = F.ws; P.x = F.x; P.out = F.out; pg8::gemm_phase(F.lds, P); }
    RUN2(7, BODY7); SEAM(7);
    if (IN(8)) { p8_norm2_route(F); if ((REPMASK >> 17) & 1) { xcd_barrier(bar); if (F.bid == 0 && F.tid < 32) __hip_atomic_store(F.ctl + CW_CNT + 16 * F.tid, 0u, RLX_AGENT); xcd_barrier(bar); p8_norm2_route(F); } p8_expert_weights(F); if ((REPMASK >> 12) & 1) { xcd_barrier(bar); p8_expert_weights(F); } } SEAM(8);
#define BODY9 { moe_table(F.lds, F.ctl + CW_CNT, 4); ProbMoe1 P; P.K = DM; P.G = F.G; P.c = F.bid; P.ws = F.ws; P.tab = (const LAS int*)(F.lds + MOE_TAB_OFF); P.nct = 4; P.done = F.ctl + CW_DONE; pg8::gemm_phase(F.lds, P); }
    if (IN(9)) BODY9;
#if MK_MULTI
    SEAM(9);
#endif
#define BODY10 { moe_table(F.lds, F.ctl + CW_CNT, 8); ProbMoe2 P; P.K = EFF; P.G = F.G; P.c = F.bid; P.ws = F.ws; P.tab = (const LAS int*)(F.lds + MOE_TAB_OFF); P.nct = 8; P.done = F.ctl + CW_DONE; pg8::gemm_phase(F.lds, P); }
    if (IN(10)) BODY10; SEAM(10);
    if (IN(11)) { if ((REPMASK >> 18) & 1) { p11_final(F, WSP(float, WS_UPDT)); xcd_barrier(bar); } p11_final(F, F.out); }
    if ((REPMASK >> 19) & 1) { xcd_barrier(bar); BODY2 }
#undef IN
#undef SEAM
}

extern "C" void kernel_launch(void* const* d_in, const int* in_sizes, int n_in, void* d_out, int out_size, void* d_ws, size_t ws_size, hipStream_t stream) {
    static int grid = 0;
    if (grid == 0) {
        if (n_in != 21 || in_sizes[0] != M * DM || out_size != M * DM || ws_size < WS_END) { fprintf(stderr, "kernel_launch: unexpected shapes/workspace (n_in %d, in0 %d, out %d, ws %zu)\n", n_in, n_in > 0 ? in_sizes[0] : -1, out_size, ws_size); grid = -1; return; }
        int dev = 0, cus = 0, per_cu = 0;
        if (hipGetDevice(&dev) != hipSuccess || hipDeviceGetAttribute(&cus, hipDeviceAttributeMultiprocessorCount, dev) != hipSuccess) { grid = -1; return; }
        if (hipFuncSetAttribute((const void*)hybrid_block_fwd, hipFuncAttributeMaxDynamicSharedMemorySize, LDS_BYTES) != hipSuccess) { fprintf(stderr, "kernel_launch: hipFuncSetAttribute failed\n"); grid = -1; return; }
        if (hipOccupancyMaxActiveBlocksPerMultiprocessor(&per_cu, (const void*)hybrid_block_fwd, NTHREADS, LDS_BYTES) != hipSuccess || per_cu < 1) fprintf(stderr, "kernel_launch: occupancy query reports %d\n", per_cu);
        (void)hipGetLastError();
        grid = cus;
    }
    if (grid < 0) return;
    (void)hipMemsetAsync((char*)d_ws + WS_CTL, 0, CTL_ZERO_BYTES, stream);
    Args a{};
    for (int i = 0; i < 21; ++i) a.in[i] = d_in[i];
    a.out = (float*)d_out; a.ws = (unsigned char*)d_ws;
#if MK_MULTI
    for (int p = 0; p < NPHASE; ++p) { a.ph_lo = p; a.ph_hi = p + 1; hipLaunchKernelGGL(hybrid_block_fwd, dim3(grid), dim3(NTHREADS), LDS_BYTES, stream, a); }
#else
    a.ph_lo = 0; a.ph_hi = NPHASE; hipLaunchKernelGGL(hybrid_block_fwd, dim3(grid), dim3(NTHREADS), LDS_BYTES, stream, a);
#endif
}
```

```cpp
#include <hip/hip_runtime.h>
#include <cstdio>
#include <cstdint>

#define REPMASK 0x0
#ifndef MK_MULTI
#define MK_MULTI 0
#endif

#define GAS __attribute__((address_space(1)))
#define LAS __attribute__((address_space(3)))
typedef unsigned short bf16_t;
typedef short bf16x8 __attribute__((ext_vector_type(8)));
typedef short s16x4 __attribute__((ext_vector_type(4)));
typedef short v4i16_t __attribute__((ext_vector_type(4)));
typedef float f32x4 __attribute__((ext_vector_type(4)));
typedef float f32x2 __attribute__((ext_vector_type(2)));
typedef float f32x16 __attribute__((ext_vector_type(16)));
typedef unsigned u32x4 __attribute__((ext_vector_type(4)));
typedef unsigned u32x2 __attribute__((ext_vector_type(2)));

constexpr int DM = 2048, NBATCH = 2, SEQ = 4096, M = NBATCH * SEQ;
constexpr int NLOG = 10312, NPHYS = 10240;
constexpr int NEXP = 32, EFF = 512;
constexpr float EPS = 1e-6f;
constexpr float ATT_SCALE_L2E = 0.08838834764831845f * 1.4426950408889634f;
constexpr float IDX_SCALE = 0.04419417382415922f;
constexpr int TOPK = 256;

constexpr size_t MiB = 1u << 20;
constexpr size_t WS_CTL = 0, CTL_ZERO_BYTES = 1 * MiB;
constexpr size_t WS_WIN_T = 1 * MiB, WS_WAU_T = 42 * MiB, WS_WHU_T = 46 * MiB, WS_WOUT_T = 50 * MiB;
constexpr size_t WS_XN = 58 * MiB, WS_MODP = 90 * MiB, WS_MOD = 92 * MiB, WS_TABA = 93 * MiB, WS_TABI = 97 * MiB, WS_MASK = 99 * MiB;
constexpr size_t WS_W40T = 104 * MiB;
constexpr size_t WS_DECAY = 103 * MiB, WS_LIST = 105 * MiB, WS_LISTW = 106 * MiB, WS_SPREVT = 107 * MiB, WS_YATT = 139 * MiB, WS_YHG = 155 * MiB, WS_UPDT = 171 * MiB;
constexpr size_t WS_AQ = 235 * MiB, WS_AK = 251 * MiB, WS_AVT = 255 * MiB, WS_IQ = 259 * MiB, WS_IK = 267 * MiB, WS_IW = 268 * MiB, WS_HQ = 269 * MiB, WS_LOGF = 285 * MiB,
                 WS_KF = 317 * MiB, WS_HI = 333 * MiB, WS_HOG = 349 * MiB, WS_GA = 365 * MiB, WS_GH = 397 * MiB;
constexpr size_t WS_WGU_T = 235 * MiB, WS_WD_T = 363 * MiB;
constexpr size_t WS_SCORES = 429 * MiB;
constexpr size_t WS_MERGED = 429 * MiB, WS_YS = 461 * MiB, WS_ACT = 557 * MiB;
constexpr size_t WS_END = 581 * MiB;
constexpr int CW_BAR = 4096, CW_CNT = 16384, CW_DONE = 32768;

constexpr int RING_BYTES = 139264, LDSCTL_OFF = RING_BYTES, MISC_OFF = LDSCTL_OFF + 320, LDS_EXTRA = 147456, LDS_BYTES = 163840;
constexpr int NWAVES = 8, NTHREADS = 512;

#define RLX_AGENT __ATOMIC_RELAXED, __HIP_MEMORY_SCOPE_AGENT
#define LDS_WAIT() asm volatile("s_waitcnt lgkmcnt(0)" ::: "memory")
#define VM_WAIT() asm volatile("s_waitcnt vmcnt(0)" ::: "memory")
__device__ __forceinline__ float bf2f(unsigned b) { return __uint_as_float(b << 16); }
__device__ __forceinline__ unsigned pk2(float lo, float hi) { unsigned r; asm("v_cvt_pk_bf16_f32 %0, %1, %2" : "=v"(r) : "v"(lo), "v"(hi)); return r; }
__device__ __forceinline__ float fexp(float x) { return __builtin_amdgcn_exp2f(x * 1.4426950408889634f); }
__device__ __forceinline__ float frcp(float x) { return __builtin_amdgcn_rcpf(x); }
__device__ __forceinline__ float sigmoidf_(float x) { return frcp(1.0f + fexp(-x)); }
__device__ __forceinline__ float siluf_(float x) { return x * sigmoidf_(x); }
__device__ __forceinline__ float wave_sum(float v) {
#pragma unroll
    for (int o = 1; o < 64; o <<= 1) v += __shfl_xor(v, o);
    return v;
}
__device__ __forceinline__ int wave_sum_i_dpp(int v) {
    v += __builtin_amdgcn_update_dpp(0, v, 0xB1, 0xF, 0xF, false);
    v += __builtin_amdgcn_update_dpp(0, v, 0x4E, 0xF, 0xF, false);
    v += __builtin_amdgcn_update_dpp(0, v, 0x124, 0xF, 0xF, false);
    v += __builtin_amdgcn_update_dpp(0, v, 0x128, 0xF, 0xF, false);
    return __builtin_amdgcn_readlane(v, 0) + __builtin_amdgcn_readlane(v, 16) + __builtin_amdgcn_readlane(v, 32) + __builtin_amdgcn_readlane(v, 48);
}
__device__ __forceinline__ int wave_sum_i(int v) {
#pragma unroll
    for (int o = 1; o < 64; o <<= 1) v += __shfl_xor(v, o);
    return v;
}

#define XB_TMO      128
#define XB_XCNT(j)  (256  + 64 * (j))
#define XB_XSUB(j)  (1280 + 64 * (j))
#define XB_XGEN(j)  (2304 + 64 * (j))
#define XB_TOP      3328
#define XB_TOPGEN   3392
#define XCD_BAR_WORDS 3456
#define XB_SPIN_CAP (1u << 18)
__device__ __forceinline__ unsigned xb_ld(unsigned* p)              { return __hip_atomic_load(p, __ATOMIC_RELAXED, __HIP_MEMORY_SCOPE_AGENT); }
__device__ __forceinline__ unsigned xb_add(unsigned* p, unsigned v) { return __hip_atomic_fetch_add(p, v, __ATOMIC_RELAXED, __HIP_MEMORY_SCOPE_AGENT); }
__device__ __forceinline__ unsigned xb_xcc_id() { return (unsigned)__builtin_amdgcn_s_getreg((3 << 11) | 20) & 0xFu; }
#define XB_SPIN(cond, bar) do { unsigned _sp = 0; while (cond) { __builtin_amdgcn_s_sleep(1); \
    if ((++_sp & 255u) == 0u) { if (xb_ld(&(bar)[XB_TMO])) break; if (_sp > XB_SPIN_CAP) { atomicAdd(&(bar)[XB_TMO], 1u); break; } } } } while (0)
struct XcdBarrier { unsigned* bar; unsigned x; volatile LAS unsigned* st; };
__device__ __forceinline__ XcdBarrier xcd_barrier_post(unsigned* bar, volatile LAS unsigned* st) {
    XcdBarrier b; b.bar = bar; b.x = xb_xcc_id(); b.st = st;
    if (threadIdx.x == 0) (void)xb_add(&bar[XB_XCNT(b.x)], 1u);
    return b;
}
__device__ __forceinline__ void xcd_barrier_complete(unsigned* bar, unsigned x, unsigned& nloc, unsigned& nx) {
    const unsigned G = gridDim.x * gridDim.y * gridDim.z;
    unsigned sum, cnt, mine, sp = 0u;
    for (;;) {
        sum = 0u; cnt = 0u; mine = 0u;
#pragma unroll
        for (unsigned j = 0; j < 16; ++j) { const unsigned c = xb_ld(&bar[XB_XCNT(j)]); sum += c; cnt += (c > 0u) ? 1u : 0u; mine = (j == x) ? c : mine; }
        if (sum == G) break;
        __builtin_amdgcn_s_sleep(1);
        if ((++sp & 255u) == 0u) { if (xb_ld(&bar[XB_TMO])) break; if (sp > XB_SPIN_CAP) { atomicAdd(&bar[XB_TMO], 1u); break; } }
    }
    nloc = mine > 0u ? mine : 1u; nx = cnt > 0u ? cnt : 1u;
}
__device__ __forceinline__ void xcd_barrier(const XcdBarrier& b) {
    asm volatile("s_waitcnt vmcnt(0)" ::: "memory");
    __syncthreads();
    if (threadIdx.x == 0) {
        unsigned* bar = b.bar;
        __builtin_amdgcn_s_waitcnt(0);
        unsigned nloc = b.st[0], nx = b.st[1];
        if (nloc == 0u) { xcd_barrier_complete(bar, b.x, nloc, nx); b.st[0] = nloc; b.st[1] = nx; }
        const unsigned old = xb_add(&bar[XB_XSUB(b.x)], 1u);
        const unsigned gen = old / nloc;
        if (old + 1u == (gen + 1u) * nloc) {
            __builtin_amdgcn_fence(__ATOMIC_RELEASE, "agent");
            asm volatile("s_waitcnt vmcnt(0)" ::: "memory");
            const unsigned og = xb_add(&bar[XB_TOP], 1u);
            const unsigned tg = og / nx;
            if (og + 1u == (tg + 1u) * nx) xb_add(&bar[XB_TOPGEN], 1u);
            else XB_SPIN(xb_ld(&bar[XB_TOPGEN]) == tg, bar);
            __builtin_amdgcn_fence(__ATOMIC_ACQUIRE, "agent");
            xb_add(&bar[XB_XGEN(b.x)], 1u);
            asm volatile("s_waitcnt vmcnt(0)" ::: "memory");
        } else {
            XB_SPIN(xb_ld(&bar[XB_XGEN(b.x)]) == gen, bar);
            __builtin_amdgcn_fence(__ATOMIC_ACQUIRE, "agent");
            asm volatile("s_waitcnt vmcnt(0)" ::: "memory");
        }
    }
    __syncthreads();
}

namespace pg8 {
constexpr int BM = 256, BK = 64, HALF = 128, HTB = HALF * BK * 2, NXCD = 8, WGM = 8;
__host__ __device__ __forceinline__ int lds_byte(int r, int c) { const int st = (r >> 4) * 2 + (c >> 5), rr = r & 15, cc = c & 31, ob = rr * 64 + cc * 2; return st * 1024 + (ob ^ (((ob >> 9) & 1) << 5)); }
__host__ __device__ __forceinline__ void stage_rc(int b, int& R, int& C) { const int st = b / 1024, sb = b % 1024, swz = sb ^ (((sb >> 9) & 1) << 5); R = (st >> 1) * 16 + swz / 64; C = (st & 1) * 32 + (swz % 64) / 2; }
__host__ __device__ __forceinline__ int perm32(int rho) { const int n = rho >> 4, i = rho & 15; return 8 * (i >> 2) + 4 * n + (i & 3); }

__device__ __forceinline__ bool static_tile(int L, int nM, int nN, int& pm, int& pn) {
    const int nwg = nM * nN; if (L >= nwg) return false;
    int wgid = L; { const int q = nwg / NXCD, r = nwg % NXCD, xcd = wgid % NXCD, off = wgid / NXCD; wgid = (xcd < r ? xcd * (q + 1) : r * (q + 1) + (xcd - r) * q) + off; }
    const int nig = WGM * nN, gid = wgid / nig, fm = gid * WGM, gsz = (nM - fm) < WGM ? (nM - fm) : WGM;
    pm = fm + ((wgid % nig) % gsz); pn = (wgid % nig) / gsz; return true;
}

template <class P>
__device__ __forceinline__ void gemm_phase(LAS unsigned char* lds, P& prob) {
    typedef typename P::U Unit;
    const int tid = threadIdx.x, wid = __builtin_amdgcn_readfirstlane(tid >> 6), lane = tid & 63, wr = wid >> 2, wc = wid & 3, fr = lane & 15, fq = lane >> 4;
    const int K = prob.K, nt = K / BK;
    unsigned voffB[2]; int stR[2], stC[2];
#pragma unroll
    for (int i = 0; i < 2; ++i) { int R, C; stage_rc(tid * 16 + i * 8192, R, C); stR[i] = R; stC[i] = C; const int Rb = P::PERM ? ((R & ~31) + perm32(R & 31)) : R; voffB[i] = (unsigned)(Rb * K + C) * 2u; }
    const size_t kstep = (size_t)(BK * 2);
    const size_t hstep = (size_t)HALF * K * 2;
    const unsigned ldsw = (unsigned)wid * 1024u;
    const int aoff = lds_byte(wr * 64 + fr, fq * 8), boff = lds_byte(wc * 32 + fr, fq * 8);
#define PG8_SA(b, h) (((b) * 2 + (h)) * HTB)
#define PG8_SB(b, h) ((4 + (b) * 2 + (h)) * HTB)
#define PG8_STAGE2(bufoff, gbase, o0, o1) do { \
        __builtin_amdgcn_global_load_lds((const unsigned*)((const char*)(gbase) + (o0)), (LAS unsigned*)(lds + (bufoff) + ldsw), 16, 0, 0); \
        __builtin_amdgcn_global_load_lds((const unsigned*)((const char*)(gbase) + (o1)), (LAS unsigned*)(lds + (bufoff) + ldsw + 8192), 16, 0, 0); } while (0)
#define PG8_STAGE_B(bufoff, gbase, h) PG8_STAGE2(bufoff, (gbase) + (h) * hstep, voffB[0], voffB[1])
#define PG8_LDA(dst, b, h) do { _Pragma("unroll") for (int m = 0; m < 4; ++m) _Pragma("unroll") for (int k = 0; k < 2; ++k) dst[m][k] = *(const LAS bf16x8*)(lds + PG8_SA(b, h) + aoff + m * 2048 + k * 1024); } while (0)
#define PG8_LDB(dst, b, h) do { _Pragma("unroll") for (int n = 0; n < 2; ++n) _Pragma("unroll") for (int k = 0; k < 2; ++k) dst[n][k] = *(const LAS bf16x8*)(lds + PG8_SB(b, h) + boff + n * 2048 + k * 1024); } while (0)
#define PG8_MMA(ai, bj, At, Bt) do { __builtin_amdgcn_s_setprio(1); _Pragma("unroll") for (int m = 0; m < 4; ++m) _Pragma("unroll") for (int n = 0; n < 2; ++n) _Pragma("unroll") for (int k = 0; k < 2; ++k) \
        acc[ai][bj][m][n] = __builtin_amdgcn_mfma_f32_16x16x32_bf16(Bt[n][k], At[m][k], acc[ai][bj][m][n], 0, 0, 0); __builtin_amdgcn_s_setprio(0); } while (0)
#define PG8_WAIT_V(n) asm volatile("s_waitcnt vmcnt(" #n ")" ::: "memory")
#define PG8_WAIT_L(n) asm volatile("s_waitcnt lgkmcnt(" #n ")" ::: "memory")
#define PG8_BAR __builtin_amdgcn_s_barrier()
#define PG8_SCHED __builtin_amdgcn_sched_barrier(0)
    Unit cur, nxt; int ui = 0;
    if (!prob.next(0, cur)) return;
    f32x4 acc[2][2][4][2];
#pragma unroll
    for (int a = 0; a < 2; ++a)
#pragma unroll
        for (int b = 0; b < 2; ++b)
#pragma unroll
            for (int m = 0; m < 4; ++m)
#pragma unroll
                for (int n = 0; n < 2; ++n) acc[a][b][m][n] = (f32x4){0.f, 0.f, 0.f, 0.f};
    bf16x8 At[4][2], B0[2][2], B1[2][2];
    const char* cA; const char* cB; unsigned vc[2][2], vn[2][2];
    prob.ready(cur, true);
    prob.bases(cur, cA, cB); prob.lane_offs(cur, stR, stC, vc);
    PG8_STAGE_B(PG8_SB(0, 0), cB, 0); PG8_STAGE_B(PG8_SB(0, 1), cB, 1); PG8_STAGE2(PG8_SA(0, 0), cA, vc[0][0], vc[0][1]); PG8_STAGE2(PG8_SA(0, 1), cA, vc[1][0], vc[1][1]);
    if (wr == 1) PG8_BAR;
    PG8_WAIT_V(2); PG8_BAR;
    PG8_STAGE_B(PG8_SB(1, 0), cB + kstep, 0); PG8_STAGE2(PG8_SA(1, 0), cA + kstep, vc[0][0], vc[0][1]); PG8_STAGE_B(PG8_SB(1, 1), cB + kstep, 1);
    PG8_WAIT_V(6); PG8_BAR;
    for (;;) {
        const bool has_next = prob.next(ui + 1, nxt);
        const char* nA = cA; const char* nB = cB;
#pragma unroll
        for (int h = 0; h < 2; ++h) { vn[h][0] = vc[h][0]; vn[h][1] = vc[h][1]; }
        if (has_next) { prob.bases(nxt, nA, nB); prob.lane_offs(nxt, stR, stC, vn); }
        for (int t = 0; t < nt; t += 2) {
            const bool last = (t == nt - 2);
            if (last && has_next) prob.ready(nxt, wid == 0);
            const char* a1 = cA + (size_t)(t + 1) * kstep;
            const char* a2 = last ? nA : cA + (size_t)(t + 2) * kstep; const char* b2 = last ? nB : cB + (size_t)(t + 2) * kstep;
            const char* a3 = a2 + kstep; const char* b3 = b2 + kstep;
            const unsigned v00 = last ? vn[0][0] : vc[0][0], v01 = last ? vn[0][1] : vc[0][1], v10 = last ? vn[1][0] : vc[1][0], v11 = last ? vn[1][1] : vc[1][1];
            PG8_LDB(B0, 0, 0); PG8_LDB(B1, 0, 1); PG8_SCHED; PG8_LDA(At, 0, 0); PG8_STAGE2(PG8_SA(1, 1), a1, vc[1][0], vc[1][1]);
            PG8_WAIT_V(8); PG8_WAIT_L(0); PG8_BAR; PG8_MMA(0, 0, At, B0); PG8_MMA(0, 1, At, B1); PG8_BAR; PG8_SCHED;
            PG8_LDA(At, 0, 1); PG8_STAGE_B(PG8_SB(0, 0), b2, 0); PG8_STAGE_B(PG8_SB(0, 1), b2, 1); PG8_STAGE2(PG8_SA(0, 0), a2, v00, v01);
            PG8_WAIT_V(8); PG8_WAIT_L(0); PG8_BAR; PG8_MMA(1, 0, At, B0); PG8_MMA(1, 1, At, B1); PG8_BAR; PG8_SCHED;
            PG8_LDB(B0, 1, 0); PG8_LDB(B1, 1, 1); PG8_SCHED; PG8_LDA(At, 1, 0); PG8_STAGE2(PG8_SA(0, 1), a2, v10, v11);
            PG8_WAIT_V(8); PG8_WAIT_L(0); PG8_BAR; PG8_MMA(0, 0, At, B0); PG8_MMA(0, 1, At, B1); PG8_BAR; PG8_SCHED;
            PG8_LDA(At, 1, 1); PG8_STAGE_B(PG8_SB(1, 0), b3, 0); PG8_STAGE_B(PG8_SB(1, 1), b3, 1); PG8_STAGE2(PG8_SA(1, 0), a3, v00, v01);
            PG8_WAIT_V(8); PG8_WAIT_L(0); PG8_BAR; PG8_MMA(1, 0, At, B0); PG8_MMA(1, 1, At, B1); PG8_BAR; PG8_SCHED;
        }
        if (wr == 0) PG8_BAR;
        prob.epi(acc, cur, wr, wc, fr, fq);
        if (!has_next) break;
        if (!prob.keep(cur)) {
#pragma unroll
            for (int a = 0; a < 2; ++a)
#pragma unroll
                for (int b = 0; b < 2; ++b)
#pragma unroll
                    for (int m = 0; m < 4; ++m)
#pragma unroll
                        for (int n = 0; n < 2; ++n) acc[a][b][m][n] = (f32x4){0.f, 0.f, 0.f, 0.f};
        }
        cur = nxt; cA = nA; cB = nB; ++ui;
#pragma unroll
        for (int h = 0; h < 2; ++h) { vc[h][0] = vn[h][0]; vc[h][1] = vn[h][1]; }
        if (wr == 1) PG8_BAR;
    }
    PG8_WAIT_V(0);
    PG8_BAR;
#undef PG8_SA
#undef PG8_SB
#undef PG8_STAGE2
#undef PG8_STAGE_B
#undef PG8_LDA
#undef PG8_LDB
#undef PG8_MMA
#undef PG8_WAIT_V
#undef PG8_WAIT_L
#undef PG8_BAR
#undef PG8_SCHED
}
}

struct Frame {
    LAS unsigned char* lds;
    unsigned* ctl;
    unsigned char* ws;
    int tid, lane, wave, G, bid;
    const float *x, *c, *w_ada, *b_ada, *g_norm1, *w_in, *g_head, *hglb, *w_attn_up, *w_hgrn_up, *w_out, *g_norm2, *w_rg, *b_rg, *w_re, *b_re, *w_eg, *w_eu, *w_ed, *g_final;
    const int* positions;
    float* out;
};
#define WSP(T, off) ((T*)(F.ws + (off)))

__device__ __forceinline__ int win_phys(int n) {
    if (n < 1280) { const int head = n >> 7, j = n & 127; return head * 128 + (j < 64 ? 2 * j : 2 * (j - 64) + 1); }
    if (n < 1536) return n;
    if (n < 2048) { const int q = n - 1536, head = q >> 6, j = q & 63; return 1536 + head * 64 + (j < 32 ? 2 * j : 2 * (j - 32) + 1); }
    if (n < 2120) return -1;
    return n - 2120 + 2048;
}
struct RmWin { __device__ __forceinline__ int operator()(int n) const { return win_phys(n); } };
struct RmId  { __device__ __forceinline__ int operator()(int n) const { return n; } };
struct RmGate { int up; __device__ __forceinline__ int operator()(int f) const { return 8 * (f >> 2) + 4 * up + (f & 3); } };
template <class RM>
__device__ __forceinline__ void transpose_item(const float* W, int K, int N, bf16_t* WT, LAS float* scr, int item, int lane, RM rm) {
    const int nblk = (N + 31) / 32, kb = item / nblk, nb = item % nblk, k0 = 64 * kb, n0 = 32 * nb;
    const int nn = n0 + (lane & 31);
    float tv[32];
#pragma unroll
    for (int i = 0; i < 32; ++i) { const int kk = 2 * i + (lane >> 5); tv[i] = (nn < N) ? W[(size_t)(k0 + kk) * N + nn] : 0.f; }
#pragma unroll
    for (int i = 0; i < 32; ++i) { const int kk = 2 * i + (lane >> 5); scr[kk * 33 + (lane & 31)] = tv[i]; }
    LDS_WAIT(); asm volatile("" ::: "memory");
    const int c = lane & 7;
#pragma unroll
    for (int j = 0; j < 4; ++j) { const int n = (lane >> 3) + 8 * j; const LAS float* s = scr + (8 * c) * 33 + n;
        u32x4 o; o.x = pk2(s[0 * 33], s[1 * 33]); o.y = pk2(s[2 * 33], s[3 * 33]); o.z = pk2(s[4 * 33], s[5 * 33]); o.w = pk2(s[6 * 33], s[7 * 33]);
        if (n0 + n < N) { const int rr = rm(n0 + n); if (rr >= 0) *(u32x4*)(WT + (size_t)rr * K + k0 + 8 * c) = o; } }
    LDS_WAIT(); asm volatile("" ::: "memory");
}

struct TDesc { const float* W; bf16_t* WT; int K, N, kind, item; };
__device__ __forceinline__ int td_row(int kind, int n) { return kind == 0 ? n : kind == 1 ? win_phys(n) : (8 * (n >> 2) + 4 * (kind - 2) + (n & 3)); }
__device__ __forceinline__ void td_load(const TDesc& d, int lane, float (&tv)[32]) {
    const int nblk = (d.N + 31) / 32, kb = d.item / nblk, nb = d.item % nblk, k0 = 64 * kb, n0 = 32 * nb;
    int nn = n0 + (lane & 31); nn = nn < d.N ? nn : d.N - 1;
    const float* p = d.W + (size_t)(k0 + (lane >> 5)) * d.N + nn;
#pragma unroll
    for (int i = 0; i < 32; ++i) tv[i] = __builtin_nontemporal_load(p + (size_t)(2 * i) * d.N);
}
__device__ __forceinline__ void td_lds(const float (&tv)[32], int lane, LAS float* scr) {
#pragma unroll
    for (int i = 0; i < 32; ++i) { const int kk = 2 * i + (lane >> 5); scr[kk * 33 + (lane & 31)] = tv[i]; }
}
__device__ __forceinline__ void td_store(const TDesc& d, int lane, LAS float* scr) {
    const int nblk = (d.N + 31) / 32, kb = d.item / nblk, nb = d.item % nblk, k0 = 64 * kb, n0 = 32 * nb;
    const int c = lane & 7;
#pragma unroll
    for (int j = 0; j < 4; ++j) { const int n = (lane >> 3) + 8 * j; const LAS float* sp = scr + (8 * c) * 33 + n;
        u32x4 o; o.x = pk2(sp[0 * 33], sp[1 * 33]); o.y = pk2(sp[2 * 33], sp[3 * 33]); o.z = pk2(sp[4 * 33], sp[5 * 33]); o.w = pk2(sp[6 * 33], sp[7 * 33]);
        if (n0 + n < d.N) { const int rr = td_row(d.kind, n0 + n); if (rr >= 0) *(u32x4*)(d.WT + (size_t)rr * d.K + k0 + 8 * c) = o; } }
}
#define TD_STREAM(it0_, stride_, total_, DESC, lane_, scr_) do { float tv_[32]; TDesc dc_, dn_; int it_ = (it0_); \
    if (it_ < (total_)) { DESC(it_, dc_); td_load(dc_, (lane_), tv_); } \
    for (; it_ < (total_); it_ += (stride_)) { td_lds(tv_, (lane_), (scr_)); __builtin_amdgcn_sched_barrier(0); \
        const bool hn_ = it_ + (stride_) < (total_); if (hn_) { DESC(it_ + (stride_), dn_); td_load(dn_, (lane_), tv_); } \
        LDS_WAIT(); asm volatile("" ::: "memory"); td_store(dc_, (lane_), (scr_)); LDS_WAIT(); asm volatile("" ::: "memory"); if (hn_) dc_ = dn_; } } while (0)

__device__ __forceinline__ void p0_prologue(Frame& F) {
    const int gw = F.bid * NWAVES + F.wave, NGW = F.G * NWAVES;
    {
        LAS float* red = (LAS float*)F.lds;
        float* MODP = WSP(float, WS_MODP);
        for (int task = F.bid; task < 48 * 16; task += F.G) {
            const int cg = task % 48, ks = task / 48;
            f32x4 a0 = {0.f, 0.f, 0.f, 0.f}, a1 = {0.f, 0.f, 0.f, 0.f};
            const int kb = ks * 128 + F.wave * 16;
#pragma unroll 16
            for (int i = 0; i < 16; ++i) { const int k = kb + i; const f32x4 wv = __builtin_nontemporal_load((const f32x4*)(F.w_ada + (size_t)k * 12288 + cg * 256 + 4 * F.lane));
                const float s0 = siluf_(F.c[k]), s1 = siluf_(F.c[DM + k]); a0 += wv * s0; a1 += wv * s1; }
            *(LAS f32x4*)(red + (F.wave * 2 + 0) * 256 + 4 * F.lane) = a0; *(LAS f32x4*)(red + (F.wave * 2 + 1) * 256 + 4 * F.lane) = a1;
            __syncthreads();
            { const int b = F.tid >> 8, col = F.tid & 255; float s = 0.f;
#pragma unroll
              for (int w = 0; w < 8; ++w) s += red[(w * 2 + b) * 256 + col];
              MODP[((size_t)ks * 2 + b) * 12288 + cg * 256 + col] = s; }
            __syncthreads();
        }
    }
    {
        LAS float* scr = (LAS float*)(F.lds + F.wave * 16384);
        constexpr int I_IN = 32 * 323, I_AU = 16 * 64, I_HU = 16 * 64, I_OUT = 32 * 64;
        constexpr int NITEMS = I_IN + I_AU + I_HU + I_OUT;
#define P0_DESC(it, d) do { int r_ = (it); \
            if (r_ < I_IN) { d.W = F.w_in; d.K = DM; d.N = NLOG; d.WT = WSP(bf16_t, WS_WIN_T); d.kind = 1; d.item = r_; } \
            else if ((r_ -= I_IN) < I_AU) { d.W = F.w_attn_up; d.K = 1024; d.N = DM; d.WT = WSP(bf16_t, WS_WAU_T); d.kind = 0; d.item = r_; } \
            else if ((r_ -= I_AU) < I_HU) { d.W = F.w_hgrn_up; d.K = 1024; d.N = DM; d.WT = WSP(bf16_t, WS_WHU_T); d.kind = 0; d.item = r_; } \
            else { r_ -= I_HU; d.W = F.w_out; d.K = DM; d.N = DM; d.WT = WSP(bf16_t, WS_WOUT_T); d.kind = 0; d.item = r_; } } while (0)
        TD_STREAM(gw, NGW, NITEMS, P0_DESC, F.lane, scr);
#undef P0_DESC
        { bf16_t* W40 = WSP(bf16_t, WS_W40T); const int gt = F.bid * NTHREADS + F.tid, NGT = F.G * NTHREADS;
          for (int e = gt; e < 96 * 256; e += NGT) { const int n = e >> 8, k0 = (e & 255) * 8; u32x4 o = {0u, 0u, 0u, 0u};
              if (n < 72) { const int col = (n < 64) ? (2048 + (n >> 1) + 32 * (n & 1)) : (2112 + (n - 64)); const float* p = F.w_in + (size_t)k0 * NLOG + col;
                  o.x = pk2(p[0], p[NLOG]); o.y = pk2(p[2 * (size_t)NLOG], p[3 * (size_t)NLOG]); o.z = pk2(p[4 * (size_t)NLOG], p[5 * (size_t)NLOG]); o.w = pk2(p[6 * (size_t)NLOG], p[7 * (size_t)NLOG]); }
              *(u32x4*)(W40 + (size_t)n * DM + k0) = o; } }
    }
    {
        f32x2* TA = WSP(f32x2, WS_TABA); f32x2* TI = WSP(f32x2, WS_TABI);
        const int gt = F.bid * NTHREADS + F.tid, NGT = F.G * NTHREADS;
        for (int e = gt; e < M * 96; e += NGT) {
            const int m = e / 96, r = e % 96; const float pos = (float)F.positions[m];
            float inv; if (r < 64) inv = powf(10000.0f, -(float)(2 * r) / 128.0f); else inv = powf(10000.0f, -(float)(2 * (r - 64)) / 64.0f);
            const float ang = pos * inv; float sn, cs; sincosf(ang, &sn, &cs);
            if (r < 64) TA[(size_t)m * 64 + r] = (f32x2){cs, sn}; else TI[(size_t)m * 32 + (r - 64)] = (f32x2){cs, sn};
        }
    }
}

__device__ __forceinline__ float row_rstd_nt(const float* xrow, int lane, f32x4 (&v)[8]) {
    float s = 0.f;
#pragma unroll
    for (int j = 0; j < 8; ++j) { v[j] = __builtin_nontemporal_load((const f32x4*)xrow + lane + 64 * j); s += (v[j].x * v[j].x + v[j].y * v[j].y) + (v[j].z * v[j].z + v[j].w * v[j].w); }
    return 1.0f / sqrtf(wave_sum(s) * (1.0f / DM) + EPS);
}
__device__ __forceinline__ float row_rstd(const float* xrow, int lane, f32x4 (&v)[8]) {
    float s = 0.f;
#pragma unroll
    for (int j = 0; j < 8; ++j) { v[j] = ((const f32x4*)xrow)[lane + 64 * j]; s += (v[j].x * v[j].x + v[j].y * v[j].y) + (v[j].z * v[j].z + v[j].w * v[j].w); }
    return 1.0f / sqrtf(wave_sum(s) * (1.0f / DM) + EPS);
}

__device__ __forceinline__ f32x16 mfma32(bf16x8 a, bf16x8 b, f32x16 c) { return __builtin_amdgcn_mfma_f32_32x32x16_bf16(a, b, c, 0, 0, 0); }
__device__ __forceinline__ int crow(int r, int hi) { return (r & 3) + 8 * (r >> 2) + 4 * hi; }
__device__ __forceinline__ void p1_norm1(Frame& F) {
    LAS float* CA = (LAS float*)(F.lds + LDS_EXTRA); LAS float* CB = CA + DM;
    LAS unsigned char* HB = F.lds;
    const float* MODP = WSP(float, WS_MODP); float* MOD = WSP(float, WS_MOD);
    const int lane = F.lane, r32 = lane & 31, hi = lane >> 5;
    for (int idx = F.bid * NTHREADS + F.tid; idx < 2 * 12288; idx += F.G * NTHREADS) { const int b = idx / 12288, j = idx % 12288; float s = F.b_ada[j]; float pv[16];
#pragma unroll
        for (int ks = 0; ks < 16; ++ks) pv[ks] = MODP[((size_t)ks * 2 + b) * 12288 + j];
        __builtin_amdgcn_sched_barrier(0);
#pragma unroll
        for (int ks = 0; ks < 16; ++ks) s += pv[ks];
        MOD[idx] = s; }
    for (int rb = F.bid; rb < M / 32; rb += F.G) {
        const int b = (rb * 32) / SEQ;
        __syncthreads();
#pragma unroll
        for (int kk = 0; kk < DM / NTHREADS; ++kk) { __builtin_amdgcn_sched_barrier(0); const int k = F.tid + kk * NTHREADS; float sh = F.b_ada[k], sc = F.b_ada[DM + k]; const float gn = F.g_norm1[k]; float p0[16], p1[16];
#pragma unroll
            for (int ks = 0; ks < 16; ++ks) { p0[ks] = MODP[((size_t)ks * 2 + b) * 12288 + k]; p1[ks] = MODP[((size_t)ks * 2 + b) * 12288 + DM + k]; }
            __builtin_amdgcn_sched_barrier(0);
#pragma unroll
            for (int ks = 0; ks < 16; ++ks) { sh += p0[ks]; sc += p1[ks]; }
            CA[k] = gn * (1.0f + sc); CB[k] = sh; }
        __syncthreads();
        bf16_t* XN = WSP(bf16_t, WS_XN);
#pragma unroll 1
        for (int r = 0; r < 4; ++r) { const int rl = F.wave * 4 + r, m = rb * 32 + rl; f32x4 v[8]; const float rs = row_rstd_nt(F.x + (size_t)m * DM, lane, v);
#pragma unroll
            for (int j = 0; j < 8; ++j) { const int k = 4 * (lane + 64 * j); const f32x4 a = *(const LAS f32x4*)(CA + k), bb = *(const LAS f32x4*)(CB + k);
                const f32x4 h = v[j] * rs * a + bb; u32x2 o; o.x = pk2(h.x, h.y); o.y = pk2(h.z, h.w); *(u32x2*)(XN + (size_t)m * DM + k) = o; *(LAS u32x2*)(HB + rl * 4112 + k * 2) = o; } }
        __syncthreads();
        f32x16 acc[3]; acc[0] = f32x16{}; acc[1] = f32x16{}; acc[2] = f32x16{};
        { const bf16_t* W40 = WSP(bf16_t, WS_W40T) + (size_t)r32 * DM + 256 * F.wave + 8 * hi;
#pragma unroll
          for (int kb = 0; kb < 8; ++kb) { bf16x8 bq[2][3];
#pragma unroll
              for (int ks = 0; ks < 2; ++ks)
#pragma unroll
                  for (int nt = 0; nt < 3; ++nt) bq[ks][nt] = *(const bf16x8*)(W40 + (size_t)nt * 32 * DM + 16 * (2 * kb + ks));
              __builtin_amdgcn_sched_barrier(0);
#pragma unroll
              for (int ks = 0; ks < 2; ++ks) { const bf16x8 a = *(const LAS bf16x8*)(HB + r32 * 4112 + (256 * F.wave + 16 * (2 * kb + ks) + 8 * hi) * 2);
#pragma unroll
                  for (int nt = 0; nt < 3; ++nt) acc[nt] = mfma32(a, bq[ks][nt], acc[nt]); }
              __builtin_amdgcn_sched_barrier(0); } }
        __syncthreads();
        LAS float* PS = (LAS float*)HB;
#pragma unroll
        for (int nt = 0; nt < 3; ++nt)
#pragma unroll
            for (int r = 0; r < 16; ++r) PS[(F.wave * 96 + nt * 32 + r32) * 33 + crow(r, hi)] = acc[nt][r];
        __syncthreads();
        { bf16_t* IK = WSP(bf16_t, WS_IK); float* IW = WSP(float, WS_IW); const f32x2* TI = WSP(f32x2, WS_TABI);
          int tv = F.tid; asm volatile("" : "+v"(tv));
#pragma unroll
          for (int j = 0; j < 2; ++j) { const int idx = tv + 512 * j, row = idx >> 5, i = idx & 31; float x1 = 0.f, x2 = 0.f;
#pragma unroll
              for (int w = 0; w < 8; ++w) { x1 += PS[(w * 96 + 2 * i) * 33 + row]; x2 += PS[(w * 96 + 2 * i + 1) * 33 + row]; }
              const int m = rb * 32 + row; const f32x2 cs = TI[(size_t)m * 32 + i];
              *(unsigned*)(IK + (size_t)m * 64 + 2 * i) = pk2(x1 * cs.x - x2 * cs.y, x2 * cs.x + x1 * cs.y); }
          if (F.tid < 256) { const int row = F.tid >> 3, hh = F.tid & 7; float v = 0.f;
#pragma unroll
              for (int w = 0; w < 8; ++w) v += PS[(w * 96 + 64 + hh) * 33 + row];
              IW[(size_t)(rb * 32 + row) * 8 + hh] = v * IDX_SCALE; } }
    }
}

struct UnitT { int pm, pn, aux; };
struct ProbBase {
    typedef UnitT U;
    int K, G, c;
    __device__ __forceinline__ void lane_offs_plain(const int (&stR)[2], const int (&stC)[2], unsigned (&va)[2][2]) const {
#pragma unroll
        for (int h = 0; h < 2; ++h)
#pragma unroll
            for (int i = 0; i < 2; ++i) va[h][i] = (unsigned)((h * 128 + stR[i]) * K + stC[i]) * 2u;
    }
    __device__ __forceinline__ bool keep(const U&) const { return false; }
    __device__ __forceinline__ void ready(const U&, bool) const {}
};

struct ProbWin : ProbBase {
    static constexpr bool PERM = true;
    const char* A; const char* B; unsigned char* ws; const float* hglb;
    __device__ __forceinline__ bool next(int i, U& u) const { u.aux = 0; return pg8::static_tile(i * G + c, M / 256, NPHYS / 256, u.pm, u.pn); }
    __device__ __forceinline__ void bases(const U& u, const char*& a, const char*& b) const { a = A + (size_t)u.pm * 256 * K * 2; b = B + (size_t)u.pn * 256 * K * 2; }
    __device__ __forceinline__ void lane_offs(const U&, const int (&stR)[2], const int (&stC)[2], unsigned (&va)[2][2]) const { lane_offs_plain(stR, stC, va); }
    __device__ __forceinline__ void epi(f32x4 (&acc)[2][2][4][2], const U& u, int wr, int wc, int fr, int fq) const {
        const int pn = u.pn, row0 = u.pm * 256 + wr * 64 + fr, colw = wc * 32 + 8 * fq;
        if (pn <= 4 || pn == 6 || pn == 7 || pn == 40) {
            const bool d128 = (pn <= 4);
            const float* tab = d128 ? (const float*)(ws + WS_TABA) : (const float*)(ws + WS_TABI);
            const int tp = d128 ? 128 : 64;
            const int i0 = d128 ? (colw >> 1) : (((wc & 1) * 32 + 8 * fq) >> 1);
            bf16_t* O; int pitch, cb; float sc = 1.f;
            if (pn < 4) { O = (bf16_t*)(ws + WS_AQ); pitch = 1024; cb = pn * 256; sc = ATT_SCALE_L2E; }
            else if (pn == 4) { O = (bf16_t*)(ws + WS_AK); pitch = 256; cb = 0; }
            else if (pn < 8) { O = (bf16_t*)(ws + WS_IQ); pitch = 512; cb = (pn - 6) * 256; }
            else { O = (bf16_t*)(ws + WS_IK); pitch = 64; cb = 0; }
            f32x4 tt0[8], tt1[8];
#pragma unroll
            for (int ai = 0; ai < 2; ++ai)
#pragma unroll
                for (int m = 0; m < 4; ++m) { const int row = row0 + ai * 128 + m * 16; tt0[ai * 4 + m] = *(const f32x4*)(tab + (size_t)row * tp + 2 * i0); tt1[ai * 4 + m] = *(const f32x4*)(tab + (size_t)row * tp + 2 * i0 + 4); }
            __builtin_amdgcn_sched_barrier(0);
#pragma unroll
            for (int ai = 0; ai < 2; ++ai)
#pragma unroll
                for (int m = 0; m < 4; ++m) { const int row = row0 + ai * 128 + m * 16;
                    const f32x4 t0 = tt0[ai * 4 + m], t1 = tt1[ai * 4 + m];
#pragma unroll
                    for (int bj = 0; bj < 2; ++bj) {
                        if (pn == 40 && (bj == 1 || wc >= 2)) {
                            if (bj == 0 && wc == 2 && fq == 0) { float* IW = (float*)(ws + WS_IW);
                                *(f32x4*)(IW + (size_t)row * 8) = acc[ai][0][m][0] * IDX_SCALE; *(f32x4*)(IW + (size_t)row * 8 + 4) = acc[ai][0][m][1] * IDX_SCALE; }
                            continue; }
                        const f32x4 v0 = acc[ai][bj][m][0], v1 = acc[ai][bj][m][1];
                        const float o0 = v0[0] * t0[0] - v0[1] * t0[1], o1 = v0[1] * t0[0] + v0[0] * t0[1], o2 = v0[2] * t0[2] - v0[3] * t0[3], o3 = v0[3] * t0[2] + v0[2] * t0[3];
                        const float o4 = v1[0] * t1[0] - v1[1] * t1[1], o5 = v1[1] * t1[0] + v1[0] * t1[1], o6 = v1[2] * t1[2] - v1[3] * t1[3], o7 = v1[3] * t1[2] + v1[2] * t1[3];
                        u32x4 w; w.x = pk2(o0 * sc, o1 * sc); w.y = pk2(o2 * sc, o3 * sc); w.z = pk2(o4 * sc, o5 * sc); w.w = pk2(o6 * sc, o7 * sc);
                        *(u32x4*)(O + (size_t)row * pitch + cb + bj * 128 + colw) = w; } }
        } else if (pn == 5) {
            bf16_t* O = (bf16_t*)(ws + WS_AVT);
#pragma unroll
            for (int ai = 0; ai < 2; ++ai)
#pragma unroll
                for (int m = 0; m < 4; ++m) { const int row = row0 + ai * 128 + m * 16, b = row >> 12, s = row & 4095;
#pragma unroll
                    for (int bj = 0; bj < 2; ++bj)
#pragma unroll
                        for (int n = 0; n < 2; ++n)
#pragma unroll
                            for (int e = 0; e < 4; ++e) { const int d = colw + 4 * n + e; O[((size_t)((b * 2 + bj) * 128 + d)) * SEQ + s] = (bf16_t)(pk2(acc[ai][bj][m][n][e], 0.f) & 0xffffu); } }
        } else if (pn >= 12 && pn < 16) {
            float* LF = (float*)(ws + WS_LOGF); bf16_t* KFo = (bf16_t*)(ws + WS_KF);
            const int cb = (pn - 12) * 256;
            f32x4 lb[2][2];
#pragma unroll
            for (int bj = 0; bj < 2; ++bj)
#pragma unroll
                for (int n = 0; n < 2; ++n) { const int cc = cb + bj * 128 + colw + 4 * n; const f32x4 a0 = *(const f32x4*)(hglb + cc), a1 = *(const f32x4*)(hglb + 1024 + cc);
#pragma unroll
                    for (int e = 0; e < 4; ++e) lb[bj][n][e] = frcp(1.0f + fexp(a1[e] - a0[e])); }
#pragma unroll
            for (int ai = 0; ai < 2; ++ai)
#pragma unroll
                for (int m = 0; m < 4; ++m) { const int row = row0 + ai * 128 + m * 16;
#pragma unroll
                    for (int bj = 0; bj < 2; ++bj) { f32x4 lf[2], kf[2];
#pragma unroll
                        for (int n = 0; n < 2; ++n)
#pragma unroll
                            for (int e = 0; e < 4; ++e) { float xx = acc[ai][bj][m][n][e]; xx = fminf(fmaxf(xx, -30.f), 30.f); const float ee = fexp(-xx), sg = frcp(1.0f + ee), sgn = ee * sg; const float l = lb[bj][n][e];
                                const float f = l + (1.0f - l) * sg; lf[n][e] = __logf(f); kf[n][e] = (1.0f - l) * sgn; }
                        const size_t off = (size_t)row * 1024 + cb + bj * 128 + colw;
                        *(f32x4*)(LF + off) = lf[0]; *(f32x4*)(LF + off + 4) = lf[1];
                        u32x4 w; w.x = pk2(kf[0][0], kf[0][1]); w.y = pk2(kf[0][2], kf[0][3]); w.z = pk2(kf[1][0], kf[1][1]); w.w = pk2(kf[1][2], kf[1][3]);
                        *(u32x4*)(KFo + off) = w; } }
        } else {
            bf16_t* O; int pitch, cb, act;
            if (pn < 12) { O = (bf16_t*)(ws + WS_HQ); pitch = 1024; cb = (pn - 8) * 256; act = 1; }
            else if (pn < 20) { O = (bf16_t*)(ws + WS_HI); pitch = 1024; cb = (pn - 16) * 256; act = 0; }
            else if (pn < 24) { O = (bf16_t*)(ws + WS_HOG); pitch = 1024; cb = (pn - 20) * 256; act = 1; }
            else if (pn < 32) { O = (bf16_t*)(ws + WS_GA); pitch = 2048; cb = (pn - 24) * 256; act = 2; }
            else { O = (bf16_t*)(ws + WS_GH); pitch = 2048; cb = (pn - 32) * 256; act = 2; }
#pragma unroll
            for (int ai = 0; ai < 2; ++ai)
#pragma unroll
                for (int m = 0; m < 4; ++m) { const int row = row0 + ai * 128 + m * 16;
#pragma unroll
                    for (int bj = 0; bj < 2; ++bj) { f32x4 v0 = acc[ai][bj][m][0], v1 = acc[ai][bj][m][1];
                        if (act == 1) {
#pragma unroll
                            for (int e = 0; e < 4; ++e) { v0[e] = siluf_(v0[e]); v1[e] = siluf_(v1[e]); } }
                        else if (act == 2) {
#pragma unroll
                            for (int e = 0; e < 4; ++e) { v0[e] = sigmoidf_(v0[e]); v1[e] = sigmoidf_(v1[e]); } }
                        u32x4 w; w.x = pk2(v0[0], v0[1]); w.y = pk2(v0[2], v0[3]); w.z = pk2(v1[0], v1[1]); w.w = pk2(v1[2], v1[3]);
                        *(u32x4*)(O + (size_t)row * pitch + cb + bj * 128 + colw) = w; } }
        }
    }
};

__device__ __forceinline__ void p3_indexer(Frame& F) {
    const bf16_t* IQ = WSP(bf16_t, WS_IQ); const bf16_t* IK = WSP(bf16_t, WS_IK); const float* IW = WSP(float, WS_IW); float* SC = WSP(float, WS_SCORES);
    const int gw = F.bid * NWAVES + F.wave, NGW = F.G * NWAVES, lane = F.lane, q = lane & 15, quad = lane >> 4;
    for (int it = gw; it < 2 * 2176; it += NGW) {
        const int b = it / 2176; int r = it % 2176; int qg = 0; while (r >= 16 * (qg + 1)) { r -= 16 * (qg + 1); ++qg; }
        const int qi = 16 * qg + r / (qg + 1), ch = r % (qg + 1);
        const int kt0 = 16 * ch, kt1 = min(16 * ch + 16, qi + 1);
        const size_t qrow = (size_t)b * SEQ + 16 * qi + q;
        bf16x8 bq[8][2];
#pragma unroll
        for (int h = 0; h < 8; ++h)
#pragma unroll
            for (int ks = 0; ks < 2; ++ks) bq[h][ks] = *(const bf16x8*)(IQ + qrow * 512 + h * 64 + 32 * ks + 8 * quad);
        const f32x4 w0 = *(const f32x4*)(IW + qrow * 8), w1 = *(const f32x4*)(IW + qrow * 8 + 4);
        const float wv[8] = {w0[0], w0[1], w0[2], w0[3], w1[0], w1[1], w1[2], w1[3]};
        f32x4 scs[16];
        bf16x8 na[4][2];
        const bf16_t* kbase = IK + ((size_t)b * SEQ + q) * 64 + 8 * quad;
        const int ntl = kt1 - kt0, rot = (gw * 5 + (gw >> 4)) % ntl;
#define IX_TILE(j_) (kt0 + (((j_) + rot) % ntl))
#pragma unroll
        for (int j = 0; j < 4; ++j) { const int kt = IX_TILE(j); na[j][0] = *(const bf16x8*)(kbase + (size_t)kt * 1024); na[j][1] = *(const bf16x8*)(kbase + (size_t)kt * 1024 + 32); }
#define IX_BODY(j) { \
                const bf16x8 a0 = na[(j) & 3][0], a1 = na[(j) & 3][1]; \
                if ((j) + 4 < 16) { const int ktn = IX_TILE((j) + 4); na[(j) & 3][0] = *(const bf16x8*)(kbase + (size_t)ktn * 1024); na[(j) & 3][1] = *(const bf16x8*)(kbase + (size_t)ktn * 1024 + 32); } \
                f32x4 dh[8]; \
                _Pragma("unroll") for (int h = 0; h < 8; ++h) dh[h] = __builtin_amdgcn_mfma_f32_16x16x32_bf16(a0, bq[h][0], (f32x4){0.f, 0.f, 0.f, 0.f}, 0, 0, 0); \
                _Pragma("unroll") for (int h = 0; h < 8; ++h) dh[h] = __builtin_amdgcn_mfma_f32_16x16x32_bf16(a1, bq[h][1], dh[h], 0, 0, 0); \
                f32x4 sc = {0.f, 0.f, 0.f, 0.f}; \
                _Pragma("unroll") for (int h = 0; h < 8; ++h) _Pragma("unroll") for (int e = 0; e < 4; ++e) { const int bi = (int)__float_as_uint(dh[h][e]); sc[e] += wv[h] * __uint_as_float((unsigned)(bi > 0 ? bi : 0)); } \
                scs[j] = sc; }
        if (ntl == 16) {
#pragma unroll
            for (int j = 0; j < 16; ++j) IX_BODY(j)
        } else {
#pragma unroll
            for (int j = 0; j < 16; ++j) { scs[j] = (f32x4){0.f, 0.f, 0.f, 0.f}; if (j < ntl) IX_BODY(j) }
        }
#undef IX_BODY
#pragma unroll
        for (int j = 0; j < 16; ++j) { if (j < ntl) *(f32x4*)(SC + qrow * SEQ + 16 * IX_TILE(j) + 4 * quad) = scs[j]; }
#undef IX_TILE
    }
}

constexpr int HG_QD = 0, HG_KD = 17408, HG_VT = 34816, HG_KET = 53248, HG_ATT = 71680, HG_TOT = 80896, HG_O = 83968;

__device__ __forceinline__ void hg_cum(Frame& F, float (&cum)[16], float& cum_last) {
    LAS float* tot = (LAS float*)(F.lds + HG_TOT);
    const int seg = F.tid >> 7, k = F.tid & 127;
    float run = 0.f;
#pragma unroll
    for (int i = 0; i < 16; ++i) { run += cum[i]; cum[i] = run; }
    tot[seg * 128 + k] = run;
    __syncthreads();
    float pre = 0.f, all = 0.f;
#pragma unroll
    for (int s = 0; s < 4; ++s) { const float t = tot[s * 128 + k]; all += t; if (s < seg) pre += t; }
#pragma unroll
    for (int i = 0; i < 16; ++i) cum[i] += pre;
    cum_last = all;
}

__device__ __forceinline__ void p3_hgrn_upd(Frame& F) {
    const float* LOGF = WSP(float, WS_LOGF); const bf16_t* KF = WSP(bf16_t, WS_KF); const bf16_t* HI = WSP(bf16_t, WS_HI);
    float* UPDT = WSP(float, WS_UPDT); float* DEC = WSP(float, WS_DECAY);
    LAS bf16_t* VT = (LAS bf16_t*)(F.lds + HG_VT); LAS bf16_t* KET = (LAS bf16_t*)(F.lds + HG_KET);
    const int seg = F.tid >> 7, k = F.tid & 127, lane = F.lane, r32 = lane & 31, hi = lane >> 5;
    float lf[16]; bf16_t lk[16], lv[16];
#define HGU_LOAD(tile_) do { const int b_ = (tile_) >> 9, n_ = ((tile_) >> 3) & 63, h_ = (tile_) & 7; const size_t ob_ = ((size_t)b_ * SEQ + 64 * n_ + 16 * seg) * 1024 + h_ * 128 + k; \
        _Pragma("unroll") for (int i = 0; i < 16; ++i) { lf[i] = LOGF[ob_ + i * 1024]; lk[i] = KF[ob_ + i * 1024]; lv[i] = HI[ob_ + i * 1024]; } } while (0)
    if (F.bid < 1024) HGU_LOAD(F.bid);
    for (int tile = F.bid; tile < 1024; tile += F.G) {
        __syncthreads();
        float cum[16], cl;
#pragma unroll
        for (int i = 0; i < 16; ++i) cum[i] = lf[i];
        hg_cum(F, cum, cl);
        { unsigned pk[8], pv[8];
#pragma unroll
          for (int i = 0; i < 16; i += 2) {
              const float k0 = bf2f(lk[i]) * fexp(cl - cum[i]), k1 = bf2f(lk[i + 1]) * fexp(cl - cum[i + 1]); pk[i >> 1] = pk2(k0, k1);
              pv[i >> 1] = (unsigned)lv[i] | ((unsigned)lv[i + 1] << 16); }
          LAS u32x4* dk = (LAS u32x4*)(KET + k * 72 + 16 * seg); dk[0] = (u32x4){pk[0], pk[1], pk[2], pk[3]}; dk[1] = (u32x4){pk[4], pk[5], pk[6], pk[7]};
          LAS u32x4* dv = (LAS u32x4*)(VT + k * 72 + 16 * seg); dv[0] = (u32x4){pv[0], pv[1], pv[2], pv[3]}; dv[1] = (u32x4){pv[4], pv[5], pv[6], pv[7]};
          if (seg == 0) DEC[(size_t)tile * 128 + k] = fexp(cl); }
        __builtin_amdgcn_sched_barrier(0);
        if (tile + F.G < 1024) HGU_LOAD(tile + F.G);
        __syncthreads();
        const int vt = F.wave & 3, kt0 = (F.wave >> 2) * 2;
        f32x16 c0 = {}, c1 = {};
#pragma unroll
        for (int ks = 0; ks < 4; ++ks) { const bf16x8 a = *(const LAS bf16x8*)(VT + (vt * 32 + r32) * 72 + 16 * ks + 8 * hi);
            const bf16x8 b0 = *(const LAS bf16x8*)(KET + (kt0 * 32 + r32) * 72 + 16 * ks + 8 * hi), b1 = *(const LAS bf16x8*)(KET + (kt0 * 32 + 32 + r32) * 72 + 16 * ks + 8 * hi);
            c0 = mfma32(a, b0, c0); c1 = mfma32(a, b1, c1); }
        float* U = UPDT + (size_t)tile * 16384;
#pragma unroll
        for (int r = 0; r < 16; ++r) { const int v = vt * 32 + crow(r, hi); U[v * 128 + kt0 * 32 + r32] = c0[r]; U[v * 128 + kt0 * 32 + 32 + r32] = c1[r]; }
    }
#undef HGU_LOAD
}

__device__ __forceinline__ void p4_hgrn_scan(Frame& F) {
    const float* UPDT = WSP(float, WS_UPDT); const float* DEC = WSP(float, WS_DECAY); bf16_t* SP = WSP(bf16_t, WS_SPREVT);
    const int gt = F.bid * NTHREADS + F.tid, NGT = F.G * NTHREADS;
    for (int e = gt; e < 2 * 8 * 16384 / 2; e += NGT) {
        const int bh = e >> 13, vk = (e & 8191) * 2, b = bh >> 3, h = bh & 7, k = vk & 127;
        float s0 = 0.f, s1 = 0.f;
#pragma unroll 8
        for (int n = 0; n < 64; ++n) { const size_t tile = (size_t)(b * 64 + n) * 8 + h;
            const f32x2 u = __builtin_nontemporal_load((const f32x2*)(UPDT + tile * 16384 + vk)), d = *(const f32x2*)(DEC + tile * 128 + k);
            *(unsigned*)(SP + tile * 16384 + vk) = pk2(s0, s1);
            s0 = d.x * s0 + u.x; s1 = d.y * s1 + u.y; }
    }
}

__device__ __forceinline__ void p5_hgrn_out(Frame& F) {
    const float* LOGF = WSP(float, WS_LOGF); const bf16_t* KF = WSP(bf16_t, WS_KF); const bf16_t* HI = WSP(bf16_t, WS_HI); const bf16_t* HQ = WSP(bf16_t, WS_HQ);
    const bf16_t* HOG = WSP(bf16_t, WS_HOG); const bf16_t* SP = WSP(bf16_t, WS_SPREVT); bf16_t* YHG = WSP(bf16_t, WS_YHG);
    LAS bf16_t* QD = (LAS bf16_t*)(F.lds + HG_QD); LAS bf16_t* KD = (LAS bf16_t*)(F.lds + HG_KD); LAS bf16_t* VT = (LAS bf16_t*)(F.lds + HG_VT);
    LAS bf16_t* ATT = (LAS bf16_t*)(F.lds + HG_ATT); LAS float* OB = (LAS float*)(F.lds + HG_O);
    const int seg = F.tid >> 7, k = F.tid & 127, lane = F.lane, r32 = lane & 31, hi = lane >> 5;
    float lf[16]; bf16_t lq[16], lk[16], lv[16];
#define HGO_LOAD(tile_) do { const int b_ = (tile_) >> 9, n_ = ((tile_) >> 3) & 63, h_ = (tile_) & 7; const size_t ob_ = ((size_t)b_ * SEQ + 64 * n_ + 16 * seg) * 1024 + h_ * 128 + k; \
        _Pragma("unroll") for (int i = 0; i < 16; ++i) { lf[i] = LOGF[ob_ + i * 1024]; lq[i] = HQ[ob_ + i * 1024]; lk[i] = KF[ob_ + i * 1024]; lv[i] = HI[ob_ + i * 1024]; } } while (0)
    if (F.bid < 1024) HGO_LOAD(F.bid);
    for (int tile = F.bid; tile < 1024; tile += F.G) {
        const int b = tile >> 9, n = (tile >> 3) & 63, h = tile & 7; const size_t m0 = (size_t)b * SEQ + 64 * n;
        __syncthreads();
        float cum[16], cl;
#pragma unroll
        for (int i = 0; i < 16; ++i) cum[i] = lf[i];
        hg_cum(F, cum, cl);
        { unsigned pv[8];
          __builtin_amdgcn_sched_barrier(0);
#pragma unroll
          for (int i = 0; i < 16; ++i) {
              const float qd = bf2f(lq[i]) * fexp(cum[i]), kd = bf2f(lk[i]) * fexp(-cum[i]);
              QD[(16 * seg + i) * 136 + k] = (bf16_t)(pk2(qd, 0.f) & 0xffffu); KD[(16 * seg + i) * 136 + k] = (bf16_t)(pk2(kd, 0.f) & 0xffffu);
              if (i & 1) pv[i >> 1] |= ((unsigned)lv[i] << 16); else pv[i >> 1] = (unsigned)lv[i]; }
          LAS u32x4* dv = (LAS u32x4*)(VT + k * 72 + 16 * seg); dv[0] = (u32x4){pv[0], pv[1], pv[2], pv[3]}; dv[1] = (u32x4){pv[4], pv[5], pv[6], pv[7]}; }
        const int tt = F.wave >> 2, vt = F.wave & 3;
        bf16x8 sb[8];
        { const bf16_t* S = SP + (size_t)tile * 16384 + (size_t)(vt * 32 + r32) * 128;
#pragma unroll
          for (int ks = 0; ks < 8; ++ks) sb[ks] = *(const bf16x8*)(S + 16 * ks + 8 * hi); }
        __builtin_amdgcn_sched_barrier(0);
        if (tile + F.G < 1024) HGO_LOAD(tile + F.G);
        __syncthreads();
        if (F.wave < 4) { const int ta = F.wave >> 1, sa = F.wave & 1; f32x16 c = {};
            if (sa <= ta) {
#pragma unroll
                for (int ks = 0; ks < 8; ++ks) { const bf16x8 a = *(const LAS bf16x8*)(QD + (ta * 32 + r32) * 136 + 16 * ks + 8 * hi), bb = *(const LAS bf16x8*)(KD + (sa * 32 + r32) * 136 + 16 * ks + 8 * hi); c = mfma32(a, bb, c); } }
#pragma unroll
            for (int r = 0; r < 16; ++r) { const int t = ta * 32 + crow(r, hi), s = sa * 32 + r32; const float v = (s <= t) ? c[r] : 0.f; ATT[t * 72 + s] = (bf16_t)(pk2(v, 0.f) & 0xffffu); } }
        f32x16 o = {};
        {
#pragma unroll
          for (int ks = 0; ks < 8; ++ks) { const bf16x8 a = *(const LAS bf16x8*)(QD + (tt * 32 + r32) * 136 + 16 * ks + 8 * hi); o = mfma32(a, sb[ks], o); } }
        __syncthreads();
#pragma unroll
        for (int ks = 0; ks < 4; ++ks) { const bf16x8 a = *(const LAS bf16x8*)(ATT + (tt * 32 + r32) * 72 + 16 * ks + 8 * hi), bb = *(const LAS bf16x8*)(VT + (vt * 32 + r32) * 72 + 16 * ks + 8 * hi); o = mfma32(a, bb, o); }
#pragma unroll
        for (int r = 0; r < 16; ++r) OB[(tt * 32 + crow(r, hi)) * 132 + vt * 32 + r32] = o[r];
        __syncthreads();
        { const int t = F.tid >> 3, part = F.tid & 7; float v[16], ss = 0.f;
#pragma unroll
          for (int i = 0; i < 16; i += 4) { const f32x4 x = *(const LAS f32x4*)(OB + t * 132 + part * 16 + i); v[i] = x[0]; v[i + 1] = x[1]; v[i + 2] = x[2]; v[i + 3] = x[3]; ss += (x[0] * x[0] + x[1] * x[1]) + (x[2] * x[2] + x[3] * x[3]); }
          ss += __shfl_xor(ss, 1); ss += __shfl_xor(ss, 2); ss += __shfl_xor(ss, 4);
          const float rs = 1.0f / sqrtf(ss * (1.0f / 128.0f) + EPS);
          const size_t off = (m0 + t) * 1024 + h * 128 + part * 16; unsigned w[8];
          const u32x4 g0 = *(const u32x4*)(HOG + off), g1 = *(const u32x4*)(HOG + off + 8); const unsigned gg[8] = {g0.x, g0.y, g0.z, g0.w, g1.x, g1.y, g1.z, g1.w};
          const float* ghp = F.g_head + h * 128 + part * 16; const f32x4 gh0 = *(const f32x4*)ghp, gh1 = *(const f32x4*)(ghp + 4), gh2 = *(const f32x4*)(ghp + 8), gh3 = *(const f32x4*)(ghp + 12);
          const float ghv[16] = {gh0[0], gh0[1], gh0[2], gh0[3], gh1[0], gh1[1], gh1[2], gh1[3], gh2[0], gh2[1], gh2[2], gh2[3], gh3[0], gh3[1], gh3[2], gh3[3]};
#pragma unroll
          for (int i = 0; i < 8; ++i) { w[i] = pk2(v[2 * i] * rs * ghv[2 * i] * bf2f(gg[i] & 0xffffu), v[2 * i + 1] * rs * ghv[2 * i + 1] * bf2f(gg[i] >> 16)); }
          *(u32x4*)(YHG + off) = (u32x4){w[0], w[1], w[2], w[3]}; *(u32x4*)(YHG + off + 8) = (u32x4){w[4], w[5], w[6], w[7]}; }
    }
}

__device__ __forceinline__ unsigned f2ord(float f) { const unsigned u = __float_as_uint(f); return (u & 0x80000000u) ? ~u : (u | 0x80000000u); }
__device__ __forceinline__ void p4_sel_load(const float* SC, int row, int lane, unsigned (&nu)[64]) {
    const int t = row & (SEQ - 1);
    if (t >= TOPK) { const float* srow = SC + (size_t)row * SEQ; const int ng = (t >> 9) + 1;
#pragma unroll
        for (int g = 0; g < 8; ++g) {
            if (g < ng) {
#pragma unroll
                for (int j = 0; j < 8; ++j) nu[8 * g + j] = __float_as_uint(__builtin_nontemporal_load(srow + 64 * (8 * g + j) + lane));
            }
        }
    }
}
__device__ __forceinline__ void p4_select(Frame& F) {
    const float* SC = WSP(float, WS_SCORES); unsigned long long* MASK = WSP(unsigned long long, WS_MASK);
    const int gw = F.bid * NWAVES + F.wave, NGW = F.G * NWAVES, lane = F.lane;
    constexpr int NPAIR = NBATCH * (SEQ / 2);
#define SEL_ROW(k_) ({ const int idx_ = gw + ((k_) >> 1) * NGW; const int b_ = idx_ / (SEQ / 2), p_ = idx_ % (SEQ / 2); b_ * SEQ + (((k_) & 1) ? (SEQ - 1 - p_) : p_); })
#define SEL_HAVE(k_) (gw + ((k_) >> 1) * NGW < NPAIR)
    unsigned nu[64];
#pragma unroll
    for (int i = 0; i < 64; ++i) nu[i] = 0u;
    int k = 0; bool have = SEL_HAVE(0); int row = have ? SEL_ROW(0) : 0;
    if (have) p4_sel_load(SC, row, lane, nu);
    while (have) {
        const int t = row & (SEQ - 1);
        unsigned long long mine = 0ull;
        unsigned u[64];
        const int ng = (t >> 9) + 1;
        if (t >= TOPK) {
#pragma unroll
            for (int g = 0; g < 8; ++g) {
                if (g < ng) {
#pragma unroll
                    for (int j = 0; j < 8; ++j) { const int i = 8 * g + j; const unsigned bits = nu[i]; u[i] = bits ^ ((unsigned)((int)bits >> 31) | 0x80000000u); }
                    if (g == ng - 1) {
#pragma unroll
                        for (int j = 0; j < 8; ++j) { const int i = 8 * g + j, s = 64 * i + lane; u[i] = (s <= t) ? u[i] : 0u; }
                    }
                } else {
#pragma unroll
                    for (int j = 0; j < 8; ++j) u[8 * g + j] = 0u;
                }
            }
        }
        __builtin_amdgcn_sched_barrier(0);
        ++k; const bool haveN = SEL_HAVE(k); const int rowN = haveN ? SEL_ROW(k) : 0;
        if (haveN) p4_sel_load(SC, rowN, lane, nu);
        __builtin_amdgcn_sched_barrier(0);
        if (t < TOPK) {
            const int lo = 64 * lane;
            mine = (t >= lo + 63) ? ~0ull : (t < lo ? 0ull : ((1ull << (t - lo + 1)) - 1ull));
        } else {
            const int ntot = 512 * ng;
            unsigned hp[32];
#pragma unroll
            for (int i = 0; i < 32; ++i) hp[i] = (u[2 * i] >> 16) | (u[2 * i + 1] & 0xffff0000u);
            unsigned T = 0u; bool exact = false; int geT = ntot;
            { const unsigned one2 = 0x00010001u; unsigned Th = 0u;
              for (int bit = 15; bit >= 0; --bit) {
                  const unsigned ch = Th | (1u << bit); unsigned c2 = ch | (ch << 16), acc2 = 0u;
                  asm volatile("" : "+v"(c2));
#pragma unroll
                  for (int g = 0; g < 8; ++g) {
                      if (g < ng) {
#pragma unroll
                          for (int j = 0; j < 4; ++j) { unsigned d;
                              asm("v_pk_sub_u16 %0, %1, %2 clamp" : "=v"(d) : "v"(c2), "v"(hp[4 * g + j]));
                              asm("v_pk_min_u16 %0, %1, %2" : "=v"(d) : "v"(d), "v"(one2));
                              asm("v_pk_add_u16 %0, %1, %2" : "=v"(acc2) : "v"(acc2), "v"(d)); }
                      }
                  }
                  const int ge = ntot - wave_sum_i_dpp((int)((acc2 & 0xffffu) + (acc2 >> 16)));
                  if (ge >= TOPK) { Th = ch; geT = ge; if (ge == TOPK) { exact = true; break; } }
              }
              T = Th << 16; }
            if (!exact) {
                for (int bit = 15; bit >= 0; --bit) {
                    unsigned cand = T | (1u << bit); int c = 0;
                    asm volatile("" : "+v"(cand));
#pragma unroll
                    for (int g = 0; g < 8; ++g) {
                        if (g < ng) {
#pragma unroll
                            for (int j = 0; j < 8; j += 2) { unsigned d0, d1;
                                asm("v_sub_u32_e64 %0, %1, %2 clamp" : "=v"(d0) : "v"(cand), "v"(u[8 * g + j]));
                                asm("v_sub_u32_e64 %0, %1, %2 clamp" : "=v"(d1) : "v"(cand), "v"(u[8 * g + j + 1]));
                                asm("v_min_u32_e32 %0, 1, %1" : "=v"(d0) : "v"(d0));
                                asm("v_min_u32_e32 %0, 1, %1" : "=v"(d1) : "v"(d1));
                                c += (int)(d0 + d1); }
                        }
                    }
                    const int ge = ntot - wave_sum_i_dpp(c);
                    if (ge >= TOPK) { T = cand; geT = ge; if (ge == TOPK) break; }
                }
            }
            const bool allties = (geT == TOPK);
            int need = 0;
            if (!allties) { int cg = 0;
#pragma unroll
                for (int g = 0; g < 8; ++g) {
                    if (g < ng) {
#pragma unroll
                        for (int j = 0; j < 8; ++j) cg += (u[8 * g + j] > T) ? 1 : 0;
                    }
                }
                need = TOPK - wave_sum_i_dpp(cg); }
            int running = 0; const unsigned long long lt = (1ull << lane) - 1ull;
#pragma unroll
            for (int g = 0; g < 8; ++g) {
                if (g < ng) {
#pragma unroll
                    for (int j = 0; j < 8; ++j) { const int i = 8 * g + j;
                        unsigned long long sb;
                        if (allties) sb = __ballot(u[i] >= T);
                        else { const bool eq = (u[i] == T); const unsigned long long bal = __ballot(eq);
                            const int rank = running + __popcll(bal & lt); running += __popcll(bal);
                            sb = __ballot((u[i] > T) || (eq && rank < need)); }
                        if (lane == i) mine = sb; }
                }
            }
        }
        MASK[(size_t)row * 64 + lane] = mine;
        row = rowN; have = haveN;
    }
#undef SEL_ROW
#undef SEL_HAVE
}

constexpr int AT_K = 0, AT_V = 34816, AT_END = 34816 + 34816;
constexpr int AT_MRG = 0, AT_STG = 69632;
__device__ __forceinline__ void p5_attention(Frame& F) {
    const bf16_t* AQ = WSP(bf16_t, WS_AQ); const bf16_t* AK = WSP(bf16_t, WS_AK); const bf16_t* AVT = WSP(bf16_t, WS_AVT); const unsigned* MASK = WSP(unsigned, WS_MASK); bf16_t* YATT = WSP(bf16_t, WS_YATT);
    const int lane = F.lane, r32 = lane & 31, hi = lane >> 5, w = F.wave, kp = w >> 2, tid = F.tid;
    LAS unsigned char* lds = F.lds;
    for (int item = F.bid; item < 256; item += F.G) {
        const int b = item >> 7, hk = (item >> 6) & 1, jj = item & 63;
        for (int uu = 0; uu < 2; ++uu) {
            const int j = uu ? 127 - jj : jj;
            const int head = hk * 4 + (w & 3);
            const size_t qrow = (size_t)b * SEQ + 32 * j + r32;
            const int NT = (j + 2) >> 1, NI = (NT + 1) >> 1;
            bf16x8 qf[8];
#pragma unroll
            for (int ks = 0; ks < 8; ++ks) qf[ks] = *(const bf16x8*)(AQ + qrow * 1024 + head * 128 + 16 * ks + 8 * hi);
            f32x16 o[4]; o[0] = f32x16{}; o[1] = f32x16{}; o[2] = f32x16{}; o[3] = f32x16{};
            float mrun = -INFINITY, lrun = 0.f;
            u32x4 sk[4], sv[4];
#pragma unroll
            for (int c = 0; c < 4; ++c) { sk[c] = (u32x4){0u, 0u, 0u, 0u}; sv[c] = (u32x4){0u, 0u, 0u, 0u}; }
            const bf16_t* Kg = AK + (size_t)b * SEQ * 256 + hk * 128;
            const bf16_t* Vg = AVT + (size_t)((b * 2 + hk) * 128) * SEQ;
#define AT_LOAD(it_) do { int tv = tid; asm volatile("" : "+v"(tv)); const unsigned kb2 = (unsigned)(it_) * 128u; \
                const unsigned ko = ((kb2 + (unsigned)(tv >> 4)) * 256u + (unsigned)(tv & 15) * 8u) * 2u; \
                const unsigned vo = ((unsigned)(tv >> 3) * (unsigned)SEQ + kb2 + (unsigned)(tv & 7) * 8u) * 2u; \
                _Pragma("unroll") for (int c = 0; c < 4; ++c) { \
                    sk[c] = *(const u32x4*)((const char*)Kg + ko + (unsigned)c * 32u * 512u); \
                    sv[c] = *(const u32x4*)((const char*)Vg + vo + (unsigned)(c & 1) * 64u * (unsigned)SEQ * 2u + (unsigned)(c >> 1) * 128u); } } while (0)
#define AT_STORE(bo_) do { \
                _Pragma("unroll") for (int c = 0; c < 4; ++c) { const int id = c * 512 + tid; const int key = id >> 4, ch = id & 15; \
                    *(LAS u32x4*)(lds + (bo_) + AT_K + key * 272 + ch * 16) = sk[c]; \
                    const int vd = (id >> 3) & 127, vp = id >> 10, vc = id & 7; \
                    LAS u32x2* dst = (LAS u32x2*)(lds + (bo_) + AT_V + vp * 17408 + vd * 136 + vc * 16); dst[0] = (u32x2){sv[c].x, sv[c].y}; dst[1] = (u32x2){sv[c].z, sv[c].w}; } } while (0)
            AT_LOAD(0);
            u32x2 mwn = (kp < NT) ? *(const u32x2*)(MASK + qrow * 128 + 2 * kp) : (u32x2){0u, 0u};
            __syncthreads();
            AT_STORE(0);
            if (NI > 1) AT_LOAD(1);
            __syncthreads();
            for (int it = 0; it < NI; ++it) {
                const int bo = (it & 1) * 69632;
                if (kp == 1 && it + 1 < NI) { AT_STORE(((it + 1) & 1) * 69632); if (it + 2 < NI) AT_LOAD(it + 2); }
                const int kt = 2 * it + kp;
                const u32x2 mw = mwn;
                if (kt + 2 < NT) mwn = *(const u32x2*)(MASK + qrow * 128 + 2 * (kt + 2));
                if (kt < NT) {
                    const LAS unsigned char* Kp = lds + bo + AT_K + kp * 17408; const LAS unsigned char* Vp = lds + bo + AT_V + kp * 17408;
                    f32x16 p0 = {}, p1 = {};
                    { bf16x8 kf[2][2][2];
#define AT_KLOAD(ks_, buf_) do { kf[buf_][(ks_) & 1][0] = *(const LAS bf16x8*)(Kp + r32 * 272 + (16 * (ks_) + 8 * hi) * 2); kf[buf_][(ks_) & 1][1] = *(const LAS bf16x8*)(Kp + (32 + r32) * 272 + (16 * (ks_) + 8 * hi) * 2); } while (0)
                      AT_KLOAD(0, 0); AT_KLOAD(1, 0);
#pragma unroll
                      for (int kk = 0; kk < 4; ++kk) {
                          __builtin_amdgcn_sched_barrier(0);
                          if (kk < 3) { AT_KLOAD(2 * kk + 2, (kk + 1) & 1); AT_KLOAD(2 * kk + 3, (kk + 1) & 1); }
#pragma unroll
                          for (int k2 = 0; k2 < 2; ++k2) { p0 = mfma32(kf[kk & 1][k2][0], qf[2 * kk + k2], p0); p1 = mfma32(kf[kk & 1][k2][1], qf[2 * kk + k2], p1); } }
#undef AT_KLOAD
                    }
                    __builtin_amdgcn_sched_barrier(0);
                    u32x4 vf[2][4];
#define AT_VLOAD(dt_, buf_) do { _Pragma("unroll") for (int s = 0; s < 4; ++s) { const LAS unsigned char* vr = Vp + ((dt_) * 32 + r32) * 136 + (16 * s + 4 * hi) * 2; \
                        const u32x2 lo = *(const LAS u32x2*)vr, hh = *(const LAS u32x2*)(vr + 16); vf[buf_][s] = (u32x4){lo.x, lo.y, hh.x, hh.y}; } } while (0)
                    AT_VLOAD(0, 0);
                    float rm = fmaxf(p0[0], p1[0]);
#pragma unroll
                    for (int r = 1; r < 16; ++r) rm = fmaxf(rm, fmaxf(p0[r], p1[r]));
                    rm = fmaxf(rm, __shfl_xor(rm, 32));
                    if (__any(rm > mrun + 8.0f)) { const float mnew = fmaxf(mrun, rm), alpha = __builtin_amdgcn_exp2f(mrun - mnew); lrun *= alpha; mrun = mnew;
#pragma unroll
                        for (int dt = 0; dt < 4; ++dt)
#pragma unroll
                            for (int r = 0; r < 16; ++r) o[dt][r] *= alpha; }
                    const int mx0 = (int)(mw.x >> (4 * hi)), mx1 = (int)(mw.y >> (4 * hi));
                    float ps = 0.f;
#pragma unroll
                    for (int r = 0; r < 16; ++r) { const int bp = (r & 3) + 8 * (r >> 2);
                        int k0 = __builtin_amdgcn_sbfe(mx0, bp, 1), k1 = __builtin_amdgcn_sbfe(mx1, bp, 1);
                        asm volatile("" : "+v"(k0), "+v"(k1));
                        p0[r] = __uint_as_float(__float_as_uint(__builtin_amdgcn_exp2f(p0[r] - mrun)) & (unsigned)k0);
                        p1[r] = __uint_as_float(__float_as_uint(__builtin_amdgcn_exp2f(p1[r] - mrun)) & (unsigned)k1);
                        ps += p0[r] + p1[r]; }
                    lrun += ps;
                    bf16x8 pb[4];
#pragma unroll
                    for (int s = 0; s < 2; ++s) { u32x4 t0, t1;
                        t0.x = pk2(p0[8 * s + 0], p0[8 * s + 1]); t0.y = pk2(p0[8 * s + 2], p0[8 * s + 3]); t0.z = pk2(p0[8 * s + 4], p0[8 * s + 5]); t0.w = pk2(p0[8 * s + 6], p0[8 * s + 7]);
                        t1.x = pk2(p1[8 * s + 0], p1[8 * s + 1]); t1.y = pk2(p1[8 * s + 2], p1[8 * s + 3]); t1.z = pk2(p1[8 * s + 4], p1[8 * s + 5]); t1.w = pk2(p1[8 * s + 6], p1[8 * s + 7]);
                        pb[s] = __builtin_bit_cast(bf16x8, t0); pb[2 + s] = __builtin_bit_cast(bf16x8, t1); }
#pragma unroll
                    for (int dt = 0; dt < 4; ++dt) {
                        __builtin_amdgcn_sched_barrier(0);
                        if (dt < 3) AT_VLOAD(dt + 1, (dt + 1) & 1);
#pragma unroll
                        for (int s = 0; s < 4; ++s) o[dt] = mfma32(__builtin_bit_cast(bf16x8, vf[dt & 1][s]), pb[s], o[dt]); }
#undef AT_VLOAD
                    __builtin_amdgcn_sched_barrier(0);
                }
                if (kp == 0 && it + 1 < NI) { AT_STORE(((it + 1) & 1) * 69632); if (it + 2 < NI) AT_LOAD(it + 2); }
                __syncthreads();
            }
            __syncthreads();
            LAS float* mg = (LAS float*)(lds + AT_MRG) + (w & 3) * 66 * 64;
            if (kp == 1) { mg[lane] = mrun; mg[64 + lane] = lrun;
#pragma unroll
                for (int dt = 0; dt < 4; ++dt)
#pragma unroll
                    for (int r = 0; r < 16; ++r) mg[(2 + dt * 16 + r) * 64 + lane] = o[dt][r]; }
            __syncthreads();
            if (kp == 0) {
                const float m1 = mg[lane], l1 = mg[64 + lane];
                const float mt = fmaxf(mrun, m1), mu = (mt == -INFINITY) ? 0.f : mt;
                const float a0 = __builtin_amdgcn_exp2f(mrun - mu), a1 = __builtin_amdgcn_exp2f(m1 - mu);
                float l = lrun * a0 + l1 * a1; l += __shfl_xor(l, 32);
                const float inv = 1.0f / l;
                LAS bf16_t* stg = (LAS bf16_t*)(lds + AT_STG) + (w & 3) * 32 * 136;
#pragma unroll
                for (int dt = 0; dt < 4; ++dt)
#pragma unroll
                    for (int r = 0; r < 16; ++r) { const float v = (o[dt][r] * a0 + mg[(2 + dt * 16 + r) * 64 + lane] * a1) * inv; stg[r32 * 136 + dt * 32 + crow(r, hi)] = (bf16_t)(pk2(v, 0.f) & 0xffffu); }
                LDS_WAIT();
#pragma unroll
                for (int i = 0; i < 8; ++i) { const int rr = i * 4 + (lane >> 4), ch = lane & 15; const u32x4 v = *(const LAS u32x4*)(stg + rr * 136 + ch * 8);
                    *(u32x4*)(YATT + ((size_t)b * SEQ + 32 * j + rr) * 1024 + head * 128 + ch * 8) = v; }
            }
        }
    }
#undef AT_LOAD
#undef AT_STORE
}

struct ProbMerge : ProbBase {
    static constexpr bool PERM = true;
    unsigned char* ws;
    __device__ __forceinline__ bool next(int i, U& u) const { u.aux = i & 1; return pg8::static_tile((i >> 1) * G + c, M / 256, DM / 256, u.pm, u.pn); }
    __device__ __forceinline__ void bases(const U& u, const char*& a, const char*& b) const {
        a = (const char*)(ws + (u.aux ? WS_YHG : WS_YATT)) + (size_t)u.pm * 256 * K * 2; b = (const char*)(ws + (u.aux ? WS_WHU_T : WS_WAU_T)) + (size_t)u.pn * 256 * K * 2; }
    __device__ __forceinline__ void lane_offs(const U&, const int (&stR)[2], const int (&stC)[2], unsigned (&va)[2][2]) const { lane_offs_plain(stR, stC, va); }
    __device__ __forceinline__ bool keep(const U& u) const { return u.aux == 0; }
    __device__ __forceinline__ void epi(f32x4 (&acc)[2][2][4][2], const U& u, int wr, int wc, int fr, int fq) const {
        const bf16_t* GA = (const bf16_t*)(ws + WS_GA); const bf16_t* GH = (const bf16_t*)(ws + WS_GH); bf16_t* O = (bf16_t*)(ws + WS_MERGED);
        const int row0 = u.pm * 256 + wr * 64 + fr, colw = u.pn * 256 + wc * 32 + 8 * fq;
#pragma unroll
        for (int ai = 0; ai < 2; ++ai) {
            u32x4 gh[4][2], ga[4][2];
#pragma unroll
            for (int m = 0; m < 4; ++m)
#pragma unroll
                for (int bj = 0; bj < 2; ++bj) { const size_t off = (size_t)(row0 + ai * 128 + m * 16) * DM + colw + bj * 128; gh[m][bj] = *(const u32x4*)(GH + off); if (u.aux == 0) ga[m][bj] = __builtin_nontemporal_load((const u32x4*)(GA + off)); else ga[m][bj] = gh[m][bj]; }
            __builtin_amdgcn_sched_barrier(0);
#pragma unroll
            for (int m = 0; m < 4; ++m)
#pragma unroll
                for (int bj = 0; bj < 2; ++bj) { const size_t off = (size_t)(row0 + ai * 128 + m * 16) * DM + colw + bj * 128;
                    const unsigned ghw[4] = {gh[m][bj].x, gh[m][bj].y, gh[m][bj].z, gh[m][bj].w}; const unsigned gaw[4] = {ga[m][bj].x, ga[m][bj].y, ga[m][bj].z, ga[m][bj].w};
                    if (u.aux == 0) {
#pragma unroll
                        for (int n = 0; n < 2; ++n)
#pragma unroll
                            for (int e = 0; e < 4; ++e) { const int wi = 2 * n + (e >> 1); const float a = (e & 1) ? bf2f(gaw[wi] >> 16) : bf2f(gaw[wi] & 0xffffu), h = (e & 1) ? bf2f(ghw[wi] >> 16) : bf2f(ghw[wi] & 0xffffu);
                                acc[ai][bj][m][n][e] *= a * frcp(fmaxf(h, 1e-20f)); } }
                    else { float v[8];
#pragma unroll
                        for (int n = 0; n < 2; ++n)
#pragma unroll
                            for (int e = 0; e < 4; ++e) { const int wi = 2 * n + (e >> 1); const float h = (e & 1) ? bf2f(ghw[wi] >> 16) : bf2f(ghw[wi] & 0xffffu); v[4 * n + e] = acc[ai][bj][m][n][e] * h; }
                        u32x4 w; w.x = pk2(v[0], v[1]); w.y = pk2(v[2], v[3]); w.z = pk2(v[4], v[5]); w.w = pk2(v[6], v[7]); *(u32x4*)(O + off) = w; } }
            __builtin_amdgcn_sched_barrier(0);
        }
    }
};

struct ProbOut : ProbBase {
    static constexpr bool PERM = false;
    unsigned char* ws; const float* x; float* out;
    __device__ __forceinline__ bool next(int i, U& u) const { u.aux = 0; return pg8::static_tile(i * G + c, M / 256, DM / 256, u.pm, u.pn); }
    __device__ __forceinline__ void bases(const U& u, const char*& a, const char*& b) const { a = (const char*)(ws + WS_MERGED) + (size_t)u.pm * 256 * K * 2; b = (const char*)(ws + WS_WOUT_T) + (size_t)u.pn * 256 * K * 2; }
    __device__ __forceinline__ void lane_offs(const U&, const int (&stR)[2], const int (&stC)[2], unsigned (&va)[2][2]) const { lane_offs_plain(stR, stC, va); }
    __device__ __forceinline__ void epi(f32x4 (&acc)[2][2][4][2], const U& u, int wr, int wc, int fr, int fq) const {
        const float* MOD = (const float*)(ws + WS_MOD);
        const int row0 = u.pm * 256 + wr * 64 + fr, col0 = u.pn * 256 + wc * 32 + 4 * fq, b = (u.pm * 256) >> 12;
#pragma unroll
        for (int bj = 0; bj < 2; ++bj)
#pragma unroll
            for (int n = 0; n < 2; ++n) { const int col = col0 + bj * 128 + n * 16; const f32x4 gt = *(const f32x4*)(MOD + b * 12288 + 2 * DM + col);
                f32x4 xv[8];
#pragma unroll
                for (int ai = 0; ai < 2; ++ai)
#pragma unroll
                    for (int m = 0; m < 4; ++m) xv[ai * 4 + m] = __builtin_nontemporal_load((const f32x4*)(x + (size_t)(row0 + ai * 128 + m * 16) * DM + col));
                __builtin_amdgcn_sched_barrier(0);
#pragma unroll
                for (int ai = 0; ai < 2; ++ai)
#pragma unroll
                    for (int m = 0; m < 4; ++m) { const size_t off = (size_t)(row0 + ai * 128 + m * 16) * DM + col; *(f32x4*)(out + off) = xv[ai * 4 + m] + gt * acc[ai][bj][m][n]; }
                __builtin_amdgcn_sched_barrier(0); }
    }
};

__device__ __forceinline__ void p8_norm2_route(Frame& F) {
    LAS float* CA = (LAS float*)F.lds; LAS float* CB = CA + DM;
    LAS float* WB = CB + DM;
    LAS float* LOGI = WB + 2 * 9216;
    const float* MOD = WSP(float, WS_MOD); bf16_t* XN = WSP(bf16_t, WS_XN); const float* X1 = F.out;
    int* LIST = WSP(int, WS_LIST); float* LISTW = WSP(float, WS_LISTW);
    const int lane = F.lane, tid = F.tid;
#define RT_STAGE(j_, buf_) do { int lv_ = lane; asm volatile("" : "+v"(lv_)); _Pragma("unroll") for (int i_ = 0; i_ < 5; ++i_) { const int id0_ = i_ * 512 + F.wave * 64; if (id0_ < 2304) { const int id_ = id0_ + lv_, rho_ = id_ / 9, q_ = id_ - rho_ * 9; \
            const int k_ = (j_) * 256 + 4 * (rho_ & 63) + (rho_ >> 6); const float* src_ = (q_ == 0) ? (F.w_rg + (size_t)k_ * 4) : (F.w_re + (size_t)k_ * 32 + (q_ - 1) * 4); \
            __builtin_amdgcn_global_load_lds((const unsigned*)src_, (LAS unsigned*)(WB + (buf_) * 9216 + id0_ * 4), 16, 0, 0); } } } while (0)
    for (int rb = F.bid; rb < M / 32; rb += F.G) {
        const int b = (rb * 32) / SEQ;
        __syncthreads();
        for (int k = tid; k < DM; k += NTHREADS) { CA[k] = F.g_norm2[k] * (1.0f + MOD[b * 12288 + 4 * DM + k]); CB[k] = MOD[b * 12288 + 3 * DM + k]; }
        RT_STAGE(0, 0);
        __syncthreads();
        const int mb = rb * 32 + F.wave * 4;
        float rs[4];
#pragma unroll
        for (int r = 0; r < 4; ++r) { __builtin_amdgcn_sched_barrier(0); f32x4 v[8]; rs[r] = row_rstd(X1 + (size_t)(mb + r) * DM, lane, v);
#pragma unroll
            for (int j = 0; j < 8; ++j) { const int k = 4 * (lane + 64 * j); const f32x4 a = *(const LAS f32x4*)(CA + k), bb = *(const LAS f32x4*)(CB + k);
                const f32x4 h = v[j] * rs[r] * a + bb; u32x2 o; o.x = pk2(h.x, h.y); o.y = pk2(h.z, h.w); *(u32x2*)(XN + (size_t)(mb + r) * DM + k) = o; } }
        LAS float* red = WB + F.wave * 2304;
#pragma unroll 1
        for (int half = 0; half < 2; ++half) {
            const int m0 = mb + 2 * half;
            const float rs0 = half ? rs[2] : rs[0], rs1 = half ? rs[3] : rs[1];
            float acc[2][36];
#pragma unroll
            for (int r = 0; r < 2; ++r)
#pragma unroll
                for (int j = 0; j < 36; ++j) acc[r][j] = 0.f;
            if (half) { __syncthreads(); RT_STAGE(0, 0); }
            f32x4 xc[2];
            xc[0] = *(const f32x4*)(X1 + (size_t)m0 * DM + 4 * lane); xc[1] = *(const f32x4*)(X1 + (size_t)(m0 + 1) * DM + 4 * lane);
#pragma unroll 1
            for (int j = 0; j < 8; ++j) {
                __syncthreads();
                if (j < 7) RT_STAGE(j + 1, (j + 1) & 1);
                const f32x4 ca = *(const LAS f32x4*)(CA + 256 * j + 4 * lane), cb = *(const LAS f32x4*)(CB + 256 * j + 4 * lane);
                const f32x4 h0 = xc[0] * rs0 * ca + cb, h1 = xc[1] * rs1 * ca + cb;
                if (j < 7) { xc[0] = *(const f32x4*)(X1 + (size_t)m0 * DM + 256 * (j + 1) + 4 * lane); xc[1] = *(const f32x4*)(X1 + (size_t)(m0 + 1) * DM + 256 * (j + 1) + 4 * lane); }
                const LAS float* wb = WB + (j & 1) * 9216;
#pragma unroll
                for (int e = 0; e < 4; ++e)
#pragma unroll
                    for (int q = 0; q < 9; ++q) { const f32x4 wv = *(const LAS f32x4*)(wb + (e * 64 + lane) * 36 + q * 4);
#pragma unroll
                        for (int c = 0; c < 4; ++c) { acc[0][q * 4 + c] += h0[e] * wv[c]; acc[1][q * 4 + c] += h1[e] * wv[c]; } }
            }
            __syncthreads();
#pragma unroll
            for (int r = 0; r < 2; ++r) {
#pragma unroll
                for (int q = 0; q < 9; ++q) *(LAS f32x4*)(red + lane * 36 + q * 4) = (f32x4){acc[r][q * 4], acc[r][q * 4 + 1], acc[r][q * 4 + 2], acc[r][q * 4 + 3]};
                LDS_WAIT(); asm volatile("" ::: "memory");
                if (lane < 36) { float sm = 0.f;
#pragma unroll 16
                    for (int l = 0; l < 64; ++l) sm += red[l * 36 + lane];
                    LOGI[(F.wave * 2 + r) * 36 + lane] = sm + (lane < 4 ? F.b_rg[lane] : F.b_re[lane - 4]); }
                LDS_WAIT(); asm volatile("" ::: "memory");
            }
            if (lane < 2) {
                const LAS float* lg = LOGI + (F.wave * 2 + lane) * 36;
                int grp = 0; float gm = lg[0];
#pragma unroll
                for (int g = 1; g < 4; ++g) if (lg[g] > gm) { gm = lg[g]; grp = g; }
                float gs = 0.f;
#pragma unroll
                for (int g = 0; g < 4; ++g) gs += expf(lg[g] - gm);
                const float pgrp = 1.0f / gs;
                float el[8];
#pragma unroll
                for (int e = 0; e < 8; ++e) { el[e] = lg[4 + e]; if (grp == 1) el[e] = lg[12 + e]; if (grp == 2) el[e] = lg[20 + e]; if (grp == 3) el[e] = lg[28 + e]; }
                int e0 = 0; float v0 = el[0];
#pragma unroll
                for (int e = 1; e < 8; ++e) if (el[e] > v0) { v0 = el[e]; e0 = e; }
                int e1 = -1; float v1 = -INFINITY;
#pragma unroll
                for (int e = 0; e < 8; ++e) if (e != e0 && el[e] > v1) { v1 = el[e]; e1 = e; }
                const float p1 = expf(v1 - v0), w0 = pgrp / (1.0f + p1), w1 = pgrp * p1 / (1.0f + p1);
                const int m = m0 + lane;
                const int ea = grp * 8 + e0, eb = grp * 8 + e1;
                const unsigned sa = __hip_atomic_fetch_add(F.ctl + CW_CNT + 16 * ea, 1u, RLX_AGENT);
                const unsigned sb = __hip_atomic_fetch_add(F.ctl + CW_CNT + 16 * eb, 1u, RLX_AGENT);
                LIST[ea * M + sa] = 2 * m; LISTW[ea * M + sa] = w0;
                LIST[eb * M + sb] = 2 * m + 1; LISTW[eb * M + sb] = w1;
            }
            LDS_WAIT(); asm volatile("" ::: "memory");
        }
    }
#undef RT_STAGE
}

__device__ __forceinline__ void p8_expert_weights(Frame& F) {
    const int lane = F.lane;
    {
        __syncthreads();
        LAS float* scr = (LAS float*)(F.lds + F.wave * 16384);
        const int gw = F.bid * NWAVES + F.wave, NGW = F.G * NWAVES;
#define P8_DESC(it, d) do { const int e_ = (it) / 1536; const int r_ = (it) % 1536; \
            if (r_ < 512) { d.W = F.w_eg + (size_t)e_ * DM * EFF; d.K = DM; d.N = EFF; d.WT = WSP(bf16_t, WS_WGU_T) + (size_t)e_ * 1024 * DM; d.kind = 2; d.item = r_; } \
            else if (r_ < 1024) { d.W = F.w_eu + (size_t)e_ * DM * EFF; d.K = DM; d.N = EFF; d.WT = WSP(bf16_t, WS_WGU_T) + (size_t)e_ * 1024 * DM; d.kind = 3; d.item = r_ - 512; } \
            else { d.W = F.w_ed + (size_t)e_ * EFF * DM; d.K = EFF; d.N = DM; d.WT = WSP(bf16_t, WS_WD_T) + (size_t)e_ * DM * EFF; d.kind = 0; d.item = r_ - 1024; } } while (0)
        TD_STREAM(gw, NGW, NEXP * 1536, P8_DESC, lane, scr);
#undef P8_DESC
    }
}

constexpr int MOE_TAB_OFF = LDSCTL_OFF + 2048;
struct ProbMoe : ProbBase {
    unsigned char* ws; const LAS int* tab; int nct; unsigned* done;
    __device__ __forceinline__ bool decode(int L, U& u) const {
        const int l = (int)(threadIdx.x & 31); const bool in = (L >= tab[65 + l]) && (L < tab[66 + l]);
        const unsigned long long bal = __ballot(in);
        if (bal == 0ull) return false;
        const int e = __builtin_ctzll(bal); const int rem = L - tab[65 + e];
        u.aux = e; u.pm = rem / nct; u.pn = rem - u.pm * nct; return true;
    }
    __device__ __forceinline__ int rowbase(int e) const { return tab[32 + e]; }
    __device__ __forceinline__ int count(int e) const { return tab[e]; }
};
__device__ __forceinline__ void moe_table(LAS unsigned char* lds, const unsigned* cnt, int nct) {
    LAS int* tab = (LAS int*)(lds + MOE_TAB_OFF);
    __syncthreads();
    if (threadIdx.x < NEXP) tab[threadIdx.x] = (int)__hip_atomic_load(cnt + 16 * threadIdx.x, __ATOMIC_RELAXED, __HIP_MEMORY_SCOPE_AGENT);
    __syncthreads();
    if (threadIdx.x == 0) { int rb = 0, st = 0; for (int e = 0; e < NEXP; ++e) { tab[32 + e] = rb; tab[65 + e] = st; const int nrt = (tab[e] + 255) >> 8; rb += nrt * 256; st += nrt * nct; } tab[64] = rb; tab[97] = st; }
    __syncthreads();
}
struct ProbMoe1 : ProbMoe {
    static constexpr bool PERM = true;
    __device__ __forceinline__ bool next(int i, U& u) const { return decode(i * G + c, u); }
    __device__ __forceinline__ void bases(const U& u, const char*& a, const char*& b) const { a = (const char*)(ws + WS_XN); b = (const char*)(ws + WS_WGU_T) + ((size_t)u.aux * 1024 + u.pn * 256) * K * 2; }
    __device__ __forceinline__ void lane_offs(const U& u, const int (&stR)[2], const int (&stC)[2], unsigned (&va)[2][2]) const {
        const int* LIST = (const int*)(ws + WS_LIST); const int n = count(u.aux);
#pragma unroll
        for (int h = 0; h < 2; ++h)
#pragma unroll
            for (int i = 0; i < 2; ++i) { const int sl = u.pm * 256 + h * 128 + stR[i]; const int tok = LIST[u.aux * M + (sl < n ? sl : 0)] >> 1; va[h][i] = (unsigned)(tok * K + stC[i]) * 2u; }
    }
    __device__ __forceinline__ void epi(f32x4 (&acc)[2][2][4][2], const U& u, int wr, int wc, int fr, int fq) const {
        const float* LISTW = (const float*)(ws + WS_LISTW); bf16_t* ACT = (bf16_t*)(ws + WS_ACT);
        const int n = count(u.aux), rb = rowbase(u.aux);
        const int f0 = u.pn * 128 + wc * 16 + 4 * fq;
        float wts[8];
#pragma unroll
        for (int ai = 0; ai < 2; ++ai)
#pragma unroll
            for (int m = 0; m < 4; ++m) { const int sl = u.pm * 256 + ai * 128 + wr * 64 + m * 16 + fr; wts[ai * 4 + m] = LISTW[u.aux * M + (sl < n ? sl : 0)]; }
        __builtin_amdgcn_sched_barrier(0);
#pragma unroll
        for (int ai = 0; ai < 2; ++ai)
#pragma unroll
            for (int m = 0; m < 4; ++m) { const int sl = u.pm * 256 + ai * 128 + wr * 64 + m * 16 + fr;
                if (sl < n) { const float wt = wts[ai * 4 + m];
#pragma unroll
                    for (int bj = 0; bj < 2; ++bj) { const f32x4 g = acc[ai][bj][m][0], uu = acc[ai][bj][m][1]; float v[4];
#pragma unroll
                        for (int e = 0; e < 4; ++e) v[e] = siluf_(g[e]) * uu[e] * wt;
                        const unsigned long long w = (unsigned long long)pk2(v[0], v[1]) | ((unsigned long long)pk2(v[2], v[3]) << 32);
                        __hip_atomic_store((unsigned long long*)(ACT + (size_t)(rb + sl) * EFF + f0 + bj * 64), w, RLX_AGENT); } } }
        asm volatile("s_waitcnt vmcnt(0)" ::: "memory");
        if ((threadIdx.x & 63) == 0) __hip_atomic_fetch_add(done + 16 * ((rb >> 8) + u.pm), 1u, RLX_AGENT);
    }
};
struct ProbMoe2 : ProbMoe {
    static constexpr bool PERM = true;
    __device__ __forceinline__ void ready(const U& u, bool me) const {
        if (me) { unsigned* p = done + 16 * ((rowbase(u.aux) >> 8) + u.pm); unsigned sp = 0;
            while (__hip_atomic_load(p, RLX_AGENT) < 32u) { __builtin_amdgcn_s_sleep(2); if (++sp > (1u << 20)) break; }
            __builtin_amdgcn_fence(__ATOMIC_ACQUIRE, "agent"); asm volatile("s_waitcnt vmcnt(0)" ::: "memory"); }
    }
    __device__ __forceinline__ bool next(int i, U& u) const {
        const int u1 = tab[97] >> 1;
        const int base = u1 / G, rem = u1 - base * G, tot = tab[97];
        int n_early = 2 * base * G; if (n_early > tot) n_early = tot;
        int L;
        if (c >= rem) { const int W = G - rem, first = c - rem; const int ce = (n_early > first) ? (n_early - first + W - 1) / W : 0;
            L = (i < ce) ? (i * W + first) : (n_early + (i - ce) * G + c); }
        else L = n_early + i * G + c;
        return decode(L, u);
    }
    __device__ __forceinline__ void bases(const U& u, const char*& a, const char*& b) const { a = (const char*)(ws + WS_ACT) + (size_t)(rowbase(u.aux) + u.pm * 256) * K * 2; b = (const char*)(ws + WS_WD_T) + ((size_t)u.aux * DM + u.pn * 256) * K * 2; }
    __device__ __forceinline__ void lane_offs(const U&, const int (&stR)[2], const int (&stC)[2], unsigned (&va)[2][2]) const { lane_offs_plain(stR, stC, va); }
    __device__ __forceinline__ void epi(f32x4 (&acc)[2][2][4][2], const U& u, int wr, int wc, int fr, int fq) const {
        const int* LIST = (const int*)(ws + WS_LIST); bf16_t* YS = (bf16_t*)(ws + WS_YS);
        const int n = count(u.aux);
        const int colw = u.pn * 256 + wc * 32 + 8 * fq;
        int slots[8];
#pragma unroll
        for (int ai = 0; ai < 2; ++ai)
#pragma unroll
            for (int m = 0; m < 4; ++m) { const int sl = u.pm * 256 + ai * 128 + wr * 64 + m * 16 + fr; slots[ai * 4 + m] = LIST[u.aux * M + (sl < n ? sl : 0)]; }
        __builtin_amdgcn_sched_barrier(0);
#pragma unroll
        for (int ai = 0; ai < 2; ++ai)
#pragma unroll
            for (int m = 0; m < 4; ++m) { const int sl = u.pm * 256 + ai * 128 + wr * 64 + m * 16 + fr;
                if (sl < n) { const int slot = slots[ai * 4 + m];
#pragma unroll
                    for (int bj = 0; bj < 2; ++bj) { const f32x4 v0 = acc[ai][bj][m][0], v1 = acc[ai][bj][m][1];
                        u32x4 w; w.x = pk2(v0[0], v0[1]); w.y = pk2(v0[2], v0[3]); w.z = pk2(v1[0], v1[1]); w.w = pk2(v1[2], v1[3]);
                        *(u32x4*)(YS + (size_t)slot * DM + colw + bj * 128) = w; } } }
    }
};

__device__ __forceinline__ void p11_final(Frame& F, float* dst) {
    const float* MOD = WSP(float, WS_MOD); const bf16_t* YS = WSP(bf16_t, WS_YS);
    const int gw = F.bid * NWAVES + F.wave, NGW = F.G * NWAVES, lane = F.lane;
    for (int m = gw; m < M; m += NGW) {
        const int b = m >> 12; const float* row = F.out + (size_t)m * DM; float* orow = dst + (size_t)m * DM; f32x4 v[8]; float s = 0.f;
#pragma unroll
        for (int j = 0; j < 8; ++j) { const int k = 4 * (lane + 64 * j); const f32x4 xv = __builtin_nontemporal_load((const f32x4*)(row + k)), gt = *(const f32x4*)(MOD + b * 12288 + 5 * DM + k);
            const u32x2 y0 = __builtin_nontemporal_load((const u32x2*)(YS + (size_t)(2 * m) * DM + k)), y1 = __builtin_nontemporal_load((const u32x2*)(YS + (size_t)(2 * m + 1) * DM + k));
            f32x4 y; y.x = bf2f(y0.x & 0xffffu) + bf2f(y1.x & 0xffffu); y.y = bf2f(y0.x >> 16) + bf2f(y1.x >> 16); y.z = bf2f(y0.y & 0xffffu) + bf2f(y1.y & 0xffffu); y.w = bf2f(y0.y >> 16) + bf2f(y1.y >> 16);
            v[j] = xv + gt * y; s += (v[j].x * v[j].x + v[j].y * v[j].y) + (v[j].z * v[j].z + v[j].w * v[j].w); }
        f32x4 gf[8];
#pragma unroll
        for (int j = 0; j < 8; ++j) gf[j] = *(const f32x4*)(F.g_final + 4 * (lane + 64 * j));
        const float rs = 1.0f / sqrtf(wave_sum(s) * (1.0f / DM) + EPS);
#pragma unroll
        for (int j = 0; j < 8; ++j) { const int k = 4 * (lane + 64 * j); __builtin_nontemporal_store(v[j] * rs * gf[j], (f32x4*)(orow + k)); }
    }
}

constexpr int NPHASE = 12;
struct Args { const void* in[21]; float* out; unsigned char* ws; int ph_lo, ph_hi; };
__global__ void __launch_bounds__(NTHREADS, 2) hybrid_block_fwd(Args args) {
    extern __shared__ __attribute__((aligned(16))) unsigned char lds_raw[];
    Frame F;
    F.lds = (LAS unsigned char*)lds_raw;
    F.tid = threadIdx.x; F.lane = F.tid & 63; F.wave = __builtin_amdgcn_readfirstlane(F.tid >> 6); F.G = gridDim.x; F.bid = blockIdx.x;
    F.ws = args.ws; F.ctl = (unsigned*)(args.ws + WS_CTL); F.out = args.out;
    F.x = (const float*)args.in[0]; F.c = (const float*)args.in[1]; F.positions = (const int*)args.in[2]; F.w_ada = (const float*)args.in[3]; F.b_ada = (const float*)args.in[4];
    F.g_norm1 = (const float*)args.in[5]; F.w_in = (const float*)args.in[6]; F.g_head = (const float*)args.in[7]; F.hglb = (const float*)args.in[8]; F.w_attn_up = (const float*)args.in[9];
    F.w_hgrn_up = (const float*)args.in[10]; F.w_out = (const float*)args.in[11]; F.g_norm2 = (const float*)args.in[12]; F.w_rg = (const float*)args.in[13]; F.b_rg = (const float*)args.in[14];
    F.w_re = (const float*)args.in[15]; F.b_re = (const float*)args.in[16]; F.w_eg = (const float*)args.in[17]; F.w_eu = (const float*)args.in[18]; F.w_ed = (const float*)args.in[19]; F.g_final = (const float*)args.in[20];
    volatile LAS unsigned* MISC = (volatile LAS unsigned*)(F.lds + MISC_OFF);
    for (int u = F.tid; u < (LDS_EXTRA - LDSCTL_OFF) / 4; u += NTHREADS) ((LAS unsigned*)(F.lds + LDSCTL_OFF))[u] = 0u;
    __syncthreads();
    const int lo = args.ph_lo, hi = args.ph_hi;
    XcdBarrier bar; bar.bar = F.ctl + CW_BAR; bar.x = 0; bar.st = nullptr;
    if (hi - lo > 1) bar = xcd_barrier_post(F.ctl + CW_BAR, MISC + 8);
#ifndef PHMASK
#define PHMASK 0xfff
#endif
#define IN(k) (((PHMASK >> (k)) & 1) && lo <= (k) && (k) < hi)
#define SEAM(k) do { if (IN(k) && IN((k) + 1)) xcd_barrier(bar); } while (0)
#ifndef REPMASK
#define REPMASK 0
#endif
#define RUN2(k, BODY) do { if (IN(k)) { BODY } if (((REPMASK >> (k)) & 1) && IN(k)) { xcd_barrier(bar); BODY } } while (0)
    RUN2(0, p0_prologue(F);); SEAM(0);
    RUN2(1, p1_norm1(F);); SEAM(1);
#define BODY2 { ProbWin P; P.K = DM; P.G = F.G; P.c = F.bid; P.A = (const char*)(F.ws + WS_XN); P.B = (const char*)(F.ws + WS_WIN_T); P.ws = F.ws; P.hglb = F.hglb; pg8::gemm_phase(F.lds, P); }
    RUN2(2, BODY2); SEAM(2);
    RUN2(3, p3_indexer(F); p3_hgrn_upd(F);); if ((REPMASK >> 20) & 1) { xcd_barrier(bar); p3_indexer(F); } if ((REPMASK >> 21) & 1) { xcd_barrier(bar); p3_hgrn_upd(F); } SEAM(3);
    RUN2(4, p4_select(F); p4_hgrn_scan(F);); if ((REPMASK >> 15) & 1) { xcd_barrier(bar); p4_select(F); } if ((REPMASK >> 16) & 1) { xcd_barrier(bar); p4_hgrn_scan(F); } SEAM(4);
    RUN2(5, p5_attention(F); p5_hgrn_out(F);); if ((REPMASK >> 13) & 1) { xcd_barrier(bar); p5_attention(F); } if ((REPMASK >> 14) & 1) { xcd_barrier(bar); p5_hgrn_out(F); } SEAM(5);
#define BODY6 { ProbMerge P; P.K = 1024; P.G = F.G; P.c = F.bid; P.ws = F.ws; pg8::gemm_phase(F.lds, P); }
    RUN2(6, BODY6); SEAM(6);
#define BODY7 { ProbOut P; P.K = DM; P.G = F.G; P.c = F.bid; P.ws = F.ws; P.x = F.x; P.out = F.out; pg8::gemm_phase(F.lds, P); }
    RUN2(7, BODY7); SEAM(7);
    if (IN(8)) { p8_norm2_route(F); if ((REPMASK >> 17) & 1) { xcd_barrier(bar); if (F.bid == 0 && F.tid < 32) __hip_atomic_store(F.ctl + CW_CNT + 16 * F.tid, 0u, RLX_AGENT); xcd_barrier(bar); p8_norm2_route(F); } p8_expert_weights(F); if ((REPMASK >> 12) & 1) { xcd_barrier(bar); p8_expert_weights(F); } } SEAM(8);
#define BODY9 { moe_table(F.lds, F.ctl + CW_CNT, 4); ProbMoe1 P; P.K = DM; P.G = F.G; P.c = F.bid; P.ws = F.ws; P.tab = (const LAS int*)(F.lds + MOE_TAB_OFF); P.nct = 4; P.done = F.ctl + CW_DONE; pg8::gemm_phase(F.lds, P); }
    if (IN(9)) BODY9;
#if MK_MULTI
    SEAM(9);
#endif
#define BODY10 { moe_table(F.lds, F.ctl + CW_CNT, 8); ProbMoe2 P; P.K = EFF; P.G = F.G; P.c = F.bid; P.ws = F.ws; P.tab = (const LAS int*)(F.lds + MOE_TAB_OFF); P.nct = 8; P.done = F.ctl + CW_DONE; pg8::gemm_phase(F.lds, P); }
    if (IN(10)) BODY10; SEAM(10);
    if (IN(11)) { if ((REPMASK >> 18) & 1) { p11_final(F, WSP(float, WS_UPDT)); xcd_barrier(bar); } p11_final(F, F.out); }
    if ((REPMASK >> 19) & 1) { xcd_barrier(bar); BODY2 }
#undef IN
#undef SEAM
}

extern "C" void kernel_launch(void* const* d_in, const int* in_sizes, int n_in, void* d_out, int out_size, void* d_ws, size_t ws_size, hipStream_t stream) {
    static int grid = 0;
    if (grid == 0) {
        if (n_in != 21 || in_sizes[0] != M * DM || out_size != M * DM || ws_size < WS_END) { fprintf(stderr, "kernel_launch: unexpected shapes/workspace (n_in %d, in0 %d, out %d, ws %zu)\n", n_in, n_in > 0 ? in_sizes[0] : -1, out_size, ws_size); grid = -1; return; }
        int dev = 0, cus = 0, per_cu = 0;
        if (hipGetDevice(&dev) != hipSuccess || hipDeviceGetAttribute(&cus, hipDeviceAttributeMultiprocessorCount, dev) != hipSuccess) { grid = -1; return; }
        if (hipFuncSetAttribute((const void*)hybrid_block_fwd, hipFuncAttributeMaxDynamicSharedMemorySize, LDS_BYTES) != hipSuccess) { fprintf(stderr, "kernel_launch: hipFuncSetAttribute failed\n"); grid = -1; return; }
        if (hipOccupancyMaxActiveBlocksPerMultiprocessor(&per_cu, (const void*)hybrid_block_fwd, NTHREADS, LDS_BYTES) != hipSuccess || per_cu < 1) fprintf(stderr, "kernel_launch: occupancy query reports %d\n", per_cu);
        (void)hipGetLastError();
        grid = cus;
    }
    if (grid < 0) return;
    (void)hipMemsetAsync((char*)d_ws + WS_CTL, 0, CTL_ZERO_BYTES, stream);
    Args a{};
    for (int i = 0; i < 21; ++i) a.in[i] = d_in[i];
    a.out = (float*)d_out; a.ws = (unsigned char*)d_ws;
#if MK_MULTI
    for (int p = 0; p < NPHASE; ++p) { a.ph_lo = p; a.ph_hi = p + 1; hipLaunchKernelGGL(hybrid_block_fwd, dim3(grid), dim3(NTHREADS), LDS_BYTES, stream, a); }
#else
    a.ph_lo = 0; a.ph_hi = NPHASE; hipLaunchKernelGGL(hybrid_block_fwd, dim3(grid), dim3(NTHREADS), LDS_BYTES, stream, a);
#endif
}
```

```cpp
#include <hip/hip_runtime.h>
#include <cstdio>
#include <cstdint>

#define REPMASK 0x0
#ifndef MK_MULTI
#define MK_MULTI 0
#endif

#define GAS __attribute__((address_space(1)))
#define LAS __attribute__((address_space(3)))
typedef unsigned short bf16_t;
typedef short bf16x8 __attribute__((ext_vector_type(8)));
typedef short s16x4 __attribute__((ext_vector_type(4)));
typedef short v4i16_t __attribute__((ext_vector_type(4)));
typedef float f32x4 __attribute__((ext_vector_type(4)));
typedef float f32x2 __attribute__((ext_vector_type(2)));
typedef float f32x16 __attribute__((ext_vector_type(16)));
typedef unsigned u32x4 __attribute__((ext_vector_type(4)));
typedef unsigned u32x2 __attribute__((ext_vector_type(2)));

constexpr int DM = 2048, NBATCH = 2, SEQ = 4096, M = NBATCH * SEQ;
constexpr int NLOG = 10312, NPHYS = 10240;
constexpr int NEXP = 32, EFF = 512;
constexpr float EPS = 1e-6f;
constexpr float ATT_SCALE_L2E = 0.08838834764831845f * 1.4426950408889634f;
constexpr float IDX_SCALE = 0.04419417382415922f;
constexpr int TOPK = 256;

constexpr size_t MiB = 1u << 20;
constexpr size_t WS_CTL = 0, CTL_ZERO_BYTES = 1 * MiB;
constexpr size_t WS_WIN_T = 1 * MiB, WS_WAU_T = 42 * MiB, WS_WHU_T = 46 * MiB, WS_WOUT_T = 50 * MiB;
constexpr size_t WS_XN = 58 * MiB, WS_MODP = 90 * MiB, WS_MOD = 92 * MiB, WS_TABA = 93 * MiB, WS_TABI = 97 * MiB, WS_MASK = 99 * MiB;
constexpr size_t WS_W40T = 104 * MiB;
constexpr size_t WS_DECAY = 103 * MiB, WS_LIST = 105 * MiB, WS_LISTW = 106 * MiB, WS_SPREVT = 107 * MiB, WS_YATT = 139 * MiB, WS_YHG = 155 * MiB, WS_UPDT = 171 * MiB;
constexpr size_t WS_AQ = 235 * MiB, WS_AK = 251 * MiB, WS_AVT = 255 * MiB, WS_IQ = 259 * MiB, WS_IK = 267 * MiB, WS_IW = 268 * MiB, WS_HQ = 269 * MiB, WS_LOGF = 285 * MiB,
                 WS_KF = 317 * MiB, WS_HI = 333 * MiB, WS_HOG = 349 * MiB, WS_GA = 365 * MiB, WS_GH = 397 * MiB;
constexpr size_t WS_WGU_T = 235 * MiB, WS_WD_T = 363 * MiB;
constexpr size_t WS_SCORES = 429 * MiB;
constexpr size_t WS_MERGED = 429 * MiB, WS_YS = 461 * MiB, WS_ACT = 557 * MiB;
constexpr size_t WS_END = 581 * MiB;
constexpr int CW_BAR = 4096, CW_CNT = 16384, CW_DONE = 32768;

constexpr int RING_BYTES = 139264, LDSCTL_OFF = RING_BYTES, MISC_OFF = LDSCTL_OFF + 320, LDS_EXTRA = 147456, LDS_BYTES = 163840;
constexpr int NWAVES = 8, NTHREADS = 512;

#define RLX_AGENT __ATOMIC_RELAXED, __HIP_MEMORY_SCOPE_AGENT
#define LDS_WAIT() asm volatile("s_waitcnt lgkmcnt(0)" ::: "memory")
#define VM_WAIT() asm volatile("s_waitcnt vmcnt(0)" ::: "memory")
__device__ __forceinline__ float bf2f(unsigned b) { return __uint_as_float(b << 16); }
__device__ __forceinline__ unsigned pk2(float lo, float hi) { unsigned r; asm("v_cvt_pk_bf16_f32 %0, %1, %2" : "=v"(r) : "v"(lo), "v"(hi)); return r; }
__device__ __forceinline__ float fexp(float x) { return __builtin_amdgcn_exp2f(x * 1.4426950408889634f); }
__device__ __forceinline__ float frcp(float x) { return __builtin_amdgcn_rcpf(x); }
__device__ __forceinline__ float sigmoidf_(float x) { return frcp(1.0f + fexp(-x)); }
__device__ __forceinline__ float siluf_(float x) { return x * sigmoidf_(x); }
__device__ __forceinline__ float wave_sum(float v) {
#pragma unroll
    for (int o = 1; o < 64; o <<= 1) v += __shfl_xor(v, o);
    return v;
}
__device__ __forceinline__ int wave_sum_i_dpp(int v) {
    v += __builtin_amdgcn_update_dpp(0, v, 0xB1, 0xF, 0xF, false);
    v += __builtin_amdgcn_update_dpp(0, v, 0x4E, 0xF, 0xF, false);
    v += __builtin_amdgcn_update_dpp(0, v, 0x124, 0xF, 0xF, false);
    v += __builtin_amdgcn_update_dpp(0, v, 0x128, 0xF, 0xF, false);
    return __builtin_amdgcn_readlane(v, 0) + __builtin_amdgcn_readlane(v, 16) + __builtin_amdgcn_readlane(v, 32) + __builtin_amdgcn_readlane(v, 48);
}
__device__ __forceinline__ int wave_sum_i(int v) {
#pragma unroll
    for (int o = 1; o < 64; o <<= 1) v += __shfl_xor(v, o);
    return v;
}

#define XB_TMO      128
#define XB_XCNT(j)  (256  + 64 * (j))
#define XB_XSUB(j)  (1280 + 64 * (j))
#define XB_XGEN(j)  (2304 + 64 * (j))
#define XB_TOP      3328
#define XB_TOPGEN   3392
#define XCD_BAR_WORDS 3456
#define XB_SPIN_CAP (1u << 18)
__device__ __forceinline__ unsigned xb_ld(unsigned* p)              { return __hip_atomic_load(p, __ATOMIC_RELAXED, __HIP_MEMORY_SCOPE_AGENT); }
__device__ __forceinline__ unsigned xb_add(unsigned* p, unsigned v) { return __hip_atomic_fetch_add(p, v, __ATOMIC_RELAXED, __HIP_MEMORY_SCOPE_AGENT); }
__device__ __forceinline__ unsigned xb_xcc_id() { return (unsigned)__builtin_amdgcn_s_getreg((3 << 11) | 20) & 0xFu; }
#define XB_SPIN(cond, bar) do { unsigned _sp = 0; while (cond) { __builtin_amdgcn_s_sleep(1); \
    if ((++_sp & 255u) == 0u) { if (xb_ld(&(bar)[XB_TMO])) break; if (_sp > XB_SPIN_CAP) { atomicAdd(&(bar)[XB_TMO], 1u); break; } } } } while (0)
struct XcdBarrier { unsigned* bar; unsigned x; volatile LAS unsigned* st; };
__device__ __forceinline__ XcdBarrier xcd_barrier_post(unsigned* bar, volatile LAS unsigned* st) {
    XcdBarrier b; b.bar = bar; b.x = xb_xcc_id(); b.st = st;
    if (threadIdx.x == 0) (void)xb_add(&bar[XB_XCNT(b.x)], 1u);
    return b;
}
__device__ __forceinline__ void xcd_barrier_complete(unsigned* bar, unsigned x, unsigned& nloc, unsigned& nx) {
    const unsigned G = gridDim.x * gridDim.y * gridDim.z;
    unsigned sum, cnt, mine, sp = 0u;
    for (;;) {
        sum = 0u; cnt = 0u; mine = 0u;
#pragma unroll
        for (unsigned j = 0; j < 16; ++j) { const unsigned c = xb_ld(&bar[XB_XCNT(j)]); sum += c; cnt += (c > 0u) ? 1u : 0u; mine = (j == x) ? c : mine; }
        if (sum == G) break;
        __builtin_amdgcn_s_sleep(1);
        if ((++sp & 255u) == 0u) { if (xb_ld(&bar[XB_TMO])) break; if (sp > XB_SPIN_CAP) { atomicAdd(&bar[XB_TMO], 1u); break; } }
    }
    nloc = mine > 0u ? mine : 1u; nx = cnt > 0u ? cnt : 1u;
}
__device__ __forceinline__ void xcd_barrier(const XcdBarrier& b) {
    asm volatile("s_waitcnt vmcnt(0)" ::: "memory");
    __syncthreads();
    if (threadIdx.x == 0) {
        unsigned* bar = b.bar;
        __builtin_amdgcn_s_waitcnt(0);
        unsigned nloc = b.st[0], nx = b.st[1];
        if (nloc == 0u) { xcd_barrier_complete(bar, b.x, nloc, nx); b.st[0] = nloc; b.st[1] = nx; }
        const unsigned old = xb_add(&bar[XB_XSUB(b.x)], 1u);
        const unsigned gen = old / nloc;
        if (old + 1u == (gen + 1u) * nloc) {
            __builtin_amdgcn_fence(__ATOMIC_RELEASE, "agent");
            asm volatile("s_waitcnt vmcnt(0)" ::: "memory");
            const unsigned og = xb_add(&bar[XB_TOP], 1u);
            const unsigned tg = og / nx;
            if (og + 1u == (tg + 1u) * nx) xb_add(&bar[XB_TOPGEN], 1u);
            else XB_SPIN(xb_ld(&bar[XB_TOPGEN]) == tg, bar);
            __builtin_amdgcn_fence(__ATOMIC_ACQUIRE, "agent");
            xb_add(&bar[XB_XGEN(b.x)], 1u);
            asm volatile("s_waitcnt vmcnt(0)" ::: "memory");
        } else {
            XB_SPIN(xb_ld(&bar[XB_XGEN(b.x)]) == gen, bar);
            __builtin_amdgcn_fence(__ATOMIC_ACQUIRE, "agent");
            asm volatile("s_waitcnt vmcnt(0)" ::: "memory");
        }
    }
    __syncthreads();
}

namespace pg8 {
constexpr int BM = 256, BK = 64, HALF = 128, HTB = HALF * BK * 2, NXCD = 8, WGM = 8;
__host__ __device__ __forceinline__ int lds_byte(int r, int c) { const int st = (r >> 4) * 2 + (c >> 5), rr = r & 15, cc = c & 31, ob = rr * 64 + cc * 2; return st * 1024 + (ob ^ (((ob >> 9) & 1) << 5)); }
__host__ __device__ __forceinline__ void stage_rc(int b, int& R, int& C) { const int st = b / 1024, sb = b % 1024, swz = sb ^ (((sb >> 9) & 1) << 5); R = (st >> 1) * 16 + swz / 64; C = (st & 1) * 32 + (swz % 64) / 2; }
__host__ __device__ __forceinline__ int perm32(int rho) { const int n = rho >> 4, i = rho & 15; return 8 * (i >> 2) + 4 * n + (i & 3); }

__device__ __forceinline__ bool static_tile(int L, int nM, int nN, int& pm, int& pn) {
    const int nwg = nM * nN; if (L >= nwg) return false;
    int wgid = L; { const int q = nwg / NXCD, r = nwg % NXCD, xcd = wgid % NXCD, off = wgid / NXCD; wgid = (xcd < r ? xcd * (q + 1) : r * (q + 1) + (xcd - r) * q) + off; }
    const int nig = WGM * nN, gid = wgid / nig, fm = gid * WGM, gsz = (nM - fm) < WGM ? (nM - fm) : WGM;
    pm = fm + ((wgid % nig) % gsz); pn = (wgid % nig) / gsz; return true;
}

template <class P>
__device__ __forceinline__ void gemm_phase(LAS unsigned char* lds, P& prob) {
    typedef typename P::U Unit;
    const int tid = threadIdx.x, wid = __builtin_amdgcn_readfirstlane(tid >> 6), lane = tid & 63, wr = wid >> 2, wc = wid & 3, fr = lane & 15, fq = lane >> 4;
    const int K = prob.K, nt = K / BK;
    unsigned voffB[2]; int stR[2], stC[2];
#pragma unroll
    for (int i = 0; i < 2; ++i) { int R, C; stage_rc(tid * 16 + i * 8192, R, C); stR[i] = R; stC[i] = C; const int Rb = P::PERM ? ((R & ~31) + perm32(R & 31)) : R; voffB[i] = (unsigned)(Rb * K + C) * 2u; }
    const size_t kstep = (size_t)(BK * 2);
    const size_t hstep = (size_t)HALF * K * 2;
    const unsigned ldsw = (unsigned)wid * 1024u;
    const int aoff = lds_byte(wr * 64 + fr, fq * 8), boff = lds_byte(wc * 32 + fr, fq * 8);
#define PG8_SA(b, h) (((b) * 2 + (h)) * HTB)
#define PG8_SB(b, h) ((4 + (b) * 2 + (h)) * HTB)
#define PG8_STAGE2(bufoff, gbase, o0, o1) do { \
        __builtin_amdgcn_global_load_lds((const unsigned*)((const char*)(gbase) + (o0)), (LAS unsigned*)(lds + (bufoff) + ldsw), 16, 0, 0); \
        __builtin_amdgcn_global_load_lds((const unsigned*)((const char*)(gbase) + (o1)), (LAS unsigned*)(lds + (bufoff) + ldsw + 8192), 16, 0, 0); } while (0)
#define PG8_STAGE_B(bufoff, gbase, h) PG8_STAGE2(bufoff, (gbase) + (h) * hstep, voffB[0], voffB[1])
#define PG8_LDA(dst, b, h) do { _Pragma("unroll") for (int m = 0; m < 4; ++m) _Pragma("unroll") for (int k = 0; k < 2; ++k) dst[m][k] = *(const LAS bf16x8*)(lds + PG8_SA(b, h) + aoff + m * 2048 + k * 1024); } while (0)
#define PG8_LDB(dst, b, h) do { _Pragma("unroll") for (int n = 0; n < 2; ++n) _Pragma("unroll") for (int k = 0; k < 2; ++k) dst[n][k] = *(const LAS bf16x8*)(lds + PG8_SB(b, h) + boff + n * 2048 + k * 1024); } while (0)
#define PG8_MMA(ai, bj, At, Bt) do { __builtin_amdgcn_s_setprio(1); _Pragma("unroll") for (int m = 0; m < 4; ++m) _Pragma("unroll") for (int n = 0; n < 2; ++n) _Pragma("unroll") for (int k = 0; k < 2; ++k) \
        acc[ai][bj][m][n] = __builtin_amdgcn_mfma_f32_16x16x32_bf16(Bt[n][k], At[m][k], acc[ai][bj][m][n], 0, 0, 0); __builtin_amdgcn_s_setprio(0); } while (0)
#define PG8_WAIT_V(n) asm volatile("s_waitcnt vmcnt(" #n ")" ::: "memory")
#define PG8_WAIT_L(n) asm volatile("s_waitcnt lgkmcnt(" #n ")" ::: "memory")
#define PG8_BAR __builtin_amdgcn_s_barrier()
#define PG8_SCHED __builtin_amdgcn_sched_barrier(0)
    Unit cur, nxt; int ui = 0;
    if (!prob.next(0, cur)) return;
    f32x4 acc[2][2][4][2];
#pragma unroll
    for (int a = 0; a < 2; ++a)
#pragma unroll
        for (int b = 0; b < 2; ++b)
#pragma unroll
            for (int m = 0; m < 4; ++m)
#pragma unroll
                for (int n = 0; n < 2; ++n) acc[a][b][m][n] = (f32x4){0.f, 0.f, 0.f, 0.f};
    bf16x8 At[4][2], B0[2][2], B1[2][2];
    const char* cA; const char* cB; unsigned vc[2][2], vn[2][2];
    prob.ready(cur, true);
    prob.bases(cur, cA, cB); prob.lane_offs(cur, stR, stC, vc);
    PG8_STAGE_B(PG8_SB(0, 0), cB, 0); PG8_STAGE_B(PG8_SB(0, 1), cB, 1); PG8_STAGE2(PG8_SA(0, 0), cA, vc[0][0], vc[0][1]); PG8_STAGE2(PG8_SA(0, 1), cA, vc[1][0], vc[1][1]);
    if (wr == 1) PG8_BAR;
    PG8_WAIT_V(2); PG8_BAR;
    PG8_STAGE_B(PG8_SB(1, 0), cB + kstep, 0); PG8_STAGE2(PG8_SA(1, 0), cA + kstep, vc[0][0], vc[0][1]); PG8_STAGE_B(PG8_SB(1, 1), cB + kstep, 1);
    PG8_WAIT_V(6); PG8_BAR;
    for (;;) {
        const bool has_next = prob.next(ui + 1, nxt);
        const char* nA = cA; const char* nB = cB;
#pragma unroll
        for (int h = 0; h < 2; ++h) { vn[h][0] = vc[h][0]; vn[h][1] = vc[h][1]; }
        if (has_next) { prob.bases(nxt, nA, nB); prob.lane_offs(nxt, stR, stC, vn); }
        for (int t = 0; t < nt; t += 2) {
            const bool last = (t == nt - 2);
            if (last && has_next) prob.ready(nxt, wid == 0);
            const char* a1 = cA + (size_t)(t + 1) * kstep;
            const char* a2 = last ? nA : cA + (size_t)(t + 2) * kstep; const char* b2 = last ? nB : cB + (size_t)(t + 2) * kstep;
            const char* a3 = a2 + kstep; const char* b3 = b2 + kstep;
            const unsigned v00 = last ? vn[0][0] : vc[0][0], v01 = last ? vn[0][1] : vc[0][1], v10 = last ? vn[1][0] : vc[1][0], v11 = last ? vn[1][1] : vc[1][1];
            PG8_LDB(B0, 0, 0); PG8_LDB(B1, 0, 1); PG8_SCHED; PG8_LDA(At, 0, 0); PG8_STAGE2(PG8_SA(1, 1), a1, vc[1][0], vc[1][1]);
            PG8_WAIT_V(8); PG8_WAIT_L(0); PG8_BAR; PG8_MMA(0, 0, At, B0); PG8_MMA(0, 1, At, B1); PG8_BAR; PG8_SCHED;
            PG8_LDA(At, 0, 1); PG8_STAGE_B(PG8_SB(0, 0), b2, 0); PG8_STAGE_B(PG8_SB(0, 1), b2, 1); PG8_STAGE2(PG8_SA(0, 0), a2, v00, v01);
            PG8_WAIT_V(8); PG8_WAIT_L(0); PG8_BAR; PG8_MMA(1, 0, At, B0); PG8_MMA(1, 1, At, B1); PG8_BAR; PG8_SCHED;
            PG8_LDB(B0, 1, 0); PG8_LDB(B1, 1, 1); PG8_SCHED; PG8_LDA(At, 1, 0); PG8_STAGE2(PG8_SA(0, 1), a2, v10, v11);
            PG8_WAIT_V(8); PG8_WAIT_L(0); PG8_BAR; PG8_MMA(0, 0, At, B0); PG8_MMA(0, 1, At, B1); PG8_BAR; PG8_SCHED;
            PG8_LDA(At, 1, 1); PG8_STAGE_B(PG8_SB(1, 0), b3, 0); PG8_STAGE_B(PG8_SB(1, 1), b3, 1); PG8_STAGE2(PG8_SA(1, 0), a3, v00, v01);
            PG8_WAIT_V(8); PG8_WAIT_L(0); PG8_BAR; PG8_MMA(1, 0, At, B0); PG8_MMA(1, 1, At, B1); PG8_BAR; PG8_SCHED;
        }
        if (wr == 0) PG8_BAR;
        prob.epi(acc, cur, wr, wc, fr, fq);
        if (!has_next) break;
        if (!prob.keep(cur)) {
#pragma unroll
            for (int a = 0; a < 2; ++a)
#pragma unroll
                for (int b = 0; b < 2; ++b)
#pragma unroll
                    for (int m = 0; m < 4; ++m)
#pragma unroll
                        for (int n = 0; n < 2; ++n) acc[a][b][m][n] = (f32x4){0.f, 0.f, 0.f, 0.f};
        }
        cur = nxt; cA = nA; cB = nB; ++ui;
#pragma unroll
        for (int h = 0; h < 2; ++h) { vc[h][0] = vn[h][0]; vc[h][1] = vn[h][1]; }
        if (wr == 1) PG8_BAR;
    }
    PG8_WAIT_V(0);
    PG8_BAR;
#undef PG8_SA
#undef PG8_SB
#undef PG8_STAGE2
#undef PG8_STAGE_B
#undef PG8_LDA
#undef PG8_LDB
#undef PG8_MMA
#undef PG8_WAIT_V
#undef PG8_WAIT_L
#undef PG8_BAR
#undef PG8_SCHED
}
}

struct Frame {
    LAS unsigned char* lds;
    unsigned* ctl;
    unsigned char* ws;
    int tid, lane, wave, G, bid;
    const float *x, *c, *w_ada, *b_ada, *g_norm1, *w_in, *g_head, *hglb, *w_attn_up, *w_hgrn_up, *w_out, *g_norm2, *w_rg, *b_rg, *w_re, *b_re, *w_eg, *w_eu, *w_ed, *g_final;
    const int* positions;
    float* out;
};
#define WSP(T, off) ((T*)(F.ws + (off)))

__device__ __forceinline__ int win_phys(int n) {
    if (n < 1280) { const int head = n >> 7, j = n & 127; return head * 128 + (j < 64 ? 2 * j : 2 * (j - 64) + 1); }
    if (n < 1536) return n;
    if (n < 2048) { const int q = n - 1536, head = q >> 6, j = q & 63; return 1536 + head * 64 + (j < 32 ? 2 * j : 2 * (j - 32) + 1); }
    if (n < 2120) return -1;
    return n - 2120 + 2048;
}
struct RmWin { __device__ __forceinline__ int operator()(int n) const { return win_phys(n); } };
struct RmId  { __device__ __forceinline__ int operator()(int n) const { return n; } };
struct RmGate { int up; __device__ __forceinline__ int operator()(int f) const { return 8 * (f >> 2) + 4 * up + (f & 3); } };
template <class RM>
__device__ __forceinline__ void transpose_item(const float* W, int K, int N, bf16_t* WT, LAS float* scr, int item, int lane, RM rm) {
    const int nblk = (N + 31) / 32, kb = item / nblk, nb = item % nblk, k0 = 64 * kb, n0 = 32 * nb;
    const int nn = n0 + (lane & 31);
    float tv[32];
#pragma unroll
    for (int i = 0; i < 32; ++i) { const int kk = 2 * i + (lane >> 5); tv[i] = (nn < N) ? W[(size_t)(k0 + kk) * N + nn] : 0.f; }
#pragma unroll
    for (int i = 0; i < 32; ++i) { const int kk = 2 * i + (lane >> 5); scr[kk * 33 + (lane & 31)] = tv[i]; }
    LDS_WAIT(); asm volatile("" ::: "memory");
    const int c = lane & 7;
#pragma unroll
    for (int j = 0; j < 4; ++j) { const int n = (lane >> 3) + 8 * j; const LAS float* s = scr + (8 * c) * 33 + n;
        u32x4 o; o.x = pk2(s[0 * 33], s[1 * 33]); o.y = pk2(s[2 * 33], s[3 * 33]); o.z = pk2(s[4 * 33], s[5 * 33]); o.w = pk2(s[6 * 33], s[7 * 33]);
        if (n0 + n < N) { const int rr = rm(n0 + n); if (rr >= 0) *(u32x4*)(WT + (size_t)rr * K + k0 + 8 * c) = o; } }
    LDS_WAIT(); asm volatile("" ::: "memory");
}

struct TDesc { const float* W; bf16_t* WT; int K, N, kind, item; };
__device__ __forceinline__ int td_row(int kind, int n) { return kind == 0 ? n : kind == 1 ? win_phys(n) : (8 * (n >> 2) + 4 * (kind - 2) + (n & 3)); }
__device__ __forceinline__ void td_load(const TDesc& d, int lane, float (&tv)[32]) {
    const int nblk = (d.N + 31) / 32, kb = d.item / nblk, nb = d.item % nblk, k0 = 64 * kb, n0 = 32 * nb;
    int nn = n0 + (lane & 31); nn = nn < d.N ? nn : d.N - 1;
    const float* p = d.W + (size_t)(k0 + (lane >> 5)) * d.N + nn;
#pragma unroll
    for (int i = 0; i < 32; ++i) tv[i] = __builtin_nontemporal_load(p + (size_t)(2 * i) * d.N);
}
__device__ __forceinline__ void td_lds(const float (&tv)[32], int lane, LAS float* scr) {
#pragma unroll
    for (int i = 0; i < 32; ++i) { const int kk = 2 * i + (lane >> 5); scr[kk * 33 + (lane & 31)] = tv[i]; }
}
__device__ __forceinline__ void td_store(const TDesc& d, int lane, LAS float* scr) {
    const int nblk = (d.N + 31) / 32, kb = d.item / nblk, nb = d.item % nblk, k0 = 64 * kb, n0 = 32 * nb;
    const int c = lane & 7;
#pragma unroll
    for (int j = 0; j < 4; ++j) { const int n = (lane >> 3) + 8 * j; const LAS float* sp = scr + (8 * c) * 33 + n;
        u32x4 o; o.x = pk2(sp[0 * 33], sp[1 * 33]); o.y = pk2(sp[2 * 33], sp[3 * 33]); o.z = pk2(sp[4 * 33], sp[5 * 33]); o.w = pk2(sp[6 * 33], sp[7 * 33]);
        if (n0 + n < d.N) { const int rr = td_row(d.kind, n0 + n); if (rr >= 0) *(u32x4*)(d.WT + (size_t)rr * d.K + k0 + 8 * c) = o; } }
}
#define TD_STREAM(it0_, stride_, total_, DESC, lane_, scr_) do { float tv_[32]; TDesc dc_, dn_; int it_ = (it0_); \
    if (it_ < (total_)) { DESC(it_, dc_); td_load(dc_, (lane_), tv_); } \
    for (; it_ < (total_); it_ += (stride_)) { td_lds(tv_, (lane_), (scr_)); __builtin_amdgcn_sched_barrier(0); \
        const bool hn_ = it_ + (stride_) < (total_); if (hn_) { DESC(it_ + (stride_), dn_); td_load(dn_, (lane_), tv_); } \
        LDS_WAIT(); asm volatile("" ::: "memory"); td_store(dc_, (lane_), (scr_)); LDS_WAIT(); asm volatile("" ::: "memory"); if (hn_) dc_ = dn_; } } while (0)

__device__ __forceinline__ void p0_prologue(Frame& F) {
    const int gw = F.bid * NWAVES + F.wave, NGW = F.G * NWAVES;
    {
        LAS float* red = (LAS float*)F.lds;
        float* MODP = WSP(float, WS_MODP);
        for (int task = F.bid; task < 48 * 16; task += F.G) {
            const int cg = task % 48, ks = task / 48;
            f32x4 a0 = {0.f, 0.f, 0.f, 0.f}, a1 = {0.f, 0.f, 0.f, 0.f};
            const int kb = ks * 128 + F.wave * 16;
#pragma unroll 16
            for (int i = 0; i < 16; ++i) { const int k = kb + i; const f32x4 wv = __builtin_nontemporal_load((const f32x4*)(F.w_ada + (size_t)k * 12288 + cg * 256 + 4 * F.lane));
                const float s0 = siluf_(F.c[k]), s1 = siluf_(F.c[DM + k]); a0 += wv * s0; a1 += wv * s1; }
            *(LAS f32x4*)(red + (F.wave * 2 + 0) * 256 + 4 * F.lane) = a0; *(LAS f32x4*)(red + (F.wave * 2 + 1) * 256 + 4 * F.lane) = a1;
            __syncthreads();
            { const int b = F.tid >> 8, col = F.tid & 255; float s = 0.f;
#pragma unroll
              for (int w = 0; w < 8; ++w) s += red[(w * 2 + b) * 256 + col];
              MODP[((size_t)ks * 2 + b) * 12288 + cg * 256 + col] = s; }
            __syncthreads();
        }
    }
    {
        LAS float* scr = (LAS float*)(F.lds + F.wave * 16384);
        constexpr int I_IN = 32 * 323, I_AU = 16 * 64, I_HU = 16 * 64, I_OUT = 32 * 64;
        constexpr int NITEMS = I_IN + I_AU + I_HU + I_OUT;
#define P0_DESC(it, d) do { int r_ = (it); \
            if (r_ < I_IN) { d.W = F.w_in; d.K = DM; d.N = NLOG; d.WT = WSP(bf16_t, WS_WIN_T); d.kind = 1; d.item = r_; } \
            else if ((r_ -= I_IN) < I_AU) { d.W = F.w_attn_up; d.K = 1024; d.N = DM; d.WT = WSP(bf16_t, WS_WAU_T); d.kind = 0; d.item = r_; } \
            else if ((r_ -= I_AU) < I_HU) { d.W = F.w_hgrn_up; d.K = 1024; d.N = DM; d.WT = WSP(bf16_t, WS_WHU_T); d.kind = 0; d.item = r_; } \
            else { r_ -= I_HU; d.W = F.w_out; d.K = DM; d.N = DM; d.WT = WSP(bf16_t, WS_WOUT_T); d.kind = 0; d.item = r_; } } while (0)
        TD_STREAM(gw, NGW, NITEMS, P0_DESC, F.lane, scr);
#undef P0_DESC
        { bf16_t* W40 = WSP(bf16_t, WS_W40T); const int gt = F.bid * NTHREADS + F.tid, NGT = F.G * NTHREADS;
          for (int e = gt; e < 96 * 256; e += NGT) { const int n = e >> 8, k0 = (e & 255) * 8; u32x4 o = {0u, 0u, 0u, 0u};
              if (n < 72) { const int col = (n < 64) ? (2048 + (n >> 1) + 32 * (n & 1)) : (2112 + (n - 64)); const float* p = F.w_in + (size_t)k0 * NLOG + col;
                  o.x = pk2(p[0], p[NLOG]); o.y = pk2(p[2 * (size_t)NLOG], p[3 * (size_t)NLOG]); o.z = pk2(p[4 * (size_t)NLOG], p[5 * (size_t)NLOG]); o.w = pk2(p[6 * (size_t)NLOG], p[7 * (size_t)NLOG]); }
              *(u32x4*)(W40 + (size_t)n * DM + k0) = o; } }
    }
    {
        f32x2* TA = WSP(f32x2, WS_TABA); f32x2* TI = WSP(f32x2, WS_TABI);
        const int gt = F.bid * NTHREADS + F.tid, NGT = F.G * NTHREADS;
        for (int e = gt; e < M * 96; e += NGT) {
            const int m = e / 96, r = e % 96; const float pos = (float)F.positions[m];
            float inv; if (r < 64) inv = powf(10000.0f, -(float)(2 * r) / 128.0f); else inv = powf(10000.0f, -(float)(2 * (r - 64)) / 64.0f);
            const float ang = pos * inv; float sn, cs; sincosf(ang, &sn, &cs);
            if (r < 64) TA[(size_t)m * 64 + r] = (f32x2){cs, sn}; else TI[(size_t)m * 32 + (r - 64)] = (f32x2){cs, sn};
        }
    }
}

__device__ __forceinline__ float row_rstd_nt(const float* xrow, int lane, f32x4 (&v)[8]) {
    float s = 0.f;
#pragma unroll
    for (int j = 0; j < 8; ++j) { v[j] = __builtin_nontemporal_load((const f32x4*)xrow + lane + 64 * j); s += (v[j].x * v[j].x + v[j].y * v[j].y) + (v[j].z * v[j].z + v[j].w * v[j].w); }
    return 1.0f / sqrtf(wave_sum(s) * (1.0f / DM) + EPS);
}
__device__ __forceinline__ float row_rstd(const float* xrow, int lane, f32x4 (&v)[8]) {
    float s = 0.f;
#pragma unroll
    for (int j = 0; j < 8; ++j) { v[j] = ((const f32x4*)xrow)[lane + 64 * j]; s += (v[j].x * v[j].x + v[j].y * v[j].y) + (v[j].z * v[j].z + v[j].w * v[j].w); }
    return 1.0f / sqrtf(wave_sum(s) * (1.0f / DM) + EPS);
}

__device__ __forceinline__ f32x16 mfma32(bf16x8 a, bf16x8 b, f32x16 c) { return __builtin_amdgcn_mfma_f32_32x32x16_bf16(a, b, c, 0, 0, 0); }
__device__ __forceinline__ int crow(int r, int hi) { return (r & 3) + 8 * (r >> 2) + 4 * hi; }
__device__ __forceinline__ void p1_norm1(Frame& F) {
    LAS float* CA = (LAS float*)(F.lds + LDS_EXTRA); LAS float* CB = CA + DM;
    LAS unsigned char* HB = F.lds;
    const float* MODP = WSP(float, WS_MODP); float* MOD = WSP(float, WS_MOD);
    const int lane = F.lane, r32 = lane & 31, hi = lane >> 5;
    for (int idx = F.bid * NTHREADS + F.tid; idx < 2 * 12288; idx += F.G * NTHREADS) { const int b = idx / 12288, j = idx % 12288; float s = F.b_ada[j]; float pv[16];
#pragma unroll
        for (int ks = 0; ks < 16; ++ks) pv[ks] = MODP[((size_t)ks * 2 + b) * 12288 + j];
        __builtin_amdgcn_sched_barrier(0);
#pragma unroll
        for (int ks = 0; ks < 16; ++ks) s += pv[ks];
        MOD[idx] = s; }
    for (int rb = F.bid; rb < M / 32; rb += F.G) {
        const int b = (rb * 32) / SEQ;
        __syncthreads();
#pragma unroll
        for (int kk = 0; kk < DM / NTHREADS; ++kk) { __builtin_amdgcn_sched_barrier(0); const int k = F.tid + kk * NTHREADS; float sh = F.b_ada[k], sc = F.b_ada[DM + k]; const float gn = F.g_norm1[k]; float p0[16], p1[16];
#pragma unroll
            for (int ks = 0; ks < 16; ++ks) { p0[ks] = MODP[((size_t)ks * 2 + b) * 12288 + k]; p1[ks] = MODP[((size_t)ks * 2 + b) * 12288 + DM + k]; }
            __builtin_amdgcn_sched_barrier(0);
#pragma unroll
            for (int ks = 0; ks < 16; ++ks) { sh += p0[ks]; sc += p1[ks]; }
            CA[k] = gn * (1.0f + sc); CB[k] = sh; }
        __syncthreads();
        bf16_t* XN = WSP(bf16_t, WS_XN);
#pragma unroll 1
        for (int r = 0; r < 4; ++r) { const int rl = F.wave * 4 + r, m = rb * 32 + rl; f32x4 v[8]; const float rs = row_rstd_nt(F.x + (size_t)m * DM, lane, v);
#pragma unroll
            for (int j = 0; j < 8; ++j) { const int k = 4 * (lane + 64 * j); const f32x4 a = *(const LAS f32x4*)(CA + k), bb = *(const LAS f32x4*)(CB + k);
                const f32x4 h = v[j] * rs * a + bb; u32x2 o; o.x = pk2(h.x, h.y); o.y = pk2(h.z, h.w); *(u32x2*)(XN + (size_t)m * DM + k) = o; *(LAS u32x2*)(HB + rl * 4112 + k * 2) = o; } }
        __syncthreads();
        f32x16 acc[3]; acc[0] = f32x16{}; acc[1] = f32x16{}; acc[2] = f32x16{};
        { const bf16_t* W40 = WSP(bf16_t, WS_W40T) + (size_t)r32 * DM + 256 * F.wave + 8 * hi;
#pragma unroll
          for (int kb = 0; kb < 8; ++kb) { bf16x8 bq[2][3];
#pragma unroll
              for (int ks = 0; ks < 2; ++ks)
#pragma unroll
                  for (int nt = 0; nt < 3; ++nt) bq[ks][nt] = *(const bf16x8*)(W40 + (size_t)nt * 32 * DM + 16 * (2 * kb + ks));
              __builtin_amdgcn_sched_barrier(0);
#pragma unroll
              for (int ks = 0; ks < 2; ++ks) { const bf16x8 a = *(const LAS bf16x8*)(HB + r32 * 4112 + (256 * F.wave + 16 * (2 * kb + ks) + 8 * hi) * 2);
#pragma unroll
                  for (int nt = 0; nt < 3; ++nt) acc[nt] = mfma32(a, bq[ks][nt], acc[nt]); }
              __builtin_amdgcn_sched_barrier(0); } }
        __syncthreads();
        LAS float* PS = (LAS float*)HB;
#pragma unroll
        for (int nt = 0; nt < 3; ++nt)
#pragma unroll
            for (int r = 0; r < 16; ++r) PS[(F.wave * 96 + nt * 32 + r32) * 33 + crow(r, hi)] = acc[nt][r];
        __syncthreads();
        { bf16_t* IK = WSP(bf16_t, WS_IK); float* IW = WSP(float, WS_IW); const f32x2* TI = WSP(f32x2, WS_TABI);
          int tv = F.tid; asm volatile("" : "+v"(tv));
#pragma unroll
          for (int j = 0; j < 2; ++j) { const int idx = tv + 512 * j, row = idx >> 5, i = idx & 31; float x1 = 0.f, x2 = 0.f;
#pragma unroll
              for (int w = 0; w < 8; ++w) { x1 += PS[(w * 96 + 2 * i) * 33 + row]; x2 += PS[(w * 96 + 2 * i + 1) * 33 + row]; }
              const int m = rb * 32 + row; const f32x2 cs = TI[(size_t)m * 32 + i];
              *(unsigned*)(IK + (size_t)m * 64 + 2 * i) = pk2(x1 * cs.x - x2 * cs.y, x2 * cs.x + x1 * cs.y); }
          if (F.tid < 256) { const int row = F.tid >> 3, hh = F.tid & 7; float v = 0.f;
#pragma unroll
              for (int w = 0; w < 8; ++w) v += PS[(w * 96 + 64 + hh) * 33 + row];
              IW[(size_t)(rb * 32 + row) * 8 + hh] = v * IDX_SCALE; } }
    }
}

struct UnitT { int pm, pn, aux; };
struct ProbBase {
    typedef UnitT U;
    int K, G, c;
    __device__ __forceinline__ void lane_offs_plain(const int (&stR)[2], const int (&stC)[2], unsigned (&va)[2][2]) const {
#pragma unroll
        for (int h = 0; h < 2; ++h)
#pragma unroll
            for (int i = 0; i < 2; ++i) va[h][i] = (unsigned)((h * 128 + stR[i]) * K + stC[i]) * 2u;
    }
    __device__ __forceinline__ bool keep(const U&) const { return false; }
    __device__ __forceinline__ void ready(const U&, bool) const {}
};

struct ProbWin : ProbBase {
    static constexpr bool PERM = true;
    const char* A; const char* B; unsigned char* ws; const float* hglb;
    __device__ __forceinline__ bool next(int i, U& u) const { u.aux = 0; return pg8::static_tile(i * G + c, M / 256, NPHYS / 256, u.pm, u.pn); }
    __device__ __forceinline__ void bases(const U& u, const char*& a, const char*& b) const { a = A + (size_t)u.pm * 256 * K * 2; b = B + (size_t)u.pn * 256 * K * 2; }
    __device__ __forceinline__ void lane_offs(const U&, const int (&stR)[2], const int (&stC)[2], unsigned (&va)[2][2]) const { lane_offs_plain(stR, stC, va); }
    __device__ __forceinline__ void epi(f32x4 (&acc)[2][2][4][2], const U& u, int wr, int wc, int fr, int fq) const {
        const int pn = u.pn, row0 = u.pm * 256 + wr * 64 + fr, colw = wc * 32 + 8 * fq;
        if (pn <= 4 || pn == 6 || pn == 7 || pn == 40) {
            const bool d128 = (pn <= 4);
            const float* tab = d128 ? (const float*)(ws + WS_TABA) : (const float*)(ws + WS_TABI);
            const int tp = d128 ? 128 : 64;
            const int i0 = d128 ? (colw >> 1) : (((wc & 1) * 32 + 8 * fq) >> 1);
            bf16_t* O; int pitch, cb; float sc = 1.f;
            if (pn < 4) { O = (bf16_t*)(ws + WS_AQ); pitch = 1024; cb = pn * 256; sc = ATT_SCALE_L2E; }
            else if (pn == 4) { O = (bf16_t*)(ws + WS_AK); pitch = 256; cb = 0; }
            else if (pn < 8) { O = (bf16_t*)(ws + WS_IQ); pitch = 512; cb = (pn - 6) * 256; }
            else { O = (bf16_t*)(ws + WS_IK); pitch = 64; cb = 0; }
            f32x4 tt0[8], tt1[8];
#pragma unroll
            for (int ai = 0; ai < 2; ++ai)
#pragma unroll
                for (int m = 0; m < 4; ++m) { const int row = row0 + ai * 128 + m * 16; tt0[ai * 4 + m] = *(const f32x4*)(tab + (size_t)row * tp + 2 * i0); tt1[ai * 4 + m] = *(const f32x4*)(tab + (size_t)row * tp + 2 * i0 + 4); }
            __builtin_amdgcn_sched_barrier(0);
#pragma unroll
            for (int ai = 0; ai < 2; ++ai)
#pragma unroll
                for (int m = 0; m < 4; ++m) { const int row = row0 + ai * 128 + m * 16;
                    const f32x4 t0 = tt0[ai * 4 + m], t1 = tt1[ai * 4 + m];
#pragma unroll
                    for (int bj = 0; bj < 2; ++bj) {
                        if (pn == 40 && (bj == 1 || wc >= 2)) {
                            if (bj == 0 && wc == 2 && fq == 0) { float* IW = (float*)(ws + WS_IW);
                                *(f32x4*)(IW + (size_t)row * 8) = acc[ai][0][m][0] * IDX_SCALE; *(f32x4*)(IW + (size_t)row * 8 + 4) = acc[ai][0][m][1] * IDX_SCALE; }
                            continue; }
                        const f32x4 v0 = acc[ai][bj][m][0], v1 = acc[ai][bj][m][1];
                        const float o0 = v0[0] * t0[0] - v0[1] * t0[1], o1 = v0[1] * t0[0] + v0[0] * t0[1], o2 = v0[2] * t0[2] - v0[3] * t0[3], o3 = v0[3] * t0[2] + v0[2] * t0[3];
                        const float o4 = v1[0] * t1[0] - v1[1] * t1[1], o5 = v1[1] * t1[0] + v1[0] * t1[1], o6 = v1[2] * t1[2] - v1[3] * t1[3], o7 = v1[3] * t1[2] + v1[2] * t1[3];
                        u32x4 w; w.x = pk2(o0 * sc, o1 * sc); w.y = pk2(o2 * sc, o3 * sc); w.z = pk2(o4 * sc, o5 * sc); w.w = pk2(o6 * sc, o7 * sc);
                        *(u32x4*)(O + (size_t)row * pitch + cb + bj * 128 + colw) = w; } }
        } else if (pn == 5) {
            bf16_t* O = (bf16_t*)(ws + WS_AVT);
#pragma unroll
            for (int ai = 0; ai < 2; ++ai)
#pragma unroll
                for (int m = 0; m < 4; ++m) { const int row = row0 + ai * 128 + m * 16, b = row >> 12, s = row & 4095;
#pragma unroll
                    for (int bj = 0; bj < 2; ++bj)
#pragma unroll
                        for (int n = 0; n < 2; ++n)
#pragma unroll
                            for (int e = 0; e < 4; ++e) { const int d = colw + 4 * n + e; O[((size_t)((b * 2 + bj) * 128 + d)) * SEQ + s] = (bf16_t)(pk2(acc[ai][bj][m][n][e], 0.f) & 0xffffu); } }
        } else if (pn >= 12 && pn < 16) {
            float* LF = (float*)(ws + WS_LOGF); bf16_t* KFo = (bf16_t*)(ws + WS_KF);
            const int cb = (pn - 12) * 256;
            f32x4 lb[2][2];
#pragma unroll
            for (int bj = 0; bj < 2; ++bj)
#pragma unroll
                for (int n = 0; n < 2; ++n) { const int cc = cb + bj * 128 + colw + 4 * n; const f32x4 a0 = *(const f32x4*)(hglb + cc), a1 = *(const f32x4*)(hglb + 1024 + cc);
#pragma unroll
                    for (int e = 0; e < 4; ++e) lb[bj][n][e] = frcp(1.0f + fexp(a1[e] - a0[e])); }
#pragma unroll
            for (int ai = 0; ai < 2; ++ai)
#pragma unroll
                for (int m = 0; m < 4; ++m) { const int row = row0 + ai * 128 + m * 16;
#pragma unroll
                    for (int bj = 0; bj < 2; ++bj) { f32x4 lf[2], kf[2];
#pragma unroll
                        for (int n = 0; n < 2; ++n)
#pragma unroll
                            for (int e = 0; e < 4; ++e) { float xx = acc[ai][bj][m][n][e]; xx = fminf(fmaxf(xx, -30.f), 30.f); const float ee = fexp(-xx), sg = frcp(1.0f + ee), sgn = ee * sg; const float l = lb[bj][n][e];
                                const float f = l + (1.0f - l) * sg; lf[n][e] = __logf(f); kf[n][e] = (1.0f - l) * sgn; }
                        const size_t off = (size_t)row * 1024 + cb + bj * 128 + colw;
                        *(f32x4*)(LF + off) = lf[0]; *(f32x4*)(LF + off + 4) = lf[1];
                        u32x4 w; w.x = pk2(kf[0][0], kf[0][1]); w.y = pk2(kf[0][2], kf[0][3]); w.z = pk2(kf[1][0], kf[1][1]); w.w = pk2(kf[1][2], kf[1][3]);
                        *(u32x4*)(KFo + off) = w; } }
        } else {
            bf16_t* O; int pitch, cb, act;
            if (pn < 12) { O = (bf16_t*)(ws + WS_HQ); pitch = 1024; cb = (pn - 8) * 256; act = 1; }
            else if (pn < 20) { O = (bf16_t*)(ws + WS_HI); pitch = 1024; cb = (pn - 16) * 256; act = 0; }
            else if (pn < 24) { O = (bf16_t*)(ws + WS_HOG); pitch = 1024; cb = (pn - 20) * 256; act = 1; }
            else if (pn < 32) { O = (bf16_t*)(ws + WS_GA); pitch = 2048; cb = (pn - 24) * 256; act = 2; }
            else { O = (bf16_t*)(ws + WS_GH); pitch = 2048; cb = (pn - 32) * 256; act = 2; }
#pragma unroll
            for (int ai = 0; ai < 2; ++ai)
#pragma unroll
                for (int m = 0; m < 4; ++m) { const int row = row0 + ai * 128 + m * 16;
#pragma unroll
                    for (int bj = 0; bj < 2; ++bj) { f32x4 v0 = acc[ai][bj][m][0], v1 = acc[ai][bj][m][1];
                        if (act == 1) {
#pragma unroll
                            for (int e = 0; e < 4; ++e) { v0[e] = siluf_(v0[e]); v1[e] = siluf_(v1[e]); } }
                        else if (act == 2) {
#pragma unroll
                            for (int e = 0; e < 4; ++e) { v0[e] = sigmoidf_(v0[e]); v1[e] = sigmoidf_(v1[e]); } }
                        u32x4 w; w.x = pk2(v0[0], v0[1]); w.y = pk2(v0[2], v0[3]); w.z = pk2(v1[0], v1[1]); w.w = pk2(v1[2], v1[3]);
                        *(u32x4*)(O + (size_t)row * pitch + cb + bj * 128 + colw) = w; } }
        }
    }
};

__device__ __forceinline__ void p3_indexer(Frame& F) {
    const bf16_t* IQ = WSP(bf16_t, WS_IQ); const bf16_t* IK = WSP(bf16_t, WS_IK); const float* IW = WSP(float, WS_IW); float* SC = WSP(float, WS_SCORES);
    const int gw = F.bid * NWAVES + F.wave, NGW = F.G * NWAVES, lane = F.lane, q = lane & 15, quad = lane >> 4;
    for (int it = gw; it < 2 * 2176; it += NGW) {
        const int b = it / 2176; int r = it % 2176; int qg = 0; while (r >= 16 * (qg + 1)) { r -= 16 * (qg + 1); ++qg; }
        const int qi = 16 * qg + r / (qg + 1), ch = r % (qg + 1);
        const int kt0 = 16 * ch, kt1 = min(16 * ch + 16, qi + 1);
        const size_t qrow = (size_t)b * SEQ + 16 * qi + q;
        bf16x8 bq[8][2];
#pragma unroll
        for (int h = 0; h < 8; ++h)
#pragma unroll
            for (int ks = 0; ks < 2; ++ks) bq[h][ks] = *(const bf16x8*)(IQ + qrow * 512 + h * 64 + 32 * ks + 8 * quad);
        const f32x4 w0 = *(const f32x4*)(IW + qrow * 8), w1 = *(const f32x4*)(IW + qrow * 8 + 4);
        const float wv[8] = {w0[0], w0[1], w0[2], w0[3], w1[0], w1[1], w1[2], w1[3]};
        f32x4 scs[16];
        bf16x8 na[4][2];
        const bf16_t* kbase = IK + ((size_t)b * SEQ + q) * 64 + 8 * quad;
        const int ntl = kt1 - kt0, rot = (gw * 5 + (gw >> 4)) % ntl;
#define IX_TILE(j_) (kt0 + (((j_) + rot) % ntl))
#pragma unroll
        for (int j = 0; j < 4; ++j) { const int kt = IX_TILE(j); na[j][0] = *(const bf16x8*)(kbase + (size_t)kt * 1024); na[j][1] = *(const bf16x8*)(kbase + (size_t)kt * 1024 + 32); }
#define IX_BODY(j) { \
                const bf16x8 a0 = na[(j) & 3][0], a1 = na[(j) & 3][1]; \
                if ((j) + 4 < 16) { const int ktn = IX_TILE((j) + 4); na[(j) & 3][0] = *(const bf16x8*)(kbase + (size_t)ktn * 1024); na[(j) & 3][1] = *(const bf16x8*)(kbase + (size_t)ktn * 1024 + 32); } \
                f32x4 dh[8]; \
                _Pragma("unroll") for (int h = 0; h < 8; ++h) dh[h] = __builtin_amdgcn_mfma_f32_16x16x32_bf16(a0, bq[h][0], (f32x4){0.f, 0.f, 0.f, 0.f}, 0, 0, 0); \
                _Pragma("unroll") for (int h = 0; h < 8; ++h) dh[h] = __builtin_amdgcn_mfma_f32_16x16x32_bf16(a1, bq[h][1], dh[h], 0, 0, 0); \
                f32x4 sc = {0.f, 0.f, 0.f, 0.f}; \
                _Pragma("unroll") for (int h = 0; h < 8; ++h) _Pragma("unroll") for (int e = 0; e < 4; ++e) { const int bi = (int)__float_as_uint(dh[h][e]); sc[e] += wv[h] * __uint_as_float((unsigned)(bi > 0 ? bi : 0)); } \
                scs[j] = sc; }
        if (ntl == 16) {
#pragma unroll
            for (int j = 0; j < 16; ++j) IX_BODY(j)
        } else {
#pragma unroll
            for (int j = 0; j < 16; ++j) { scs[j] = (f32x4){0.f, 0.f, 0.f, 0.f}; if (j < ntl) IX_BODY(j) }
        }
#undef IX_BODY
#pragma unroll
        for (int j = 0; j < 16; ++j) { if (j < ntl) *(f32x4*)(SC + qrow * SEQ + 16 * IX_TILE(j) + 4 * quad) = scs[j]; }
#undef IX_TILE
    }
}

constexpr int HG_QD = 0, HG_KD = 17408, HG_VT = 34816, HG_KET = 53248, HG_ATT = 71680, HG_TOT = 80896, HG_O = 83968;

__device__ __forceinline__ void hg_cum(Frame& F, float (&cum)[16], float& cum_last) {
    LAS float* tot = (LAS float*)(F.lds + HG_TOT);
    const int seg = F.tid >> 7, k = F.tid & 127;
    float run = 0.f;
#pragma unroll
    for (int i = 0; i < 16; ++i) { run += cum[i]; cum[i] = run; }
    tot[seg * 128 + k] = run;
    __syncthreads();
    float pre = 0.f, all = 0.f;
#pragma unroll
    for (int s = 0; s < 4; ++s) { const float t = tot[s * 128 + k]; all += t; if (s < seg) pre += t; }
#pragma unroll
    for (int i = 0; i < 16; ++i) cum[i] += pre;
    cum_last = all;
}

__device__ __forceinline__ void p3_hgrn_upd(Frame& F) {
    const float* LOGF = WSP(float, WS_LOGF); const bf16_t* KF = WSP(bf16_t, WS_KF); const bf16_t* HI = WSP(bf16_t, WS_HI);
    bf16_t* UPDT = WSP(bf16_t, WS_UPDT); float* DEC = WSP(float, WS_DECAY);
    LAS bf16_t* VT = (LAS bf16_t*)(F.lds + HG_VT); LAS bf16_t* KET = (LAS bf16_t*)(F.lds + HG_KET);
    const int seg = F.tid >> 7, k = F.tid & 127, lane = F.lane, r32 = lane & 31, hi = lane >> 5;
    float lf[16]; bf16_t lk[16], lv[16];
#define HGU_LOAD(tile_) do { const int b_ = (tile_) >> 9, n_ = ((tile_) >> 3) & 63, h_ = (tile_) & 7; const size_t ob_ = ((size_t)b_ * SEQ + 64 * n_ + 16 * seg) * 1024 + h_ * 128 + k; \
        _Pragma("unroll") for (int i = 0; i < 16; ++i) { lf[i] = LOGF[ob_ + i * 1024]; lk[i] = KF[ob_ + i * 1024]; lv[i] = HI[ob_ + i * 1024]; } } while (0)
    if (F.bid < 1024) HGU_LOAD(F.bid);
    for (int tile = F.bid; tile < 1024; tile += F.G) {
        __syncthreads();
        float cum[16], cl;
#pragma unroll
        for (int i = 0; i < 16; ++i) cum[i] = lf[i];
        hg_cum(F, cum, cl);
        { unsigned pk[8], pv[8];
#pragma unroll
          for (int i = 0; i < 16; i += 2) {
              const float k0 = bf2f(lk[i]) * fexp(cl - cum[i]), k1 = bf2f(lk[i + 1]) * fexp(cl - cum[i + 1]); pk[i >> 1] = pk2(k0, k1);
              pv[i >> 1] = (unsigned)lv[i] | ((unsigned)lv[i + 1] << 16); }
          LAS u32x4* dk = (LAS u32x4*)(KET + k * 72 + 16 * seg); dk[0] = (u32x4){pk[0], pk[1], pk[2], pk[3]}; dk[1] = (u32x4){pk[4], pk[5], pk[6], pk[7]};
          LAS u32x4* dv = (LAS u32x4*)(VT + k * 72 + 16 * seg); dv[0] = (u32x4){pv[0], pv[1], pv[2], pv[3]}; dv[1] = (u32x4){pv[4], pv[5], pv[6], pv[7]};
          if (seg == 0) DEC[(size_t)tile * 128 + k] = fexp(cl); }
        __builtin_amdgcn_sched_barrier(0);
        if (tile + F.G < 1024) HGU_LOAD(tile + F.G);
        __syncthreads();
        const int vt = F.wave & 3, kt0 = (F.wave >> 2) * 2;
        f32x16 c0 = {}, c1 = {};
#pragma unroll
        for (int ks = 0; ks < 4; ++ks) { const bf16x8 a = *(const LAS bf16x8*)(VT + (vt * 32 + r32) * 72 + 16 * ks + 8 * hi);
            const bf16x8 b0 = *(const LAS bf16x8*)(KET + (kt0 * 32 + r32) * 72 + 16 * ks + 8 * hi), b1 = *(const LAS bf16x8*)(KET + (kt0 * 32 + 32 + r32) * 72 + 16 * ks + 8 * hi);
            c0 = mfma32(a, b0, c0); c1 = mfma32(a, b1, c1); }
        bf16_t* U = UPDT + (size_t)tile * 16384;
#pragma unroll
        for (int r = 0; r < 16; ++r) { const int v = vt * 32 + crow(r, hi);
            const float n0 = __uint_as_float((unsigned)__builtin_amdgcn_update_dpp(0, (int)__float_as_uint(c0[r]), 0xB1, 0xF, 0xF, false));
            const float n1 = __uint_as_float((unsigned)__builtin_amdgcn_update_dpp(0, (int)__float_as_uint(c1[r]), 0xB1, 0xF, 0xF, false));
            if (!(lane & 1)) { *(unsigned*)(U + v * 128 + kt0 * 32 + r32) = pk2(c0[r], n0); *(unsigned*)(U + v * 128 + kt0 * 32 + 32 + r32) = pk2(c1[r], n1); } }
    }
#undef HGU_LOAD
}

__device__ __forceinline__ void p4_hgrn_scan(Frame& F) {
    const bf16_t* UPDT = WSP(bf16_t, WS_UPDT); const float* DEC = WSP(float, WS_DECAY); bf16_t* SP = WSP(bf16_t, WS_SPREVT);
    const int gt = F.bid * NTHREADS + F.tid, NGT = F.G * NTHREADS;
    for (int e = gt; e < 2 * 8 * 16384 / 2; e += NGT) {
        const int bh = e >> 13, vk = (e & 8191) * 2, b = bh >> 3, h = bh & 7, k = vk & 127;
        float s0 = 0.f, s1 = 0.f;
#pragma unroll 8
        for (int n = 0; n < 64; ++n) { const size_t tile = (size_t)(b * 64 + n) * 8 + h;
            const unsigned uu = __builtin_nontemporal_load((const unsigned*)(UPDT + tile * 16384 + vk)); const f32x2 d = *(const f32x2*)(DEC + tile * 128 + k);
            *(unsigned*)(SP + tile * 16384 + vk) = pk2(s0, s1);
            s0 = d.x * s0 + bf2f(uu & 0xffffu); s1 = d.y * s1 + bf2f(uu >> 16); }
    }
}

__device__ __forceinline__ void p5_hgrn_out(Frame& F) {
    const float* LOGF = WSP(float, WS_LOGF); const bf16_t* KF = WSP(bf16_t, WS_KF); const bf16_t* HI = WSP(bf16_t, WS_HI); const bf16_t* HQ = WSP(bf16_t, WS_HQ);
    const bf16_t* HOG = WSP(bf16_t, WS_HOG); const bf16_t* SP = WSP(bf16_t, WS_SPREVT); bf16_t* YHG = WSP(bf16_t, WS_YHG);
    LAS bf16_t* QD = (LAS bf16_t*)(F.lds + HG_QD); LAS bf16_t* KD = (LAS bf16_t*)(F.lds + HG_KD); LAS bf16_t* VT = (LAS bf16_t*)(F.lds + HG_VT);
    LAS bf16_t* ATT = (LAS bf16_t*)(F.lds + HG_ATT); LAS float* OB = (LAS float*)(F.lds + HG_O);
    const int seg = F.tid >> 7, k = F.tid & 127, lane = F.lane, r32 = lane & 31, hi = lane >> 5;
    float lf[16]; bf16_t lq[16], lk[16], lv[16];
#define HGO_LOAD(tile_) do { const int b_ = (tile_) >> 9, n_ = ((tile_) >> 3) & 63, h_ = (tile_) & 7; const size_t ob_ = ((size_t)b_ * SEQ + 64 * n_ + 16 * seg) * 1024 + h_ * 128 + k; \
        _Pragma("unroll") for (int i = 0; i < 16; ++i) { lf[i] = LOGF[ob_ + i * 1024]; lq[i] = HQ[ob_ + i * 1024]; lk[i] = KF[ob_ + i * 1024]; lv[i] = HI[ob_ + i * 1024]; } } while (0)
    if (F.bid < 1024) HGO_LOAD(F.bid);
    for (int tile = F.bid; tile < 1024; tile += F.G) {
        const int b = tile >> 9, n = (tile >> 3) & 63, h = tile & 7; const size_t m0 = (size_t)b * SEQ + 64 * n;
        __syncthreads();
        float cum[16], cl;
#pragma unroll
        for (int i = 0; i < 16; ++i) cum[i] = lf[i];
        hg_cum(F, cum, cl);
        { unsigned pv[8];
          __builtin_amdgcn_sched_barrier(0);
#pragma unroll
          for (int i = 0; i < 16; ++i) {
              const float qd = bf2f(lq[i]) * fexp(cum[i]), kd = bf2f(lk[i]) * fexp(-cum[i]);
              QD[(16 * seg + i) * 136 + k] = (bf16_t)(pk2(qd, 0.f) & 0xffffu); KD[(16 * seg + i) * 136 + k] = (bf16_t)(pk2(kd, 0.f) & 0xffffu);
              if (i & 1) pv[i >> 1] |= ((unsigned)lv[i] << 16); else pv[i >> 1] = (unsigned)lv[i]; }
          LAS u32x4* dv = (LAS u32x4*)(VT + k * 72 + 16 * seg); dv[0] = (u32x4){pv[0], pv[1], pv[2], pv[3]}; dv[1] = (u32x4){pv[4], pv[5], pv[6], pv[7]}; }
        const int tt = F.wave >> 2, vt = F.wave & 3;
        bf16x8 sb[8];
        { const bf16_t* S = SP + (size_t)tile * 16384 + (size_t)(vt * 32 + r32) * 128;
#pragma unroll
          for (int ks = 0; ks < 8; ++ks) sb[ks] = *(const bf16x8*)(S + 16 * ks + 8 * hi); }
        __builtin_amdgcn_sched_barrier(0);
        if (tile + F.G < 1024) HGO_LOAD(tile + F.G);
        __syncthreads();
        if (F.wave < 4) { const int ta = F.wave >> 1, sa = F.wave & 1; f32x16 c = {};
            if (sa <= ta) {
#pragma unroll
                for (int ks = 0; ks < 8; ++ks) { const bf16x8 a = *(const LAS bf16x8*)(QD + (ta * 32 + r32) * 136 + 16 * ks + 8 * hi), bb = *(const LAS bf16x8*)(KD + (sa * 32 + r32) * 136 + 16 * ks + 8 * hi); c = mfma32(a, bb, c); } }
#pragma unroll
            for (int r = 0; r < 16; ++r) { const int t = ta * 32 + crow(r, hi), s = sa * 32 + r32; const float v = (s <= t) ? c[r] : 0.f; ATT[t * 72 + s] = (bf16_t)(pk2(v, 0.f) & 0xffffu); } }
        f32x16 o = {};
        {
#pragma unroll
          for (int ks = 0; ks < 8; ++ks) { const bf16x8 a = *(const LAS bf16x8*)(QD + (tt * 32 + r32) * 136 + 16 * ks + 8 * hi); o = mfma32(a, sb[ks], o); } }
        __syncthreads();
#pragma unroll
        for (int ks = 0; ks < 4; ++ks) { const bf16x8 a = *(const LAS bf16x8*)(ATT + (tt * 32 + r32) * 72 + 16 * ks + 8 * hi), bb = *(const LAS bf16x8*)(VT + (vt * 32 + r32) * 72 + 16 * ks + 8 * hi); o = mfma32(a, bb, o); }
#pragma unroll
        for (int r = 0; r < 16; ++r) OB[(tt * 32 + crow(r, hi)) * 132 + vt * 32 + r32] = o[r];
        __syncthreads();
        { const int t = F.tid >> 3, part = F.tid & 7; float v[16], ss = 0.f;
#pragma unroll
          for (int i = 0; i < 16; i += 4) { const f32x4 x = *(const LAS f32x4*)(OB + t * 132 + part * 16 + i); v[i] = x[0]; v[i + 1] = x[1]; v[i + 2] = x[2]; v[i + 3] = x[3]; ss += (x[0] * x[0] + x[1] * x[1]) + (x[2] * x[2] + x[3] * x[3]); }
          ss += __shfl_xor(ss, 1); ss += __shfl_xor(ss, 2); ss += __shfl_xor(ss, 4);
          const float rs = 1.0f / sqrtf(ss * (1.0f / 128.0f) + EPS);
          const size_t off = (m0 + t) * 1024 + h * 128 + part * 16; unsigned w[8];
          const u32x4 g0 = *(const u32x4*)(HOG + off), g1 = *(const u32x4*)(HOG + off + 8); const unsigned gg[8] = {g0.x, g0.y, g0.z, g0.w, g1.x, g1.y, g1.z, g1.w};
          const float* ghp = F.g_head + h * 128 + part * 16; const f32x4 gh0 = *(const f32x4*)ghp, gh1 = *(const f32x4*)(ghp + 4), gh2 = *(const f32x4*)(ghp + 8), gh3 = *(const f32x4*)(ghp + 12);
          const float ghv[16] = {gh0[0], gh0[1], gh0[2], gh0[3], gh1[0], gh1[1], gh1[2], gh1[3], gh2[0], gh2[1], gh2[2], gh2[3], gh3[0], gh3[1], gh3[2], gh3[3]};
#pragma unroll
          for (int i = 0; i < 8; ++i) { w[i] = pk2(v[2 * i] * rs * ghv[2 * i] * bf2f(gg[i] & 0xffffu), v[2 * i + 1] * rs * ghv[2 * i + 1] * bf2f(gg[i] >> 16)); }
          *(u32x4*)(YHG + off) = (u32x4){w[0], w[1], w[2], w[3]}; *(u32x4*)(YHG + off + 8) = (u32x4){w[4], w[5], w[6], w[7]}; }
    }
}

__device__ __forceinline__ unsigned f2ord(float f) { const unsigned u = __float_as_uint(f); return (u & 0x80000000u) ? ~u : (u | 0x80000000u); }
__device__ __forceinline__ void p4_sel_load(const float* SC, int row, int lane, unsigned (&nu)[64]) {
    const int t = row & (SEQ - 1);
    if (t >= TOPK) { const float* srow = SC + (size_t)row * SEQ; const int ng = (t >> 9) + 1;
#pragma unroll
        for (int g = 0; g < 8; ++g) {
            if (g < ng) {
#pragma unroll
                for (int j = 0; j < 8; ++j) nu[8 * g + j] = __float_as_uint(__builtin_nontemporal_load(srow + 64 * (8 * g + j) + lane));
            }
        }
    }
}
__device__ __forceinline__ void p4_select(Frame& F) {
    const float* SC = WSP(float, WS_SCORES); unsigned long long* MASK = WSP(unsigned long long, WS_MASK);
    const int gw = F.bid * NWAVES + F.wave, NGW = F.G * NWAVES, lane = F.lane;
    constexpr int NPAIR = NBATCH * (SEQ / 2);
#define SEL_ROW(k_) ({ const int idx_ = gw + ((k_) >> 1) * NGW; const int b_ = idx_ / (SEQ / 2), p_ = idx_ % (SEQ / 2); b_ * SEQ + (((k_) & 1) ? (SEQ - 1 - p_) : p_); })
#define SEL_HAVE(k_) (gw + ((k_) >> 1) * NGW < NPAIR)
    unsigned nu[64];
#pragma unroll
    for (int i = 0; i < 64; ++i) nu[i] = 0u;
    int k = 0; bool have = SEL_HAVE(0); int row = have ? SEL_ROW(0) : 0;
    if (have) p4_sel_load(SC, row, lane, nu);
    while (have) {
        const int t = row & (SEQ - 1);
        unsigned long long mine = 0ull;
        unsigned u[64];
        const int ng = (t >> 9) + 1;
        if (t >= TOPK) {
#pragma unroll
            for (int g = 0; g < 8; ++g) {
                if (g < ng) {
#pragma unroll
                    for (int j = 0; j < 8; ++j) { const int i = 8 * g + j; const unsigned bits = nu[i]; u[i] = bits ^ ((unsigned)((int)bits >> 31) | 0x80000000u); }
                    if (g == ng - 1) {
#pragma unroll
                        for (int j = 0; j < 8; ++j) { const int i = 8 * g + j, s = 64 * i + lane; u[i] = (s <= t) ? u[i] : 0u; }
                    }
                } else {
#pragma unroll
                    for (int j = 0; j < 8; ++j) u[8 * g + j] = 0u;
                }
            }
        }
        __builtin_amdgcn_sched_barrier(0);
        ++k; const bool haveN = SEL_HAVE(k); const int rowN = haveN ? SEL_ROW(k) : 0;
        if (haveN) p4_sel_load(SC, rowN, lane, nu);
        __builtin_amdgcn_sched_barrier(0);
        if (t < TOPK) {
            const int lo = 64 * lane;
            mine = (t >= lo + 63) ? ~0ull : (t < lo ? 0ull : ((1ull << (t - lo + 1)) - 1ull));
        } else {
            const int ntot = 512 * ng;
            unsigned hp[32];
#pragma unroll
            for (int i = 0; i < 32; ++i) hp[i] = (u[2 * i] >> 16) | (u[2 * i + 1] & 0xffff0000u);
            unsigned T = 0u; bool exact = false; int geT = ntot;
            { const unsigned one2 = 0x00010001u; unsigned Th = 0u;
              for (int bit = 15; bit >= 0; --bit) {
                  const unsigned ch = Th | (1u << bit); unsigned c2 = ch | (ch << 16), acc2 = 0u;
                  asm volatile("" : "+v"(c2));
#pragma unroll
                  for (int g = 0; g < 8; ++g) {
                      if (g < ng) {
#pragma unroll
                          for (int j = 0; j < 4; ++j) { unsigned d;
                              asm("v_pk_sub_u16 %0, %1, %2 clamp" : "=v"(d) : "v"(c2), "v"(hp[4 * g + j]));
                              asm("v_pk_min_u16 %0, %1, %2" : "=v"(d) : "v"(d), "v"(one2));
                              asm("v_pk_add_u16 %0, %1, %2" : "=v"(acc2) : "v"(acc2), "v"(d)); }
                      }
                  }
                  const int ge = ntot - wave_sum_i_dpp((int)((acc2 & 0xffffu) + (acc2 >> 16)));
                  if (ge >= TOPK) { Th = ch; geT = ge; if (ge == TOPK) { exact = true; break; } }
              }
              T = Th << 16; }
            if (!exact) {
                for (int bit = 15; bit >= 0; --bit) {
                    unsigned cand = T | (1u << bit); int c = 0;
                    asm volatile("" : "+v"(cand));
#pragma unroll
                    for (int g = 0; g < 8; ++g) {
                        if (g < ng) {
#pragma unroll
                            for (int j = 0; j < 8; j += 2) { unsigned d0, d1;
                                asm("v_sub_u32_e64 %0, %1, %2 clamp" : "=v"(d0) : "v"(cand), "v"(u[8 * g + j]));
                                asm("v_sub_u32_e64 %0, %1, %2 clamp" : "=v"(d1) : "v"(cand), "v"(u[8 * g + j + 1]));
                                asm("v_min_u32_e32 %0, 1, %1" : "=v"(d0) : "v"(d0));
                                asm("v_min_u32_e32 %0, 1, %1" : "=v"(d1) : "v"(d1));
                                c += (int)(d0 + d1); }
                        }
                    }
                    const int ge = ntot - wave_sum_i_dpp(c);
                    if (ge >= TOPK) { T = cand; geT = ge; if (ge == TOPK) break; }
                }
            }
            const bool allties = (geT == TOPK);
            int need = 0;
            if (!allties) { int cg = 0;
#pragma unroll
                for (int g = 0; g < 8; ++g) {
                    if (g < ng) {
#pragma unroll
                        for (int j = 0; j < 8; ++j) cg += (u[8 * g + j] > T) ? 1 : 0;
                    }
                }
                need = TOPK - wave_sum_i_dpp(cg); }
            int running = 0; const unsigned long long lt = (1ull << lane) - 1ull;
#pragma unroll
            for (int g = 0; g < 8; ++g) {
                if (g < ng) {
#pragma unroll
                    for (int j = 0; j < 8; ++j) { const int i = 8 * g + j;
                        unsigned long long sb;
                        if (allties) sb = __ballot(u[i] >= T);
                        else { const bool eq = (u[i] == T); const unsigned long long bal = __ballot(eq);
                            const int rank = running + __popcll(bal & lt); running += __popcll(bal);
                            sb = __ballot((u[i] > T) || (eq && rank < need)); }
                        if (lane == i) mine = sb; }
                }
            }
        }
        MASK[(size_t)row * 64 + lane] = mine;
        row = rowN; have = haveN;
    }
#undef SEL_ROW
#undef SEL_HAVE
}

constexpr int AT_K = 0, AT_V = 34816, AT_END = 34816 + 34816;
constexpr int AT_MRG = 0, AT_STG = 69632;
__device__ __forceinline__ void p5_attention(Frame& F) {
    const bf16_t* AQ = WSP(bf16_t, WS_AQ); const bf16_t* AK = WSP(bf16_t, WS_AK); const bf16_t* AVT = WSP(bf16_t, WS_AVT); const unsigned* MASK = WSP(unsigned, WS_MASK); bf16_t* YATT = WSP(bf16_t, WS_YATT);
    const int lane = F.lane, r32 = lane & 31, hi = lane >> 5, w = F.wave, kp = w >> 2, tid = F.tid;
    LAS unsigned char* lds = F.lds;
    for (int item = F.bid; item < 256; item += F.G) {
        const int b = item >> 7, hk = (item >> 6) & 1, jj = item & 63;
        for (int uu = 0; uu < 2; ++uu) {
            const int j = uu ? 127 - jj : jj;
            const int head = hk * 4 + (w & 3);
            const size_t qrow = (size_t)b * SEQ + 32 * j + r32;
            const int NT = (j + 2) >> 1, NI = (NT + 1) >> 1;
            bf16x8 qf[8];
#pragma unroll
            for (int ks = 0; ks < 8; ++ks) qf[ks] = *(const bf16x8*)(AQ + qrow * 1024 + head * 128 + 16 * ks + 8 * hi);
            f32x16 o[4]; o[0] = f32x16{}; o[1] = f32x16{}; o[2] = f32x16{}; o[3] = f32x16{};
            float mrun = -INFINITY, lrun = 0.f;
            u32x4 sk[4], sv[4];
#pragma unroll
            for (int c = 0; c < 4; ++c) { sk[c] = (u32x4){0u, 0u, 0u, 0u}; sv[c] = (u32x4){0u, 0u, 0u, 0u}; }
            const bf16_t* Kg = AK + (size_t)b * SEQ * 256 + hk * 128;
            const bf16_t* Vg = AVT + (size_t)((b * 2 + hk) * 128) * SEQ;
#define AT_LOAD(it_) do { int tv = tid; asm volatile("" : "+v"(tv)); const unsigned kb2 = (unsigned)(it_) * 128u; \
                const unsigned ko = ((kb2 + (unsigned)(tv >> 4)) * 256u + (unsigned)(tv & 15) * 8u) * 2u; \
                const unsigned vo = ((unsigned)(tv >> 3) * (unsigned)SEQ + kb2 + (unsigned)(tv & 7) * 8u) * 2u; \
                _Pragma("unroll") for (int c = 0; c < 4; ++c) { \
                    sk[c] = *(const u32x4*)((const char*)Kg + ko + (unsigned)c * 32u * 512u); \
                    sv[c] = *(const u32x4*)((const char*)Vg + vo + (unsigned)(c & 1) * 64u * (unsigned)SEQ * 2u + (unsigned)(c >> 1) * 128u); } } while (0)
#define AT_STORE(bo_) do { \
                _Pragma("unroll") for (int c = 0; c < 4; ++c) { const int id = c * 512 + tid; const int key = id >> 4, ch = id & 15; \
                    *(LAS u32x4*)(lds + (bo_) + AT_K + key * 272 + ch * 16) = sk[c]; \
                    const int vd = (id >> 3) & 127, vp = id >> 10, vc = id & 7; \
                    LAS u32x2* dst = (LAS u32x2*)(lds + (bo_) + AT_V + vp * 17408 + vd * 136 + vc * 16); dst[0] = (u32x2){sv[c].x, sv[c].y}; dst[1] = (u32x2){sv[c].z, sv[c].w}; } } while (0)
            AT_LOAD(0);
            u32x2 mwn = (kp < NT) ? *(const u32x2*)(MASK + qrow * 128 + 2 * kp) : (u32x2){0u, 0u};
            __syncthreads();
            AT_STORE(0);
            if (NI > 1) AT_LOAD(1);
            __syncthreads();
            for (int it = 0; it < NI; ++it) {
                const int bo = (it & 1) * 69632;
                if (kp == 1 && it + 1 < NI) { AT_STORE(((it + 1) & 1) * 69632); if (it + 2 < NI) AT_LOAD(it + 2); }
                const int kt = 2 * it + kp;
                const u32x2 mw = mwn;
                if (kt + 2 < NT) mwn = *(const u32x2*)(MASK + qrow * 128 + 2 * (kt + 2));
                if (kt < NT) {
                    const LAS unsigned char* Kp = lds + bo + AT_K + kp * 17408; const LAS unsigned char* Vp = lds + bo + AT_V + kp * 17408;
                    f32x16 p0 = {}, p1 = {};
                    { bf16x8 kf[2][2][2];
#define AT_KLOAD(ks_, buf_) do { kf[buf_][(ks_) & 1][0] = *(const LAS bf16x8*)(Kp + r32 * 272 + (16 * (ks_) + 8 * hi) * 2); kf[buf_][(ks_) & 1][1] = *(const LAS bf16x8*)(Kp + (32 + r32) * 272 + (16 * (ks_) + 8 * hi) * 2); } while (0)
                      AT_KLOAD(0, 0); AT_KLOAD(1, 0);
#pragma unroll
                      for (int kk = 0; kk < 4; ++kk) {
                          __builtin_amdgcn_sched_barrier(0);
                          if (kk < 3) { AT_KLOAD(2 * kk + 2, (kk + 1) & 1); AT_KLOAD(2 * kk + 3, (kk + 1) & 1); }
#pragma unroll
                          for (int k2 = 0; k2 < 2; ++k2) { p0 = mfma32(kf[kk & 1][k2][0], qf[2 * kk + k2], p0); p1 = mfma32(kf[kk & 1][k2][1], qf[2 * kk + k2], p1); } }
#undef AT_KLOAD
                    }
                    __builtin_amdgcn_sched_barrier(0);
                    u32x4 vf[2][4];
#define AT_VLOAD(dt_, buf_) do { _Pragma("unroll") for (int s = 0; s < 4; ++s) { const LAS unsigned char* vr = Vp + ((dt_) * 32 + r32) * 136 + (16 * s + 4 * hi) * 2; \
                        const u32x2 lo = *(const LAS u32x2*)vr, hh = *(const LAS u32x2*)(vr + 16); vf[buf_][s] = (u32x4){lo.x, lo.y, hh.x, hh.y}; } } while (0)
                    AT_VLOAD(0, 0);
                    float rm = fmaxf(p0[0], p1[0]);
#pragma unroll
                    for (int r = 1; r < 16; ++r) rm = fmaxf(rm, fmaxf(p0[r], p1[r]));
                    rm = fmaxf(rm, __shfl_xor(rm, 32));
                    if (__any(rm > mrun + 8.0f)) { const float mnew = fmaxf(mrun, rm), alpha = __builtin_amdgcn_exp2f(mrun - mnew); lrun *= alpha; mrun = mnew;
#pragma unroll
                        for (int dt = 0; dt < 4; ++dt)
#pragma unroll
                            for (int r = 0; r < 16; ++r) o[dt][r] *= alpha; }
                    const int mx0 = (int)(mw.x >> (4 * hi)), mx1 = (int)(mw.y >> (4 * hi));
                    float ps = 0.f;
#pragma unroll
                    for (int r = 0; r < 16; ++r) { const int bp = (r & 3) + 8 * (r >> 2);
                        int k0 = __builtin_amdgcn_sbfe(mx0, bp, 1), k1 = __builtin_amdgcn_sbfe(mx1, bp, 1);
                        asm volatile("" : "+v"(k0), "+v"(k1));
                        p0[r] = __uint_as_float(__float_as_uint(__builtin_amdgcn_exp2f(p0[r] - mrun)) & (unsigned)k0);
                        p1[r] = __uint_as_float(__float_as_uint(__builtin_amdgcn_exp2f(p1[r] - mrun)) & (unsigned)k1);
                        ps += p0[r] + p1[r]; }
                    lrun += ps;
                    bf16x8 pb[4];
#pragma unroll
                    for (int s = 0; s < 2; ++s) { u32x4 t0, t1;
                        t0.x = pk2(p0[8 * s + 0], p0[8 * s + 1]); t0.y = pk2(p0[8 * s + 2], p0[8 * s + 3]); t0.z = pk2(p0[8 * s + 4], p0[8 * s + 5]); t0.w = pk2(p0[8 * s + 6], p0[8 * s + 7]);
                        t1.x = pk2(p1[8 * s + 0], p1[8 * s + 1]); t1.y = pk2(p1[8 * s + 2], p1[8 * s + 3]); t1.z = pk2(p1[8 * s + 4], p1[8 * s + 5]); t1.w = pk2(p1[8 * s + 6], p1[8 * s + 7]);
                        pb[s] = __builtin_bit_cast(bf16x8, t0); pb[2 + s] = __builtin_bit_cast(bf16x8, t1); }
#pragma unroll
                    for (int dt = 0; dt < 4; ++dt) {
                        __builtin_amdgcn_sched_barrier(0);
                        if (dt < 3) AT_VLOAD(dt + 1, (dt + 1) & 1);
#pragma unroll
                        for (int s = 0; s < 4; ++s) o[dt] = mfma32(__builtin_bit_cast(bf16x8, vf[dt & 1][s]), pb[s], o[dt]); }
#undef AT_VLOAD
                    __builtin_amdgcn_sched_barrier(0);
                }
                if (kp == 0 && it + 1 < NI) { AT_STORE(((it + 1) & 1) * 69632); if (it + 2 < NI) AT_LOAD(it + 2); }
                __syncthreads();
            }
            __syncthreads();
            LAS float* mg = (LAS float*)(lds + AT_MRG) + (w & 3) * 66 * 64;
            if (kp == 1) { mg[lane] = mrun; mg[64 + lane] = lrun;
#pragma unroll
                for (int dt = 0; dt < 4; ++dt)
#pragma unroll
                    for (int r = 0; r < 16; ++r) mg[(2 + dt * 16 + r) * 64 + lane] = o[dt][r]; }
            __syncthreads();
            if (kp == 0) {
                const float m1 = mg[lane], l1 = mg[64 + lane];
                const float mt = fmaxf(mrun, m1), mu = (mt == -INFINITY) ? 0.f : mt;
                const float a0 = __builtin_amdgcn_exp2f(mrun - mu), a1 = __builtin_amdgcn_exp2f(m1 - mu);
                float l = lrun * a0 + l1 * a1; l += __shfl_xor(l, 32);
                const float inv = 1.0f / l;
                LAS bf16_t* stg = (LAS bf16_t*)(lds + AT_STG) + (w & 3) * 32 * 136;
#pragma unroll
                for (int dt = 0; dt < 4; ++dt)
#pragma unroll
                    for (int r = 0; r < 16; ++r) { const float v = (o[dt][r] * a0 + mg[(2 + dt * 16 + r) * 64 + lane] * a1) * inv; stg[r32 * 136 + dt * 32 + crow(r, hi)] = (bf16_t)(pk2(v, 0.f) & 0xffffu); }
                LDS_WAIT();
#pragma unroll
                for (int i = 0; i < 8; ++i) { const int rr = i * 4 + (lane >> 4), ch = lane & 15; const u32x4 v = *(const LAS u32x4*)(stg + rr * 136 + ch * 8);
                    *(u32x4*)(YATT + ((size_t)b * SEQ + 32 * j + rr) * 1024 + head * 128 + ch * 8) = v; }
            }
        }
    }
#undef AT_LOAD
#undef AT_STORE
}

struct ProbMerge : ProbBase {
    static constexpr bool PERM = true;
    unsigned char* ws;
    __device__ __forceinline__ bool next(int i, U& u) const { u.aux = i & 1; return pg8::static_tile((i >> 1) * G + c, M / 256, DM / 256, u.pm, u.pn); }
    __device__ __forceinline__ void bases(const U& u, const char*& a, const char*& b) const {
        a = (const char*)(ws + (u.aux ? WS_YHG : WS_YATT)) + (size_t)u.pm * 256 * K * 2; b = (const char*)(ws + (u.aux ? WS_WHU_T : WS_WAU_T)) + (size_t)u.pn * 256 * K * 2; }
    __device__ __forceinline__ void lane_offs(const U&, const int (&stR)[2], const int (&stC)[2], unsigned (&va)[2][2]) const { lane_offs_plain(stR, stC, va); }
    __device__ __forceinline__ bool keep(const U& u) const { return u.aux == 0; }
    __device__ __forceinline__ void epi(f32x4 (&acc)[2][2][4][2], const U& u, int wr, int wc, int fr, int fq) const {
        const bf16_t* GA = (const bf16_t*)(ws + WS_GA); const bf16_t* GH = (const bf16_t*)(ws + WS_GH); bf16_t* O = (bf16_t*)(ws + WS_MERGED);
        const int row0 = u.pm * 256 + wr * 64 + fr, colw = u.pn * 256 + wc * 32 + 8 * fq;
#pragma unroll
        for (int ai = 0; ai < 2; ++ai) {
            u32x4 gh[4][2], ga[4][2];
#pragma unroll
            for (int m = 0; m < 4; ++m)
#pragma unroll
                for (int bj = 0; bj < 2; ++bj) { const size_t off = (size_t)(row0 + ai * 128 + m * 16) * DM + colw + bj * 128; gh[m][bj] = *(const u32x4*)(GH + off); if (u.aux == 0) ga[m][bj] = __builtin_nontemporal_load((const u32x4*)(GA + off)); else ga[m][bj] = gh[m][bj]; }
            __builtin_amdgcn_sched_barrier(0);
#pragma unroll
            for (int m = 0; m < 4; ++m)
#pragma unroll
                for (int bj = 0; bj < 2; ++bj) { const size_t off = (size_t)(row0 + ai * 128 + m * 16) * DM + colw + bj * 128;
                    const unsigned ghw[4] = {gh[m][bj].x, gh[m][bj].y, gh[m][bj].z, gh[m][bj].w}; const unsigned gaw[4] = {ga[m][bj].x, ga[m][bj].y, ga[m][bj].z, ga[m][bj].w};
                    if (u.aux == 0) {
#pragma unroll
                        for (int n = 0; n < 2; ++n)
#pragma unroll
                            for (int e = 0; e < 4; ++e) { const int wi = 2 * n + (e >> 1); const float a = (e & 1) ? bf2f(gaw[wi] >> 16) : bf2f(gaw[wi] & 0xffffu), h = (e & 1) ? bf2f(ghw[wi] >> 16) : bf2f(ghw[wi] & 0xffffu);
                                acc[ai][bj][m][n][e] *= a * frcp(fmaxf(h, 1e-20f)); } }
                    else { float v[8];
#pragma unroll
                        for (int n = 0; n < 2; ++n)
#pragma unroll
                            for (int e = 0; e < 4; ++e) { const int wi = 2 * n + (e >> 1); const float h = (e & 1) ? bf2f(ghw[wi] >> 16) : bf2f(ghw[wi] & 0xffffu); v[4 * n + e] = acc[ai][bj][m][n][e] * h; }
                        u32x4 w; w.x = pk2(v[0], v[1]); w.y = pk2(v[2], v[3]); w.z = pk2(v[4], v[5]); w.w = pk2(v[6], v[7]); *(u32x4*)(O + off) = w; } }
            __builtin_amdgcn_sched_barrier(0);
        }
    }
};

struct ProbOut : ProbBase {
    static constexpr bool PERM = false;
    unsigned char* ws; const float* x; float* out;
    __device__ __forceinline__ bool next(int i, U& u) const { u.aux = 0; return pg8::static_tile(i * G + c, M / 256, DM / 256, u.pm, u.pn); }
    __device__ __forceinline__ void bases(const U& u, const char*& a, const char*& b) const { a = (const char*)(ws + WS_MERGED) + (size_t)u.pm * 256 * K * 2; b = (const char*)(ws + WS_WOUT_T) + (size_t)u.pn * 256 * K * 2; }
    __device__ __forceinline__ void lane_offs(const U&, const int (&stR)[2], const int (&stC)[2], unsigned (&va)[2][2]) const { lane_offs_plain(stR, stC, va); }
    __device__ __forceinline__ void epi(f32x4 (&acc)[2][2][4][2], const U& u, int wr, int wc, int fr, int fq) const {
        const float* MOD = (const float*)(ws + WS_MOD);
        const int row0 = u.pm * 256 + wr * 64 + fr, col0 = u.pn * 256 + wc * 32 + 4 * fq, b = (u.pm * 256) >> 12;
#pragma unroll
        for (int bj = 0; bj < 2; ++bj)
#pragma unroll
            for (int n = 0; n < 2; ++n) { const int col = col0 + bj * 128 + n * 16; const f32x4 gt = *(const f32x4*)(MOD + b * 12288 + 2 * DM + col);
                f32x4 xv[8];
#pragma unroll
                for (int ai = 0; ai < 2; ++ai)
#pragma unroll
                    for (int m = 0; m < 4; ++m) xv[ai * 4 + m] = __builtin_nontemporal_load((const f32x4*)(x + (size_t)(row0 + ai * 128 + m * 16) * DM + col));
                __builtin_amdgcn_sched_barrier(0);
#pragma unroll
                for (int ai = 0; ai < 2; ++ai)
#pragma unroll
                    for (int m = 0; m < 4; ++m) { const size_t off = (size_t)(row0 + ai * 128 + m * 16) * DM + col; *(f32x4*)(out + off) = xv[ai * 4 + m] + gt * acc[ai][bj][m][n]; }
                __builtin_amdgcn_sched_barrier(0); }
    }
};

__device__ __forceinline__ void p8_norm2_route(Frame& F) {
    LAS float* CA = (LAS float*)F.lds; LAS float* CB = CA + DM;
    LAS float* WB = CB + DM;
    LAS float* LOGI = WB + 2 * 9216;
    const float* MOD = WSP(float, WS_MOD); bf16_t* XN = WSP(bf16_t, WS_XN); const float* X1 = F.out;
    int* LIST = WSP(int, WS_LIST); float* LISTW = WSP(float, WS_LISTW);
    const int lane = F.lane, tid = F.tid;
#define RT_STAGE(j_, buf_) do { int lv_ = lane; asm volatile("" : "+v"(lv_)); _Pragma("unroll") for (int i_ = 0; i_ < 5; ++i_) { const int id0_ = i_ * 512 + F.wave * 64; if (id0_ < 2304) { const int id_ = id0_ + lv_, rho_ = id_ / 9, q_ = id_ - rho_ * 9; \
            const int k_ = (j_) * 256 + 4 * (rho_ & 63) + (rho_ >> 6); const float* src_ = (q_ == 0) ? (F.w_rg + (size_t)k_ * 4) : (F.w_re + (size_t)k_ * 32 + (q_ - 1) * 4); \
            __builtin_amdgcn_global_load_lds((const unsigned*)src_, (LAS unsigned*)(WB + (buf_) * 9216 + id0_ * 4), 16, 0, 0); } } } while (0)
    for (int rb = F.bid; rb < M / 32; rb += F.G) {
        const int b = (rb * 32) / SEQ;
        __syncthreads();
        for (int k = tid; k < DM; k += NTHREADS) { CA[k] = F.g_norm2[k] * (1.0f + MOD[b * 12288 + 4 * DM + k]); CB[k] = MOD[b * 12288 + 3 * DM + k]; }
        RT_STAGE(0, 0);
        __syncthreads();
        const int mb = rb * 32 + F.wave * 4;
        float rs[4];
#pragma unroll
        for (int r = 0; r < 4; ++r) { __builtin_amdgcn_sched_barrier(0); f32x4 v[8]; rs[r] = row_rstd(X1 + (size_t)(mb + r) * DM, lane, v);
#pragma unroll
            for (int j = 0; j < 8; ++j) { const int k = 4 * (lane + 64 * j); const f32x4 a = *(const LAS f32x4*)(CA + k), bb = *(const LAS f32x4*)(CB + k);
                const f32x4 h = v[j] * rs[r] * a + bb; u32x2 o; o.x = pk2(h.x, h.y); o.y = pk2(h.z, h.w); *(u32x2*)(XN + (size_t)(mb + r) * DM + k) = o; } }
        LAS float* red = WB + F.wave * 2304;
#pragma unroll 1
        for (int half = 0; half < 2; ++half) {
            const int m0 = mb + 2 * half;
            const float rs0 = half ? rs[2] : rs[0], rs1 = half ? rs[3] : rs[1];
            float acc[2][36];
#pragma unroll
            for (int r = 0; r < 2; ++r)
#pragma unroll
                for (int j = 0; j < 36; ++j) acc[r][j] = 0.f;
            if (half) { __syncthreads(); RT_STAGE(0, 0); }
            f32x4 xc[2];
            xc[0] = *(const f32x4*)(X1 + (size_t)m0 * DM + 4 * lane); xc[1] = *(const f32x4*)(X1 + (size_t)(m0 + 1) * DM + 4 * lane);
#pragma unroll 1
            for (int j = 0; j < 8; ++j) {
                __syncthreads();
                if (j < 7) RT_STAGE(j + 1, (j + 1) & 1);
                const f32x4 ca = *(const LAS f32x4*)(CA + 256 * j + 4 * lane), cb = *(const LAS f32x4*)(CB + 256 * j + 4 * lane);
                const f32x4 h0 = xc[0] * rs0 * ca + cb, h1 = xc[1] * rs1 * ca + cb;
                if (j < 7) { xc[0] = *(const f32x4*)(X1 + (size_t)m0 * DM + 256 * (j + 1) + 4 * lane); xc[1] = *(const f32x4*)(X1 + (size_t)(m0 + 1) * DM + 256 * (j + 1) + 4 * lane); }
                const LAS float* wb = WB + (j & 1) * 9216;
#pragma unroll
                for (int e = 0; e < 4; ++e)
#pragma unroll
                    for (int q = 0; q < 9; ++q) { const f32x4 wv = *(const LAS f32x4*)(wb + (e * 64 + lane) * 36 + q * 4);
#pragma unroll
                        for (int c = 0; c < 4; ++c) { acc[0][q * 4 + c] += h0[e] * wv[c]; acc[1][q * 4 + c] += h1[e] * wv[c]; } }
            }
            __syncthreads();
#pragma unroll
            for (int r = 0; r < 2; ++r) {
#pragma unroll
                for (int q = 0; q < 9; ++q) *(LAS f32x4*)(red + lane * 36 + q * 4) = (f32x4){acc[r][q * 4], acc[r][q * 4 + 1], acc[r][q * 4 + 2], acc[r][q * 4 + 3]};
                LDS_WAIT(); asm volatile("" ::: "memory");
                if (lane < 36) { float sm = 0.f;
#pragma unroll 16
                    for (int l = 0; l < 64; ++l) sm += red[l * 36 + lane];
                    LOGI[(F.wave * 2 + r) * 36 + lane] = sm + (lane < 4 ? F.b_rg[lane] : F.b_re[lane - 4]); }
                LDS_WAIT(); asm volatile("" ::: "memory");
            }
            if (lane < 2) {
                const LAS float* lg = LOGI + (F.wave * 2 + lane) * 36;
                int grp = 0; float gm = lg[0];
#pragma unroll
                for (int g = 1; g < 4; ++g) if (lg[g] > gm) { gm = lg[g]; grp = g; }
                float gs = 0.f;
#pragma unroll
                for (int g = 0; g < 4; ++g) gs += expf(lg[g] - gm);
                const float pgrp = 1.0f / gs;
                float el[8];
#pragma unroll
                for (int e = 0; e < 8; ++e) { el[e] = lg[4 + e]; if (grp == 1) el[e] = lg[12 + e]; if (grp == 2) el[e] = lg[20 + e]; if (grp == 3) el[e] = lg[28 + e]; }
                int e0 = 0; float v0 = el[0];
#pragma unroll
                for (int e = 1; e < 8; ++e) if (el[e] > v0) { v0 = el[e]; e0 = e; }
                int e1 = -1; float v1 = -INFINITY;
#pragma unroll
                for (int e = 0; e < 8; ++e) if (e != e0 && el[e] > v1) { v1 = el[e]; e1 = e; }
                const float p1 = expf(v1 - v0), w0 = pgrp / (1.0f + p1), w1 = pgrp * p1 / (1.0f + p1);
                const int m = m0 + lane;
                const int ea = grp * 8 + e0, eb = grp * 8 + e1;
                const unsigned sa = __hip_atomic_fetch_add(F.ctl + CW_CNT + 16 * ea, 1u, RLX_AGENT);
                const unsigned sb = __hip_atomic_fetch_add(F.ctl + CW_CNT + 16 * eb, 1u, RLX_AGENT);
                LIST[ea * M + sa] = 2 * m; LISTW[ea * M + sa] = w0;
                LIST[eb * M + sb] = 2 * m + 1; LISTW[eb * M + sb] = w1;
            }
            LDS_WAIT(); asm volatile("" ::: "memory");
        }
    }
#undef RT_STAGE
}

__device__ __forceinline__ void p8_expert_weights(Frame& F) {
    const int lane = F.lane;
    {
        __syncthreads();
        LAS float* scr = (LAS float*)(F.lds + F.wave * 16384);
        const int gw = F.bid * NWAVES + F.wave, NGW = F.G * NWAVES;
#define P8_DESC(it, d) do { const int e_ = (it) / 1536; const int r_ = (it) % 1536; \
            if (r_ < 512) { d.W = F.w_eg + (size_t)e_ * DM * EFF; d.K = DM; d.N = EFF; d.WT = WSP(bf16_t, WS_WGU_T) + (size_t)e_ * 1024 * DM; d.kind = 2; d.item = r_; } \
            else if (r_ < 1024) { d.W = F.w_eu + (size_t)e_ * DM * EFF; d.K = DM; d.N = EFF; d.WT = WSP(bf16_t, WS_WGU_T) + (size_t)e_ * 1024 * DM; d.kind = 3; d.item = r_ - 512; } \
            else { d.W = F.w_ed + (size_t)e_ * EFF * DM; d.K = EFF; d.N = DM; d.WT = WSP(bf16_t, WS_WD_T) + (size_t)e_ * DM * EFF; d.kind = 0; d.item = r_ - 1024; } } while (0)
        TD_STREAM(gw, NGW, NEXP * 1536, P8_DESC, lane, scr);
#undef P8_DESC
    }
}

constexpr int MOE_TAB_OFF = LDSCTL_OFF + 2048;
struct ProbMoe : ProbBase {
    unsigned char* ws; const LAS int* tab; int nct; unsigned* done;
    __device__ __forceinline__ bool decode(int L, U& u) const {
        const int l = (int)(threadIdx.x & 31); const bool in = (L >= tab[65 + l]) && (L < tab[66 + l]);
        const unsigned long long bal = __ballot(in);
        if (bal == 0ull) return false;
        const int e = __builtin_ctzll(bal); const int rem = L - tab[65 + e];
        u.aux = e; u.pm = rem / nct; u.pn = rem - u.pm * nct; return true;
    }
    __device__ __forceinline__ int rowbase(int e) const { return tab[32 + e]; }
    __device__ __forceinline__ int count(int e) const { return tab[e]; }
};
__device__ __forceinline__ void moe_table(LAS unsigned char* lds, const unsigned* cnt, int nct) {
    LAS int* tab = (LAS int*)(lds + MOE_TAB_OFF);
    __syncthreads();
    if (threadIdx.x < NEXP) tab[threadIdx.x] = (int)__hip_atomic_load(cnt + 16 * threadIdx.x, __ATOMIC_RELAXED, __HIP_MEMORY_SCOPE_AGENT);
    __syncthreads();
    if (threadIdx.x == 0) { int rb = 0, st = 0; for (int e = 0; e < NEXP; ++e) { tab[32 + e] = rb; tab[65 + e] = st; const int nrt = (tab[e] + 255) >> 8; rb += nrt * 256; st += nrt * nct; } tab[64] = rb; tab[97] = st; }
    __syncthreads();
}
struct ProbMoe1 : ProbMoe {
    static constexpr bool PERM = true;
    __device__ __forceinline__ bool next(int i, U& u) const { return decode(i * G + c, u); }
    __device__ __forceinline__ void bases(const U& u, const char*& a, const char*& b) const { a = (const char*)(ws + WS_XN); b = (const char*)(ws + WS_WGU_T) + ((size_t)u.aux * 1024 + u.pn * 256) * K * 2; }
    __device__ __forceinline__ void lane_offs(const U& u, const int (&stR)[2], const int (&stC)[2], unsigned (&va)[2][2]) const {
        const int* LIST = (const int*)(ws + WS_LIST); const int n = count(u.aux);
#pragma unroll
        for (int h = 0; h < 2; ++h)
#pragma unroll
            for (int i = 0; i < 2; ++i) { const int sl = u.pm * 256 + h * 128 + stR[i]; const int tok = LIST[u.aux * M + (sl < n ? sl : 0)] >> 1; va[h][i] = (unsigned)(tok * K + stC[i]) * 2u; }
    }
    __device__ __forceinline__ void epi(f32x4 (&acc)[2][2][4][2], const U& u, int wr, int wc, int fr, int fq) const {
        const float* LISTW = (const float*)(ws + WS_LISTW); bf16_t* ACT = (bf16_t*)(ws + WS_ACT);
        const int n = count(u.aux), rb = rowbase(u.aux);
        const int f0 = u.pn * 128 + wc * 16 + 4 * fq;
        float wts[8];
#pragma unroll
        for (int ai = 0; ai < 2; ++ai)
#pragma unroll
            for (int m = 0; m < 4; ++m) { const int sl = u.pm * 256 + ai * 128 + wr * 64 + m * 16 + fr; wts[ai * 4 + m] = LISTW[u.aux * M + (sl < n ? sl : 0)]; }
        __builtin_amdgcn_sched_barrier(0);
#pragma unroll
        for (int ai = 0; ai < 2; ++ai)
#pragma unroll
            for (int m = 0; m < 4; ++m) { const int sl = u.pm * 256 + ai * 128 + wr * 64 + m * 16 + fr;
                if (sl < n) { const float wt = wts[ai * 4 + m];
#pragma unroll
                    for (int bj = 0; bj < 2; ++bj) { const f32x4 g = acc[ai][bj][m][0], uu = acc[ai][bj][m][1]; float v[4];
#pragma unroll
                        for (int e = 0; e < 4; ++e) v[e] = siluf_(g[e]) * uu[e] * wt;
                        const unsigned long long w = (unsigned long long)pk2(v[0], v[1]) | ((unsigned long long)pk2(v[2], v[3]) << 32);
                        __hip_atomic_store((unsigned long long*)(ACT + (size_t)(rb + sl) * EFF + f0 + bj * 64), w, RLX_AGENT); } } }
        asm volatile("s_waitcnt vmcnt(0)" ::: "memory");
        if ((threadIdx.x & 63) == 0) __hip_atomic_fetch_add(done + 16 * ((rb >> 8) + u.pm), 1u, RLX_AGENT);
    }
};
struct ProbMoe2 : ProbMoe {
    static constexpr bool PERM = true;
    __device__ __forceinline__ void ready(const U& u, bool me) const {
        if (me) { unsigned* p = done + 16 * ((rowbase(u.aux) >> 8) + u.pm); unsigned sp = 0;
            while (__hip_atomic_load(p, RLX_AGENT) < 32u) { __builtin_amdgcn_s_sleep(2); if (++sp > (1u << 20)) break; }
            __builtin_amdgcn_fence(__ATOMIC_ACQUIRE, "agent"); asm volatile("s_waitcnt vmcnt(0)" ::: "memory"); }
    }
    __device__ __forceinline__ bool next(int i, U& u) const {
        const int u1 = tab[97] >> 1;
        const int base = u1 / G, rem = u1 - base * G, tot = tab[97];
        int n_early = 2 * base * G; if (n_early > tot) n_early = tot;
        int L;
        if (c >= rem) { const int W = G - rem, first = c - rem; const int ce = (n_early > first) ? (n_early - first + W - 1) / W : 0;
            L = (i < ce) ? (i * W + first) : (n_early + (i - ce) * G + c); }
        else L = n_early + i * G + c;
        return decode(L, u);
    }
    __device__ __forceinline__ void bases(const U& u, const char*& a, const char*& b) const { a = (const char*)(ws + WS_ACT) + (size_t)(rowbase(u.aux) + u.pm * 256) * K * 2; b = (const char*)(ws + WS_WD_T) + ((size_t)u.aux * DM + u.pn * 256) * K * 2; }
    __device__ __forceinline__ void lane_offs(const U&, const int (&stR)[2], const int (&stC)[2], unsigned (&va)[2][2]) const { lane_offs_plain(stR, stC, va); }
    __device__ __forceinline__ void epi(f32x4 (&acc)[2][2][4][2], const U& u, int wr, int wc, int fr, int fq) const {
        const int* LIST = (const int*)(ws + WS_LIST); bf16_t* YS = (bf16_t*)(ws + WS_YS);
        const int n = count(u.aux);
        const int colw = u.pn * 256 + wc * 32 + 8 * fq;
        int slots[8];
#pragma unroll
        for (int ai = 0; ai < 2; ++ai)
#pragma unroll
            for (int m = 0; m < 4; ++m) { const int sl = u.pm * 256 + ai * 128 + wr * 64 + m * 16 + fr; slots[ai * 4 + m] = LIST[u.aux * M + (sl < n ? sl : 0)]; }
        __builtin_amdgcn_sched_barrier(0);
#pragma unroll
        for (int ai = 0; ai < 2; ++ai)
#pragma unroll
            for (int m = 0; m < 4; ++m) { const int sl = u.pm * 256 + ai * 128 + wr * 64 + m * 16 + fr;
                if (sl < n) { const int slot = slots[ai * 4 + m];
#pragma unroll
                    for (int bj = 0; bj < 2; ++bj) { const f32x4 v0 = acc[ai][bj][m][0], v1 = acc[ai][bj][m][1];
                        u32x4 w; w.x = pk2(v0[0], v0[1]); w.y = pk2(v0[2], v0[3]); w.z = pk2(v1[0], v1[1]); w.w = pk2(v1[2], v1[3]);
                        *(u32x4*)(YS + (size_t)slot * DM + colw + bj * 128) = w; } } }
    }
};

__device__ __forceinline__ void p11_final(Frame& F, float* dst) {
    const float* MOD = WSP(float, WS_MOD); const bf16_t* YS = WSP(bf16_t, WS_YS);
    const int gw = F.bid * NWAVES + F.wave, NGW = F.G * NWAVES, lane = F.lane;
    for (int m = gw; m < M; m += NGW) {
        const int b = m >> 12; const float* row = F.out + (size_t)m * DM; float* orow = dst + (size_t)m * DM; f32x4 v[8]; float s = 0.f;
#pragma unroll
        for (int j = 0; j < 8; ++j) { const int k = 4 * (lane + 64 * j); const f32x4 xv = __builtin_nontemporal_load((const f32x4*)(row + k)), gt = *(const f32x4*)(MOD + b * 12288 + 5 * DM + k);
            const u32x2 y0 = __builtin_nontemporal_load((const u32x2*)(YS + (size_t)(2 * m) * DM + k)), y1 = __builtin_nontemporal_load((const u32x2*)(YS + (size_t)(2 * m + 1) * DM + k));
            f32x4 y; y.x = bf2f(y0.x & 0xffffu) + bf2f(y1.x & 0xffffu); y.y = bf2f(y0.x >> 16) + bf2f(y1.x >> 16); y.z = bf2f(y0.y & 0xffffu) + bf2f(y1.y & 0xffffu); y.w = bf2f(y0.y >> 16) + bf2f(y1.y >> 16);
            v[j] = xv + gt * y; s += (v[j].x * v[j].x + v[j].y * v[j].y) + (v[j].z * v[j].z + v[j].w * v[j].w); }
        f32x4 gf[8];
#pragma unroll
        for (int j = 0; j < 8; ++j) gf[j] = *(const f32x4*)(F.g_final + 4 * (lane + 64 * j));
        const float rs = 1.0f / sqrtf(wave_sum(s) * (1.0f / DM) + EPS);
#pragma unroll
        for (int j = 0; j < 8; ++j) { const int k = 4 * (lane + 64 * j); __builtin_nontemporal_store(v[j] * rs * gf[j], (f32x4*)(orow + k)); }
    }
}

constexpr int NPHASE = 12;
struct Args { const void* in[21]; float* out; unsigned char* ws; int ph_lo, ph_hi; };
__global__ void __launch_bounds__(NTHREADS, 2) hybrid_block_fwd(Args args) {
    extern __shared__ __attribute__((aligned(16))) unsigned char lds_raw[];
    Frame F;
    F.lds = (LAS unsigned char*)lds_raw;
    F.tid = threadIdx.x; F.lane = F.tid & 63; F.wave = __builtin_amdgcn_readfirstlane(F.tid >> 6); F.G = gridDim.x; F.bid = blockIdx.x;
    F.ws = args.ws; F.ctl = (unsigned*)(args.ws + WS_CTL); F.out = args.out;
    F.x = (const float*)args.in[0]; F.c = (const float*)args.in[1]; F.positions = (const int*)args.in[2]; F.w_ada = (const float*)args.in[3]; F.b_ada = (const float*)args.in[4];
    F.g_norm1 = (const float*)args.in[5]; F.w_in = (const float*)args.in[6]; F.g_head = (const float*)args.in[7]; F.hglb = (const float*)args.in[8]; F.w_attn_up = (const float*)args.in[9];
    F.w_hgrn_up = (const float*)args.in[10]; F.w_out = (const float*)args.in[11]; F.g_norm2 = (const float*)args.in[12]; F.w_rg = (const float*)args.in[13]; F.b_rg = (const float*)args.in[14];
    F.w_re = (const float*)args.in[15]; F.b_re = (const float*)args.in[16]; F.w_eg = (const float*)args.in[17]; F.w_eu = (const float*)args.in[18]; F.w_ed = (const float*)args.in[19]; F.g_final = (const float*)args.in[20];
    volatile LAS unsigned* MISC = (volatile LAS unsigned*)(F.lds + MISC_OFF);
    for (int u = F.tid; u < (LDS_EXTRA - LDSCTL_OFF) / 4; u += NTHREADS) ((LAS unsigned*)(F.lds + LDSCTL_OFF))[u] = 0u;
    __syncthreads();
    const int lo = args.ph_lo, hi = args.ph_hi;
    XcdBarrier bar; bar.bar = F.ctl + CW_BAR; bar.x = 0; bar.st = nullptr;
    if (hi - lo > 1) bar = xcd_barrier_post(F.ctl + CW_BAR, MISC + 8);
#ifndef PHMASK
#define PHMASK 0xfff
#endif
#define IN(k) (((PHMASK >> (k)) & 1) && lo <= (k) && (k) < hi)
#define SEAM(k) do { if (IN(k) && IN((k) + 1)) xcd_barrier(bar); } while (0)
#ifndef REPMASK
#define REPMASK 0
#endif
#define RUN2(k, BODY) do { if (IN(k)) { BODY } if (((REPMASK >> (k)) & 1) && IN(k)) { xcd_barrier(bar); BODY } } while (0)
    RUN2(0, p0_prologue(F);); SEAM(0);
    RUN2(1, p1_norm1(F);); SEAM(1);
#define BODY2 { ProbWin P; P.K = DM; P.G = F.G; P.c = F.bid; P.A = (const char*)(F.ws + WS_XN); P.B = (const char*)(F.ws + WS_WIN_T); P.ws = F.ws; P.hglb = F.hglb; pg8::gemm_phase(F.lds, P); }
    RUN2(2, BODY2); SEAM(2);
    RUN2(3, p3_indexer(F); p3_hgrn_upd(F);); if ((REPMASK >> 20) & 1) { xcd_barrier(bar); p3_indexer(F); } if ((REPMASK >> 21) & 1) { xcd_barrier(bar); p3_hgrn_upd(F); } SEAM(3);
    RUN2(4, p4_select(F); p4_hgrn_scan(F);); if ((REPMASK >> 15) & 1) { xcd_barrier(bar); p4_select(F); } if ((REPMASK >> 16) & 1) { xcd_barrier(bar); p4_hgrn_scan(F); } SEAM(4);
    RUN2(5, p5_attention(F); p5_hgrn_out(F);); if ((REPMASK >> 13) & 1) { xcd_barrier(bar); p5_attention(F); } if ((REPMASK >> 14) & 1) { xcd_barrier(bar); p5_hgrn_out(F); } SEAM(5);
#define BODY6 { ProbMerge P; P.K = 1024; P.G = F.G; P.c = F.bid; P.ws = F.ws; pg8::gemm_phase(F.lds, P); }
    RUN2(6, BODY6); SEAM(6);
#define BODY7 { ProbOut P; P.K = DM; P.G = F.G; P.c = F.bid; P.ws = F.ws; P.x = F.x; P.out = F.out; pg8::gemm_phase(F.lds, P); }
    RUN2(7, BODY7); SEAM(7);
    if (IN(8)) { p8_norm2_route(F); if ((REPMASK >> 17) & 1) { xcd_barrier(bar); if (F.bid == 0 && F.tid < 32) __hip_atomic_store(F.ctl + CW_CNT + 16 * F.tid, 0u, RLX_AGENT); xcd_barrier(bar); p8_norm2_route(F); } p8_expert_weights(F); if ((REPMASK >> 12) & 1) { xcd_barrier(bar); p8_expert_weights(F); } } SEAM(8);
#define BODY9 { moe_table(F.lds, F.ctl + CW_CNT, 4); ProbMoe1 P; P.K = DM; P.G = F.G; P.c = F.bid; P.ws = F.ws; P.tab = (const LAS int*)(F.lds + MOE_TAB_OFF); P.nct = 4; P.done = F.ctl + CW_DONE; pg8::gemm_phase(F.lds, P); }
    if (IN(9)) BODY9;
#if MK_MULTI
    SEAM(9);
#endif
#define BODY10 { moe_table(F.lds, F.ctl + CW_CNT, 8); ProbMoe2 P; P.K = EFF; P.G = F.G; P.c = F.bid; P.ws = F.ws; P.tab = (const LAS int*)(F.lds + MOE_TAB_OFF); P.nct = 8; P.done = F.ctl + CW_DONE; pg8::gemm_phase(F.lds, P); }
    if (IN(10)) BODY10; SEAM(10);
    if (IN(11)) { if ((REPMASK >> 18) & 1) { p11_final(F, WSP(float, WS_UPDT)); xcd_barrier(bar); } p11_final(F, F.out); }
    if ((REPMASK >> 19) & 1) { xcd_barrier(bar); BODY2 }
#undef IN
#undef SEAM
}

extern "C" void kernel_launch(void* const* d_in, const int* in_sizes, int n_in, void* d_out, int out_size, void* d_ws, size_t ws_size, hipStream_t stream) {
    static int grid = 0;
    if (grid == 0) {
        if (n_in != 21 || in_sizes[0] != M * DM || out_size != M * DM || ws_size < WS_END) { fprintf(stderr, "kernel_launch: unexpected shapes/workspace (n_in %d, in0 %d, out %d, ws %zu)\n", n_in, n_in > 0 ? in_sizes[0] : -1, out_size, ws_size); grid = -1; return; }
        int dev = 0, cus = 0, per_cu = 0;
        if (hipGetDevice(&dev) != hipSuccess || hipDeviceGetAttribute(&cus, hipDeviceAttributeMultiprocessorCount, dev) != hipSuccess) { grid = -1; return; }
        if (hipFuncSetAttribute((const void*)hybrid_block_fwd, hipFuncAttributeMaxDynamicSharedMemorySize, LDS_BYTES) != hipSuccess) { fprintf(stderr, "kernel_launch: hipFuncSetAttribute failed\n"); grid = -1; return; }
        if (hipOccupancyMaxActiveBlocksPerMultiprocessor(&per_cu, (const void*)hybrid_block_fwd, NTHREADS, LDS_BYTES) != hipSuccess || per_cu < 1) fprintf(stderr, "kernel_launch: occupancy query reports %d\n", per_cu);
        (void)hipGetLastError();
        grid = cus;
    }
    if (grid < 0) return;
    (void)hipMemsetAsync((char*)d_ws + WS_CTL, 0, CTL_ZERO_BYTES, stream);
    Args a{};
    for (int i = 0; i < 21; ++i) a.in[i] = d_in[i];
    a.out = (float*)d_out; a.ws = (unsigned char*)d_ws;
#if MK_MULTI
    for (int p = 0; p < NPHASE; ++p) { a.ph_lo = p; a.ph_hi = p + 1; hipLaunchKernelGGL(hybrid_block_fwd, dim3(grid), dim3(NTHREADS), LDS_BYTES, stream, a); }
#else
    a.ph_lo = 0; a.ph_hi = NPHASE; hipLaunchKernelGGL(hybrid_block_fwd, dim3(grid), dim3(NTHREADS), LDS_BYTES, stream, a);
#endif
}
```

```cpp
#include <hip/hip_runtime.h>
#include <cstdio>
#include <cstdint>

#define REPMASK 0x0
#ifndef MK_MULTI
#define MK_MULTI 0
#endif

#define GAS __attribute__((address_space(1)))
#define LAS __attribute__((address_space(3)))
typedef unsigned short bf16_t;
typedef short bf16x8 __attribute__((ext_vector_type(8)));
typedef short s16x4 __attribute__((ext_vector_type(4)));
typedef short v4i16_t __attribute__((ext_vector_type(4)));
typedef float f32x4 __attribute__((ext_vector_type(4)));
typedef float f32x2 __attribute__((ext_vector_type(2)));
typedef float f32x16 __attribute__((ext_vector_type(16)));
typedef unsigned u32x4 __attribute__((ext_vector_type(4)));
typedef unsigned u32x2 __attribute__((ext_vector_type(2)));

constexpr int DM = 2048, NBATCH = 2, SEQ = 4096, M = NBATCH * SEQ;
constexpr int NLOG = 10312, NPHYS = 10240;
constexpr int NEXP = 32, EFF = 512;
constexpr float EPS = 1e-6f;
constexpr float ATT_SCALE_L2E = 0.08838834764831845f * 1.4426950408889634f;
constexpr float IDX_SCALE = 0.04419417382415922f;
constexpr int TOPK = 256;

constexpr size_t MiB = 1u << 20;
constexpr size_t WS_CTL = 0, CTL_ZERO_BYTES = 1 * MiB;
constexpr size_t WS_WIN_T = 1 * MiB, WS_WAU_T = 42 * MiB, WS_WHU_T = 46 * MiB, WS_WOUT_T = 50 * MiB;
constexpr size_t WS_XN = 58 * MiB, WS_MODP = 90 * MiB, WS_MOD = 92 * MiB, WS_TABA = 93 * MiB, WS_TABI = 97 * MiB, WS_MASK = 99 * MiB;
constexpr size_t WS_W40T = 104 * MiB;
constexpr size_t WS_DECAY = 103 * MiB, WS_LIST = 105 * MiB, WS_LISTW = 106 * MiB, WS_SPREVT = 107 * MiB, WS_YATT = 139 * MiB, WS_YHG = 155 * MiB, WS_UPDT = 171 * MiB;
constexpr size_t WS_AQ = 235 * MiB, WS_AK = 251 * MiB, WS_AVT = 255 * MiB, WS_IQ = 259 * MiB, WS_IK = 267 * MiB, WS_IW = 268 * MiB, WS_HQ = 269 * MiB, WS_LOGF = 285 * MiB,
                 WS_KF = 317 * MiB, WS_HI = 333 * MiB, WS_HOG = 349 * MiB, WS_GA = 365 * MiB, WS_GH = 397 * MiB;
constexpr size_t WS_WGU_T = 235 * MiB;
constexpr size_t WS_WD_T = 581 * MiB;
constexpr size_t WS_SCORES = 429 * MiB;
constexpr size_t WS_MERGED = 429 * MiB, WS_YS = 461 * MiB, WS_ACT = 557 * MiB;
constexpr size_t WS_END = 645 * MiB;
constexpr int CW_BAR = 4096, CW_CNT = 16384, CW_DONE = 32768;

constexpr int RING_BYTES = 139264, LDSCTL_OFF = RING_BYTES, MISC_OFF = LDSCTL_OFF + 320, LDS_EXTRA = 147456, LDS_BYTES = 163840;
constexpr int NWAVES = 8, NTHREADS = 512;

#define RLX_AGENT __ATOMIC_RELAXED, __HIP_MEMORY_SCOPE_AGENT
#define LDS_WAIT() asm volatile("s_waitcnt lgkmcnt(0)" ::: "memory")
#define VM_WAIT() asm volatile("s_waitcnt vmcnt(0)" ::: "memory")
__device__ __forceinline__ float bf2f(unsigned b) { return __uint_as_float(b << 16); }
__device__ __forceinline__ unsigned pk2(float lo, float hi) { unsigned r; asm("v_cvt_pk_bf16_f32 %0, %1, %2" : "=v"(r) : "v"(lo), "v"(hi)); return r; }
__device__ __forceinline__ float fexp(float x) { return __builtin_amdgcn_exp2f(x * 1.4426950408889634f); }
__device__ __forceinline__ float frcp(float x) { return __builtin_amdgcn_rcpf(x); }
__device__ __forceinline__ float sigmoidf_(float x) { return frcp(1.0f + fexp(-x)); }
__device__ __forceinline__ float siluf_(float x) { return x * sigmoidf_(x); }
__device__ __forceinline__ float wave_sum(float v) {
#pragma unroll
    for (int o = 1; o < 64; o <<= 1) v += __shfl_xor(v, o);
    return v;
}
__device__ __forceinline__ int wave_sum_i_dpp(int v) {
    v += __builtin_amdgcn_update_dpp(0, v, 0xB1, 0xF, 0xF, false);
    v += __builtin_amdgcn_update_dpp(0, v, 0x4E, 0xF, 0xF, false);
    v += __builtin_amdgcn_update_dpp(0, v, 0x124, 0xF, 0xF, false);
    v += __builtin_amdgcn_update_dpp(0, v, 0x128, 0xF, 0xF, false);
    return __builtin_amdgcn_readlane(v, 0) + __builtin_amdgcn_readlane(v, 16) + __builtin_amdgcn_readlane(v, 32) + __builtin_amdgcn_readlane(v, 48);
}
__device__ __forceinline__ int wave_sum_i(int v) {
#pragma unroll
    for (int o = 1; o < 64; o <<= 1) v += __shfl_xor(v, o);
    return v;
}

#define XB_TMO      128
#define XB_XCNT(j)  (256  + 64 * (j))
#define XB_XSUB(j)  (1280 + 64 * (j))
#define XB_XGEN(j)  (2304 + 64 * (j))
#define XB_TOP      3328
#define XB_TOPGEN   3392
#define XCD_BAR_WORDS 3456
#define XB_SPIN_CAP (1u << 18)
__device__ __forceinline__ unsigned xb_ld(unsigned* p)              { return __hip_atomic_load(p, __ATOMIC_RELAXED, __HIP_MEMORY_SCOPE_AGENT); }
__device__ __forceinline__ unsigned xb_add(unsigned* p, unsigned v) { return __hip_atomic_fetch_add(p, v, __ATOMIC_RELAXED, __HIP_MEMORY_SCOPE_AGENT); }
__device__ __forceinline__ unsigned xb_xcc_id() { return (unsigned)__builtin_amdgcn_s_getreg((3 << 11) | 20) & 0xFu; }
#define XB_SPIN(cond, bar) do { unsigned _sp = 0; while (cond) { __builtin_amdgcn_s_sleep(1); \
    if ((++_sp & 255u) == 0u) { if (xb_ld(&(bar)[XB_TMO])) break; if (_sp > XB_SPIN_CAP) { atomicAdd(&(bar)[XB_TMO], 1u); break; } } } } while (0)
struct XcdBarrier { unsigned* bar; unsigned x; volatile LAS unsigned* st; };
__device__ __forceinline__ XcdBarrier xcd_barrier_post(unsigned* bar, volatile LAS unsigned* st) {
    XcdBarrier b; b.bar = bar; b.x = xb_xcc_id(); b.st = st;
    if (threadIdx.x == 0) (void)xb_add(&bar[XB_XCNT(b.x)], 1u);
    return b;
}
__device__ __forceinline__ void xcd_barrier_complete(unsigned* bar, unsigned x, unsigned& nloc, unsigned& nx) {
    const unsigned G = gridDim.x * gridDim.y * gridDim.z;
    unsigned sum, cnt, mine, sp = 0u;
    for (;;) {
        sum = 0u; cnt = 0u; mine = 0u;
#pragma unroll
        for (unsigned j = 0; j < 16; ++j) { const unsigned c = xb_ld(&bar[XB_XCNT(j)]); sum += c; cnt += (c > 0u) ? 1u : 0u; mine = (j == x) ? c : mine; }
        if (sum == G) break;
        __builtin_amdgcn_s_sleep(1);
        if ((++sp & 255u) == 0u) { if (xb_ld(&bar[XB_TMO])) break; if (sp > XB_SPIN_CAP) { atomicAdd(&bar[XB_TMO], 1u); break; } }
    }
    nloc = mine > 0u ? mine : 1u; nx = cnt > 0u ? cnt : 1u;
}
__device__ __forceinline__ void xcd_barrier(const XcdBarrier& b) {
    asm volatile("s_waitcnt vmcnt(0)" ::: "memory");
    __syncthreads();
    if (threadIdx.x == 0) {
        unsigned* bar = b.bar;
        __builtin_amdgcn_s_waitcnt(0);
        unsigned nloc = b.st[0], nx = b.st[1];
        if (nloc == 0u) { xcd_barrier_complete(bar, b.x, nloc, nx); b.st[0] = nloc; b.st[1] = nx; }
        const unsigned old = xb_add(&bar[XB_XSUB(b.x)], 1u);
        const unsigned gen = old / nloc;
        if (old + 1u == (gen + 1u) * nloc) {
            __builtin_amdgcn_fence(__ATOMIC_RELEASE, "agent");
            asm volatile("s_waitcnt vmcnt(0)" ::: "memory");
            const unsigned og = xb_add(&bar[XB_TOP], 1u);
            const unsigned tg = og / nx;
            if (og + 1u == (tg + 1u) * nx) xb_add(&bar[XB_TOPGEN], 1u);
            else XB_SPIN(xb_ld(&bar[XB_TOPGEN]) == tg, bar);
            __builtin_amdgcn_fence(__ATOMIC_ACQUIRE, "agent");
            xb_add(&bar[XB_XGEN(b.x)], 1u);
            asm volatile("s_waitcnt vmcnt(0)" ::: "memory");
        } else {
            XB_SPIN(xb_ld(&bar[XB_XGEN(b.x)]) == gen, bar);
            __builtin_amdgcn_fence(__ATOMIC_ACQUIRE, "agent");
            asm volatile("s_waitcnt vmcnt(0)" ::: "memory");
        }
    }
    __syncthreads();
}

namespace pg8 {
constexpr int BM = 256, BK = 64, HALF = 128, HTB = HALF * BK * 2, NXCD = 8, WGM = 8;
__host__ __device__ __forceinline__ int lds_byte(int r, int c) { const int st = (r >> 4) * 2 + (c >> 5), rr = r & 15, cc = c & 31, ob = rr * 64 + cc * 2; return st * 1024 + (ob ^ (((ob >> 9) & 1) << 5)); }
__host__ __device__ __forceinline__ void stage_rc(int b, int& R, int& C) { const int st = b / 1024, sb = b % 1024, swz = sb ^ (((sb >> 9) & 1) << 5); R = (st >> 1) * 16 + swz / 64; C = (st & 1) * 32 + (swz % 64) / 2; }
__host__ __device__ __forceinline__ int perm32(int rho) { const int n = rho >> 4, i = rho & 15; return 8 * (i >> 2) + 4 * n + (i & 3); }

__device__ __forceinline__ bool static_tile(int L, int nM, int nN, int& pm, int& pn) {
    const int nwg = nM * nN; if (L >= nwg) return false;
    int wgid = L; { const int q = nwg / NXCD, r = nwg % NXCD, xcd = wgid % NXCD, off = wgid / NXCD; wgid = (xcd < r ? xcd * (q + 1) : r * (q + 1) + (xcd - r) * q) + off; }
    const int nig = WGM * nN, gid = wgid / nig, fm = gid * WGM, gsz = (nM - fm) < WGM ? (nM - fm) : WGM;
    pm = fm + ((wgid % nig) % gsz); pn = (wgid % nig) / gsz; return true;
}

template <class P>
__device__ __forceinline__ void gemm_phase(LAS unsigned char* lds, P& prob) {
    typedef typename P::U Unit;
    const int tid = threadIdx.x, wid = __builtin_amdgcn_readfirstlane(tid >> 6), lane = tid & 63, wr = wid >> 2, wc = wid & 3, fr = lane & 15, fq = lane >> 4;
    const int K = prob.K, nt = K / BK;
    unsigned voffB[2]; int stR[2], stC[2];
#pragma unroll
    for (int i = 0; i < 2; ++i) { int R, C; stage_rc(tid * 16 + i * 8192, R, C); stR[i] = R; stC[i] = C; const int Rb = P::PERM ? ((R & ~31) + perm32(R & 31)) : R; voffB[i] = (unsigned)(Rb * K + C) * 2u; }
    const size_t kstep = (size_t)(BK * 2);
    const size_t hstep = (size_t)HALF * K * 2;
    const unsigned ldsw = (unsigned)wid * 1024u;
    const int aoff = lds_byte(wr * 64 + fr, fq * 8), boff = lds_byte(wc * 32 + fr, fq * 8);
#define PG8_SA(b, h) (((b) * 2 + (h)) * HTB)
#define PG8_SB(b, h) ((4 + (b) * 2 + (h)) * HTB)
#define PG8_STAGE2(bufoff, gbase, o0, o1) do { \
        __builtin_amdgcn_global_load_lds((const unsigned*)((const char*)(gbase) + (o0)), (LAS unsigned*)(lds + (bufoff) + ldsw), 16, 0, 0); \
        __builtin_amdgcn_global_load_lds((const unsigned*)((const char*)(gbase) + (o1)), (LAS unsigned*)(lds + (bufoff) + ldsw + 8192), 16, 0, 0); } while (0)
#define PG8_STAGE_B(bufoff, gbase, h) PG8_STAGE2(bufoff, (gbase) + (h) * hstep, voffB[0], voffB[1])
#define PG8_LDA(dst, b, h) do { _Pragma("unroll") for (int m = 0; m < 4; ++m) _Pragma("unroll") for (int k = 0; k < 2; ++k) dst[m][k] = *(const LAS bf16x8*)(lds + PG8_SA(b, h) + aoff + m * 2048 + k * 1024); } while (0)
#define PG8_LDB(dst, b, h) do { _Pragma("unroll") for (int n = 0; n < 2; ++n) _Pragma("unroll") for (int k = 0; k < 2; ++k) dst[n][k] = *(const LAS bf16x8*)(lds + PG8_SB(b, h) + boff + n * 2048 + k * 1024); } while (0)
#define PG8_MMA(ai, bj, At, Bt) do { __builtin_amdgcn_s_setprio(1); _Pragma("unroll") for (int m = 0; m < 4; ++m) _Pragma("unroll") for (int n = 0; n < 2; ++n) _Pragma("unroll") for (int k = 0; k < 2; ++k) \
        acc[ai][bj][m][n] = __builtin_amdgcn_mfma_f32_16x16x32_bf16(Bt[n][k], At[m][k], acc[ai][bj][m][n], 0, 0, 0); __builtin_amdgcn_s_setprio(0); } while (0)
#define PG8_WAIT_V(n) asm volatile("s_waitcnt vmcnt(" #n ")" ::: "memory")
#define PG8_WAIT_L(n) asm volatile("s_waitcnt lgkmcnt(" #n ")" ::: "memory")
#define PG8_BAR __builtin_amdgcn_s_barrier()
#define PG8_SCHED __builtin_amdgcn_sched_barrier(0)
    Unit cur, nxt; int ui = 0;
    if (!prob.next(0, cur)) return;
    f32x4 acc[2][2][4][2];
#pragma unroll
    for (int a = 0; a < 2; ++a)
#pragma unroll
        for (int b = 0; b < 2; ++b)
#pragma unroll
            for (int m = 0; m < 4; ++m)
#pragma unroll
                for (int n = 0; n < 2; ++n) acc[a][b][m][n] = (f32x4){0.f, 0.f, 0.f, 0.f};
    bf16x8 At[4][2], B0[2][2], B1[2][2];
    const char* cA; const char* cB; unsigned vc[2][2], vn[2][2];
    prob.ready(cur, true);
    prob.bases(cur, cA, cB); prob.lane_offs(cur, stR, stC, vc);
    PG8_STAGE_B(PG8_SB(0, 0), cB, 0); PG8_STAGE_B(PG8_SB(0, 1), cB, 1); PG8_STAGE2(PG8_SA(0, 0), cA, vc[0][0], vc[0][1]); PG8_STAGE2(PG8_SA(0, 1), cA, vc[1][0], vc[1][1]);
    if (wr == 1) PG8_BAR;
    PG8_WAIT_V(2); PG8_BAR;
    PG8_STAGE_B(PG8_SB(1, 0), cB + kstep, 0); PG8_STAGE2(PG8_SA(1, 0), cA + kstep, vc[0][0], vc[0][1]); PG8_STAGE_B(PG8_SB(1, 1), cB + kstep, 1);
    PG8_WAIT_V(6); PG8_BAR;
    for (;;) {
        const bool has_next = prob.next(ui + 1, nxt);
        const char* nA = cA; const char* nB = cB;
#pragma unroll
        for (int h = 0; h < 2; ++h) { vn[h][0] = vc[h][0]; vn[h][1] = vc[h][1]; }
        if (has_next) { prob.bases(nxt, nA, nB); prob.lane_offs(nxt, stR, stC, vn); }
        for (int t = 0; t < nt; t += 2) {
            const bool last = (t == nt - 2);
            if (last && has_next) prob.ready(nxt, wid == 0);
            const char* a1 = cA + (size_t)(t + 1) * kstep;
            const char* a2 = last ? nA : cA + (size_t)(t + 2) * kstep; const char* b2 = last ? nB : cB + (size_t)(t + 2) * kstep;
            const char* a3 = a2 + kstep; const char* b3 = b2 + kstep;
            const unsigned v00 = last ? vn[0][0] : vc[0][0], v01 = last ? vn[0][1] : vc[0][1], v10 = last ? vn[1][0] : vc[1][0], v11 = last ? vn[1][1] : vc[1][1];
            PG8_LDB(B0, 0, 0); PG8_LDB(B1, 0, 1); PG8_SCHED; PG8_LDA(At, 0, 0); PG8_STAGE2(PG8_SA(1, 1), a1, vc[1][0], vc[1][1]);
            PG8_WAIT_V(8); PG8_WAIT_L(0); PG8_BAR; PG8_MMA(0, 0, At, B0); PG8_MMA(0, 1, At, B1); PG8_BAR; PG8_SCHED;
            PG8_LDA(At, 0, 1); PG8_STAGE_B(PG8_SB(0, 0), b2, 0); PG8_STAGE_B(PG8_SB(0, 1), b2, 1); PG8_STAGE2(PG8_SA(0, 0), a2, v00, v01);
            PG8_WAIT_V(8); PG8_WAIT_L(0); PG8_BAR; PG8_MMA(1, 0, At, B0); PG8_MMA(1, 1, At, B1); PG8_BAR; PG8_SCHED;
            PG8_LDB(B0, 1, 0); PG8_LDB(B1, 1, 1); PG8_SCHED; PG8_LDA(At, 1, 0); PG8_STAGE2(PG8_SA(0, 1), a2, v10, v11);
            PG8_WAIT_V(8); PG8_WAIT_L(0); PG8_BAR; PG8_MMA(0, 0, At, B0); PG8_MMA(0, 1, At, B1); PG8_BAR; PG8_SCHED;
            PG8_LDA(At, 1, 1); PG8_STAGE_B(PG8_SB(1, 0), b3, 0); PG8_STAGE_B(PG8_SB(1, 1), b3, 1); PG8_STAGE2(PG8_SA(1, 0), a3, v00, v01);
            PG8_WAIT_V(8); PG8_WAIT_L(0); PG8_BAR; PG8_MMA(1, 0, At, B0); PG8_MMA(1, 1, At, B1); PG8_BAR; PG8_SCHED;
        }
        if (wr == 0) PG8_BAR;
        prob.epi(acc, cur, wr, wc, fr, fq);
        if (!has_next) break;
        if (!prob.keep(cur)) {
#pragma unroll
            for (int a = 0; a < 2; ++a)
#pragma unroll
                for (int b = 0; b < 2; ++b)
#pragma unroll
                    for (int m = 0; m < 4; ++m)
#pragma unroll
                        for (int n = 0; n < 2; ++n) acc[a][b][m][n] = (f32x4){0.f, 0.f, 0.f, 0.f};
        }
        cur = nxt; cA = nA; cB = nB; ++ui;
#pragma unroll
        for (int h = 0; h < 2; ++h) { vc[h][0] = vn[h][0]; vc[h][1] = vn[h][1]; }
        if (wr == 1) PG8_BAR;
    }
    PG8_WAIT_V(0);
    PG8_BAR;
#undef PG8_SA
#undef PG8_SB
#undef PG8_STAGE2
#undef PG8_STAGE_B
#undef PG8_LDA
#undef PG8_LDB
#undef PG8_MMA
#undef PG8_WAIT_V
#undef PG8_WAIT_L
#undef PG8_BAR
#undef PG8_SCHED
}
}

struct Frame {
    LAS unsigned char* lds;
    unsigned* ctl;
    unsigned char* ws;
    int tid, lane, wave, G, bid;
    const float *x, *c, *w_ada, *b_ada, *g_norm1, *w_in, *g_head, *hglb, *w_attn_up, *w_hgrn_up, *w_out, *g_norm2, *w_rg, *b_rg, *w_re, *b_re, *w_eg, *w_eu, *w_ed, *g_final;
    const int* positions;
    float* out;
};
#define WSP(T, off) ((T*)(F.ws + (off)))

__device__ __forceinline__ int win_phys(int n) {
    if (n < 1280) { const int head = n >> 7, j = n & 127; return head * 128 + (j < 64 ? 2 * j : 2 * (j - 64) + 1); }
    if (n < 1536) return n;
    if (n < 2048) { const int q = n - 1536, head = q >> 6, j = q & 63; return 1536 + head * 64 + (j < 32 ? 2 * j : 2 * (j - 32) + 1); }
    if (n < 2120) return -1;
    return n - 2120 + 2048;
}
struct RmWin { __device__ __forceinline__ int operator()(int n) const { return win_phys(n); } };
struct RmId  { __device__ __forceinline__ int operator()(int n) const { return n; } };
struct RmGate { int up; __device__ __forceinline__ int operator()(int f) const { return 8 * (f >> 2) + 4 * up + (f & 3); } };
template <class RM>
__device__ __forceinline__ void transpose_item(const float* W, int K, int N, bf16_t* WT, LAS float* scr, int item, int lane, RM rm) {
    const int nblk = (N + 31) / 32, kb = item / nblk, nb = item % nblk, k0 = 64 * kb, n0 = 32 * nb;
    const int nn = n0 + (lane & 31);
    float tv[32];
#pragma unroll
    for (int i = 0; i < 32; ++i) { const int kk = 2 * i + (lane >> 5); tv[i] = (nn < N) ? W[(size_t)(k0 + kk) * N + nn] : 0.f; }
#pragma unroll
    for (int i = 0; i < 32; ++i) { const int kk = 2 * i + (lane >> 5); scr[kk * 33 + (lane & 31)] = tv[i]; }
    LDS_WAIT(); asm volatile("" ::: "memory");
    const int c = lane & 7;
#pragma unroll
    for (int j = 0; j < 4; ++j) { const int n = (lane >> 3) + 8 * j; const LAS float* s = scr + (8 * c) * 33 + n;
        u32x4 o; o.x = pk2(s[0 * 33], s[1 * 33]); o.y = pk2(s[2 * 33], s[3 * 33]); o.z = pk2(s[4 * 33], s[5 * 33]); o.w = pk2(s[6 * 33], s[7 * 33]);
        if (n0 + n < N) { const int rr = rm(n0 + n); if (rr >= 0) *(u32x4*)(WT + (size_t)rr * K + k0 + 8 * c) = o; } }
    LDS_WAIT(); asm volatile("" ::: "memory");
}

struct TDesc { const float* W; bf16_t* WT; int K, N, kind, item; };
__device__ __forceinline__ int td_row(int kind, int n) { return kind == 0 ? n : kind == 1 ? win_phys(n) : (8 * (n >> 2) + 4 * (kind - 2) + (n & 3)); }
__device__ __forceinline__ void td_load(const TDesc& d, int lane, float (&tv)[32]) {
    const int nblk = (d.N + 31) / 32, kb = d.item / nblk, nb = d.item % nblk, k0 = 64 * kb, n0 = 32 * nb;
    int nn = n0 + (lane & 31); nn = nn < d.N ? nn : d.N - 1;
    const float* p = d.W + (size_t)(k0 + (lane >> 5)) * d.N + nn;
#pragma unroll
    for (int i = 0; i < 32; ++i) tv[i] = __builtin_nontemporal_load(p + (size_t)(2 * i) * d.N);
}
__device__ __forceinline__ void td_lds(const float (&tv)[32], int lane, LAS float* scr) {
#pragma unroll
    for (int i = 0; i < 32; ++i) { const int kk = 2 * i + (lane >> 5); scr[kk * 33 + (lane & 31)] = tv[i]; }
}
__device__ __forceinline__ void td_store(const TDesc& d, int lane, LAS float* scr) {
    const int nblk = (d.N + 31) / 32, kb = d.item / nblk, nb = d.item % nblk, k0 = 64 * kb, n0 = 32 * nb;
    const int c = lane & 7;
#pragma unroll
    for (int j = 0; j < 4; ++j) { const int n = (lane >> 3) + 8 * j; const LAS float* sp = scr + (8 * c) * 33 + n;
        u32x4 o; o.x = pk2(sp[0 * 33], sp[1 * 33]); o.y = pk2(sp[2 * 33], sp[3 * 33]); o.z = pk2(sp[4 * 33], sp[5 * 33]); o.w = pk2(sp[6 * 33], sp[7 * 33]);
        if (n0 + n < d.N) { const int rr = td_row(d.kind, n0 + n); if (rr >= 0) *(u32x4*)(d.WT + (size_t)rr * d.K + k0 + 8 * c) = o; } }
}
#define TD_STREAM(it0_, stride_, total_, DESC, lane_, scr_) do { float tv_[32]; TDesc dc_, dn_; int it_ = (it0_); \
    if (it_ < (total_)) { DESC(it_, dc_); td_load(dc_, (lane_), tv_); } \
    for (; it_ < (total_); it_ += (stride_)) { td_lds(tv_, (lane_), (scr_)); __builtin_amdgcn_sched_barrier(0); \
        const bool hn_ = it_ + (stride_) < (total_); if (hn_) { DESC(it_ + (stride_), dn_); td_load(dn_, (lane_), tv_); } \
        LDS_WAIT(); asm volatile("" ::: "memory"); td_store(dc_, (lane_), (scr_)); LDS_WAIT(); asm volatile("" ::: "memory"); if (hn_) dc_ = dn_; } } while (0)

__device__ __forceinline__ void p0_prologue(Frame& F) {
    const int gw = F.bid * NWAVES + F.wave, NGW = F.G * NWAVES;
    {
        LAS float* red = (LAS float*)F.lds;
        float* MODP = WSP(float, WS_MODP);
        for (int task = F.bid; task < 48 * 16; task += F.G) {
            const int cg = task % 48, ks = task / 48;
            f32x4 a0 = {0.f, 0.f, 0.f, 0.f}, a1 = {0.f, 0.f, 0.f, 0.f};
            const int kb = ks * 128 + F.wave * 16;
#pragma unroll 16
            for (int i = 0; i < 16; ++i) { const int k = kb + i; const f32x4 wv = __builtin_nontemporal_load((const f32x4*)(F.w_ada + (size_t)k * 12288 + cg * 256 + 4 * F.lane));
                const float s0 = siluf_(F.c[k]), s1 = siluf_(F.c[DM + k]); a0 += wv * s0; a1 += wv * s1; }
            *(LAS f32x4*)(red + (F.wave * 2 + 0) * 256 + 4 * F.lane) = a0; *(LAS f32x4*)(red + (F.wave * 2 + 1) * 256 + 4 * F.lane) = a1;
            __syncthreads();
            { const int b = F.tid >> 8, col = F.tid & 255; float s = 0.f;
#pragma unroll
              for (int w = 0; w < 8; ++w) s += red[(w * 2 + b) * 256 + col];
              MODP[((size_t)ks * 2 + b) * 12288 + cg * 256 + col] = s; }
            __syncthreads();
        }
    }
    {
        LAS float* scr = (LAS float*)(F.lds + F.wave * 16384);
        constexpr int I_IN = 32 * 323;
#define P0_DESC(it, d) do { d.W = F.w_in; d.K = DM; d.N = NLOG; d.WT = WSP(bf16_t, WS_WIN_T); d.kind = 1; d.item = (it); } while (0)
        TD_STREAM(gw, NGW, I_IN, P0_DESC, F.lane, scr);
#undef P0_DESC
        { bf16_t* W40 = WSP(bf16_t, WS_W40T); const int gt = F.bid * NTHREADS + F.tid, NGT = F.G * NTHREADS;
          for (int e = gt; e < 96 * 256; e += NGT) { const int n = e >> 8, k0 = (e & 255) * 8; u32x4 o = {0u, 0u, 0u, 0u};
              if (n < 72) { const int col = (n < 64) ? (2048 + (n >> 1) + 32 * (n & 1)) : (2112 + (n - 64)); const float* p = F.w_in + (size_t)k0 * NLOG + col;
                  o.x = pk2(p[0], p[NLOG]); o.y = pk2(p[2 * (size_t)NLOG], p[3 * (size_t)NLOG]); o.z = pk2(p[4 * (size_t)NLOG], p[5 * (size_t)NLOG]); o.w = pk2(p[6 * (size_t)NLOG], p[7 * (size_t)NLOG]); }
              *(u32x4*)(W40 + (size_t)n * DM + k0) = o; } }
    }
    {
        f32x2* TA = WSP(f32x2, WS_TABA); f32x2* TI = WSP(f32x2, WS_TABI);
        const int gt = F.bid * NTHREADS + F.tid, NGT = F.G * NTHREADS;
        for (int e = gt; e < M * 96; e += NGT) {
            const int m = e / 96, r = e % 96; const float pos = (float)F.positions[m];
            float inv; if (r < 64) inv = powf(10000.0f, -(float)(2 * r) / 128.0f); else inv = powf(10000.0f, -(float)(2 * (r - 64)) / 64.0f);
            const float ang = pos * inv; float sn, cs; sincosf(ang, &sn, &cs);
            if (r < 64) TA[(size_t)m * 64 + r] = (f32x2){cs, sn}; else TI[(size_t)m * 32 + (r - 64)] = (f32x2){cs, sn};
        }
    }
}

__device__ __forceinline__ void p3_late_weights(Frame& F) {
    LAS float* scr = (LAS float*)(F.lds + F.wave * 16384);
    const int gw = F.bid * NWAVES + F.wave, NGW = F.G * NWAVES;
    constexpr int I_AU = 16 * 64, I_HU = 16 * 64, I_OUT = 32 * 64;
#define P3_DESC(it, d) do { int r_ = (it); \
        if (r_ < I_AU) { d.W = F.w_attn_up; d.K = 1024; d.N = DM; d.WT = WSP(bf16_t, WS_WAU_T); d.kind = 0; d.item = r_; } \
        else if ((r_ -= I_AU) < I_HU) { d.W = F.w_hgrn_up; d.K = 1024; d.N = DM; d.WT = WSP(bf16_t, WS_WHU_T); d.kind = 0; d.item = r_; } \
        else { r_ -= I_HU; d.W = F.w_out; d.K = DM; d.N = DM; d.WT = WSP(bf16_t, WS_WOUT_T); d.kind = 0; d.item = r_; } } while (0)
    TD_STREAM(NGW - 1 - gw, NGW, I_AU + I_HU + I_OUT, P3_DESC, F.lane, scr);
#undef P3_DESC
}

__device__ __forceinline__ float row_rstd_nt(const float* xrow, int lane, f32x4 (&v)[8]) {
    float s = 0.f;
#pragma unroll
    for (int j = 0; j < 8; ++j) { v[j] = __builtin_nontemporal_load((const f32x4*)xrow + lane + 64 * j); s += (v[j].x * v[j].x + v[j].y * v[j].y) + (v[j].z * v[j].z + v[j].w * v[j].w); }
    return 1.0f / sqrtf(wave_sum(s) * (1.0f / DM) + EPS);
}
__device__ __forceinline__ float row_rstd(const float* xrow, int lane, f32x4 (&v)[8]) {
    float s = 0.f;
#pragma unroll
    for (int j = 0; j < 8; ++j) { v[j] = ((const f32x4*)xrow)[lane + 64 * j]; s += (v[j].x * v[j].x + v[j].y * v[j].y) + (v[j].z * v[j].z + v[j].w * v[j].w); }
    return 1.0f / sqrtf(wave_sum(s) * (1.0f / DM) + EPS);
}

__device__ __forceinline__ f32x16 mfma32(bf16x8 a, bf16x8 b, f32x16 c) { return __builtin_amdgcn_mfma_f32_32x32x16_bf16(a, b, c, 0, 0, 0); }
__device__ __forceinline__ int crow(int r, int hi) { return (r & 3) + 8 * (r >> 2) + 4 * hi; }
__device__ __forceinline__ void p1_norm1(Frame& F) {
    LAS float* CA = (LAS float*)(F.lds + LDS_EXTRA); LAS float* CB = CA + DM;
    LAS unsigned char* HB = F.lds;
    const float* MODP = WSP(float, WS_MODP); float* MOD = WSP(float, WS_MOD);
    const int lane = F.lane, r32 = lane & 31, hi = lane >> 5;
    for (int idx = F.bid * NTHREADS + F.tid; idx < 2 * 12288; idx += F.G * NTHREADS) { const int b = idx / 12288, j = idx % 12288; float s = F.b_ada[j]; float pv[16];
#pragma unroll
        for (int ks = 0; ks < 16; ++ks) pv[ks] = MODP[((size_t)ks * 2 + b) * 12288 + j];
        __builtin_amdgcn_sched_barrier(0);
#pragma unroll
        for (int ks = 0; ks < 16; ++ks) s += pv[ks];
        MOD[idx] = s; }
    for (int rb = F.bid; rb < M / 32; rb += F.G) {
        const int b = (rb * 32) / SEQ;
        __syncthreads();
#pragma unroll
        for (int kk = 0; kk < DM / NTHREADS; ++kk) { __builtin_amdgcn_sched_barrier(0); const int k = F.tid + kk * NTHREADS; float sh = F.b_ada[k], sc = F.b_ada[DM + k]; const float gn = F.g_norm1[k]; float p0[16], p1[16];
#pragma unroll
            for (int ks = 0; ks < 16; ++ks) { p0[ks] = MODP[((size_t)ks * 2 + b) * 12288 + k]; p1[ks] = MODP[((size_t)ks * 2 + b) * 12288 + DM + k]; }
            __builtin_amdgcn_sched_barrier(0);
#pragma unroll
            for (int ks = 0; ks < 16; ++ks) { sh += p0[ks]; sc += p1[ks]; }
            CA[k] = gn * (1.0f + sc); CB[k] = sh; }
        __syncthreads();
        bf16_t* XN = WSP(bf16_t, WS_XN);
#pragma unroll 1
        for (int r = 0; r < 4; ++r) { const int rl = F.wave * 4 + r, m = rb * 32 + rl; f32x4 v[8]; const float rs = row_rstd_nt(F.x + (size_t)m * DM, lane, v);
#pragma unroll
            for (int j = 0; j < 8; ++j) { const int k = 4 * (lane + 64 * j); const f32x4 a = *(const LAS f32x4*)(CA + k), bb = *(const LAS f32x4*)(CB + k);
                const f32x4 h = v[j] * rs * a + bb; u32x2 o; o.x = pk2(h.x, h.y); o.y = pk2(h.z, h.w); *(u32x2*)(XN + (size_t)m * DM + k) = o; *(LAS u32x2*)(HB + rl * 4112 + k * 2) = o; } }
        __syncthreads();
        f32x16 acc[3]; acc[0] = f32x16{}; acc[1] = f32x16{}; acc[2] = f32x16{};
        { const bf16_t* W40 = WSP(bf16_t, WS_W40T) + (size_t)r32 * DM + 256 * F.wave + 8 * hi;
#pragma unroll
          for (int kb = 0; kb < 8; ++kb) { bf16x8 bq[2][3];
#pragma unroll
              for (int ks = 0; ks < 2; ++ks)
#pragma unroll
                  for (int nt = 0; nt < 3; ++nt) bq[ks][nt] = *(const bf16x8*)(W40 + (size_t)nt * 32 * DM + 16 * (2 * kb + ks));
              __builtin_amdgcn_sched_barrier(0);
#pragma unroll
              for (int ks = 0; ks < 2; ++ks) { const bf16x8 a = *(const LAS bf16x8*)(HB + r32 * 4112 + (256 * F.wave + 16 * (2 * kb + ks) + 8 * hi) * 2);
#pragma unroll
                  for (int nt = 0; nt < 3; ++nt) acc[nt] = mfma32(a, bq[ks][nt], acc[nt]); }
              __builtin_amdgcn_sched_barrier(0); } }
        __syncthreads();
        LAS float* PS = (LAS float*)HB;
#pragma unroll
        for (int nt = 0; nt < 3; ++nt)
#pragma unroll
            for (int r = 0; r < 16; ++r) PS[(F.wave * 96 + nt * 32 + r32) * 33 + crow(r, hi)] = acc[nt][r];
        __syncthreads();
        { bf16_t* IK = WSP(bf16_t, WS_IK); float* IW = WSP(float, WS_IW); const f32x2* TI = WSP(f32x2, WS_TABI);
          int tv = F.tid; asm volatile("" : "+v"(tv));
#pragma unroll
          for (int j = 0; j < 2; ++j) { const int idx = tv + 512 * j, row = idx >> 5, i = idx & 31; float x1 = 0.f, x2 = 0.f;
#pragma unroll
              for (int w = 0; w < 8; ++w) { x1 += PS[(w * 96 + 2 * i) * 33 + row]; x2 += PS[(w * 96 + 2 * i + 1) * 33 + row]; }
              const int m = rb * 32 + row; const f32x2 cs = TI[(size_t)m * 32 + i];
              *(unsigned*)(IK + (size_t)m * 64 + 2 * i) = pk2(x1 * cs.x - x2 * cs.y, x2 * cs.x + x1 * cs.y); }
          if (F.tid < 256) { const int row = F.tid >> 3, hh = F.tid & 7; float v = 0.f;
#pragma unroll
              for (int w = 0; w < 8; ++w) v += PS[(w * 96 + 64 + hh) * 33 + row];
              IW[(size_t)(rb * 32 + row) * 8 + hh] = v * IDX_SCALE; } }
    }
}

struct UnitT { int pm, pn, aux; };
struct ProbBase {
    typedef UnitT U;
    int K, G, c;
    __device__ __forceinline__ void lane_offs_plain(const int (&stR)[2], const int (&stC)[2], unsigned (&va)[2][2]) const {
#pragma unroll
        for (int h = 0; h < 2; ++h)
#pragma unroll
            for (int i = 0; i < 2; ++i) va[h][i] = (unsigned)((h * 128 + stR[i]) * K + stC[i]) * 2u;
    }
    __device__ __forceinline__ bool keep(const U&) const { return false; }
    __device__ __forceinline__ void ready(const U&, bool) const {}
};

struct ProbWin : ProbBase {
    static constexpr bool PERM = true;
    const char* A; const char* B; unsigned char* ws; const float* hglb;
    __device__ __forceinline__ bool next(int i, U& u) const { u.aux = 0; return pg8::static_tile(i * G + c, M / 256, NPHYS / 256, u.pm, u.pn); }
    __device__ __forceinline__ void bases(const U& u, const char*& a, const char*& b) const { a = A + (size_t)u.pm * 256 * K * 2; b = B + (size_t)u.pn * 256 * K * 2; }
    __device__ __forceinline__ void lane_offs(const U&, const int (&stR)[2], const int (&stC)[2], unsigned (&va)[2][2]) const { lane_offs_plain(stR, stC, va); }
    __device__ __forceinline__ void epi(f32x4 (&acc)[2][2][4][2], const U& u, int wr, int wc, int fr, int fq) const {
        const int pn = u.pn, row0 = u.pm * 256 + wr * 64 + fr, colw = wc * 32 + 8 * fq;
        if (pn <= 4 || pn == 6 || pn == 7 || pn == 40) {
            const bool d128 = (pn <= 4);
            const float* tab = d128 ? (const float*)(ws + WS_TABA) : (const float*)(ws + WS_TABI);
            const int tp = d128 ? 128 : 64;
            const int i0 = d128 ? (colw >> 1) : (((wc & 1) * 32 + 8 * fq) >> 1);
            bf16_t* O; int pitch, cb; float sc = 1.f;
            if (pn < 4) { O = (bf16_t*)(ws + WS_AQ); pitch = 1024; cb = pn * 256; sc = ATT_SCALE_L2E; }
            else if (pn == 4) { O = (bf16_t*)(ws + WS_AK); pitch = 256; cb = 0; }
            else if (pn < 8) { O = (bf16_t*)(ws + WS_IQ); pitch = 512; cb = (pn - 6) * 256; }
            else { O = (bf16_t*)(ws + WS_IK); pitch = 64; cb = 0; }
            f32x4 tt0[8], tt1[8];
#pragma unroll
            for (int ai = 0; ai < 2; ++ai)
#pragma unroll
                for (int m = 0; m < 4; ++m) { const int row = row0 + ai * 128 + m * 16; tt0[ai * 4 + m] = *(const f32x4*)(tab + (size_t)row * tp + 2 * i0); tt1[ai * 4 + m] = *(const f32x4*)(tab + (size_t)row * tp + 2 * i0 + 4); }
            __builtin_amdgcn_sched_barrier(0);
#pragma unroll
            for (int ai = 0; ai < 2; ++ai)
#pragma unroll
                for (int m = 0; m < 4; ++m) { const int row = row0 + ai * 128 + m * 16;
                    const f32x4 t0 = tt0[ai * 4 + m], t1 = tt1[ai * 4 + m];
#pragma unroll
                    for (int bj = 0; bj < 2; ++bj) {
                        if (pn == 40 && (bj == 1 || wc >= 2)) {
                            if (bj == 0 && wc == 2 && fq == 0) { float* IW = (float*)(ws + WS_IW);
                                *(f32x4*)(IW + (size_t)row * 8) = acc[ai][0][m][0] * IDX_SCALE; *(f32x4*)(IW + (size_t)row * 8 + 4) = acc[ai][0][m][1] * IDX_SCALE; }
                            continue; }
                        const f32x4 v0 = acc[ai][bj][m][0], v1 = acc[ai][bj][m][1];
                        const float o0 = v0[0] * t0[0] - v0[1] * t0[1], o1 = v0[1] * t0[0] + v0[0] * t0[1], o2 = v0[2] * t0[2] - v0[3] * t0[3], o3 = v0[3] * t0[2] + v0[2] * t0[3];
                        const float o4 = v1[0] * t1[0] - v1[1] * t1[1], o5 = v1[1] * t1[0] + v1[0] * t1[1], o6 = v1[2] * t1[2] - v1[3] * t1[3], o7 = v1[3] * t1[2] + v1[2] * t1[3];
                        u32x4 w; w.x = pk2(o0 * sc, o1 * sc); w.y = pk2(o2 * sc, o3 * sc); w.z = pk2(o4 * sc, o5 * sc); w.w = pk2(o6 * sc, o7 * sc);
                        *(u32x4*)(O + (size_t)row * pitch + cb + bj * 128 + colw) = w; } }
        } else if (pn == 5) {
            bf16_t* O = (bf16_t*)(ws + WS_AVT);
#pragma unroll
            for (int ai = 0; ai < 2; ++ai)
#pragma unroll
                for (int m = 0; m < 4; ++m) { const int row = row0 + ai * 128 + m * 16, b = row >> 12, s = row & 4095;
#pragma unroll
                    for (int bj = 0; bj < 2; ++bj)
#pragma unroll
                        for (int n = 0; n < 2; ++n)
#pragma unroll
                            for (int e = 0; e < 4; ++e) { const int d = colw + 4 * n + e; O[((size_t)((b * 2 + bj) * 128 + d)) * SEQ + s] = (bf16_t)(pk2(acc[ai][bj][m][n][e], 0.f) & 0xffffu); } }
        } else if (pn >= 12 && pn < 16) {
            float* LF = (float*)(ws + WS_LOGF); bf16_t* KFo = (bf16_t*)(ws + WS_KF);
            const int cb = (pn - 12) * 256;
            f32x4 lb[2][2];
#pragma unroll
            for (int bj = 0; bj < 2; ++bj)
#pragma unroll
                for (int n = 0; n < 2; ++n) { const int cc = cb + bj * 128 + colw + 4 * n; const f32x4 a0 = *(const f32x4*)(hglb + cc), a1 = *(const f32x4*)(hglb + 1024 + cc);
#pragma unroll
                    for (int e = 0; e < 4; ++e) lb[bj][n][e] = frcp(1.0f + fexp(a1[e] - a0[e])); }
#pragma unroll
            for (int ai = 0; ai < 2; ++ai)
#pragma unroll
                for (int m = 0; m < 4; ++m) { const int row = row0 + ai * 128 + m * 16;
#pragma unroll
                    for (int bj = 0; bj < 2; ++bj) { f32x4 lf[2], kf[2];
#pragma unroll
                        for (int n = 0; n < 2; ++n)
#pragma unroll
                            for (int e = 0; e < 4; ++e) { float xx = acc[ai][bj][m][n][e]; xx = fminf(fmaxf(xx, -30.f), 30.f); const float ee = fexp(-xx), sg = frcp(1.0f + ee), sgn = ee * sg; const float l = lb[bj][n][e];
                                const float f = l + (1.0f - l) * sg; lf[n][e] = __logf(f); kf[n][e] = (1.0f - l) * sgn; }
                        const size_t off = (size_t)row * 1024 + cb + bj * 128 + colw;
                        *(f32x4*)(LF + off) = lf[0]; *(f32x4*)(LF + off + 4) = lf[1];
                        u32x4 w; w.x = pk2(kf[0][0], kf[0][1]); w.y = pk2(kf[0][2], kf[0][3]); w.z = pk2(kf[1][0], kf[1][1]); w.w = pk2(kf[1][2], kf[1][3]);
                        *(u32x4*)(KFo + off) = w; } }
        } else {
            bf16_t* O; int pitch, cb, act;
            if (pn < 12) { O = (bf16_t*)(ws + WS_HQ); pitch = 1024; cb = (pn - 8) * 256; act = 1; }
            else if (pn < 20) { O = (bf16_t*)(ws + WS_HI); pitch = 1024; cb = (pn - 16) * 256; act = 0; }
            else if (pn < 24) { O = (bf16_t*)(ws + WS_HOG); pitch = 1024; cb = (pn - 20) * 256; act = 1; }
            else if (pn < 32) { O = (bf16_t*)(ws + WS_GA); pitch = 2048; cb = (pn - 24) * 256; act = 2; }
            else { O = (bf16_t*)(ws + WS_GH); pitch = 2048; cb = (pn - 32) * 256; act = 2; }
#pragma unroll
            for (int ai = 0; ai < 2; ++ai)
#pragma unroll
                for (int m = 0; m < 4; ++m) { const int row = row0 + ai * 128 + m * 16;
#pragma unroll
                    for (int bj = 0; bj < 2; ++bj) { f32x4 v0 = acc[ai][bj][m][0], v1 = acc[ai][bj][m][1];
                        if (act == 1) {
#pragma unroll
                            for (int e = 0; e < 4; ++e) { v0[e] = siluf_(v0[e]); v1[e] = siluf_(v1[e]); } }
                        else if (act == 2) {
#pragma unroll
                            for (int e = 0; e < 4; ++e) { v0[e] = sigmoidf_(v0[e]); v1[e] = sigmoidf_(v1[e]); } }
                        u32x4 w; w.x = pk2(v0[0], v0[1]); w.y = pk2(v0[2], v0[3]); w.z = pk2(v1[0], v1[1]); w.w = pk2(v1[2], v1[3]);
                        *(u32x4*)(O + (size_t)row * pitch + cb + bj * 128 + colw) = w; } }
        }
    }
};

__device__ __forceinline__ void p3_indexer(Frame& F) {
    const bf16_t* IQ = WSP(bf16_t, WS_IQ); const bf16_t* IK = WSP(bf16_t, WS_IK); const float* IW = WSP(float, WS_IW); float* SC = WSP(float, WS_SCORES);
    const int gw = F.bid * NWAVES + F.wave, NGW = F.G * NWAVES, lane = F.lane, q = lane & 15, quad = lane >> 4;
    for (int it = gw; it < 2 * 2176; it += NGW) {
        const int b = it / 2176; int r = it % 2176; int qg = 0; while (r >= 16 * (qg + 1)) { r -= 16 * (qg + 1); ++qg; }
        const int qi = 16 * qg + r / (qg + 1), ch = r % (qg + 1);
        const int kt0 = 16 * ch, kt1 = min(16 * ch + 16, qi + 1);
        const size_t qrow = (size_t)b * SEQ + 16 * qi + q;
        bf16x8 bq[8][2];
#pragma unroll
        for (int h = 0; h < 8; ++h)
#pragma unroll
            for (int ks = 0; ks < 2; ++ks) bq[h][ks] = *(const bf16x8*)(IQ + qrow * 512 + h * 64 + 32 * ks + 8 * quad);
        const f32x4 w0 = *(const f32x4*)(IW + qrow * 8), w1 = *(const f32x4*)(IW + qrow * 8 + 4);
        const float wv[8] = {w0[0], w0[1], w0[2], w0[3], w1[0], w1[1], w1[2], w1[3]};
        f32x4 scs[16];
        bf16x8 na[4][2];
        const bf16_t* kbase = IK + ((size_t)b * SEQ + q) * 64 + 8 * quad;
        const int ntl = kt1 - kt0, rot = (gw * 5 + (gw >> 4)) % ntl;
#define IX_TILE(j_) (kt0 + (((j_) + rot) % ntl))
#pragma unroll
        for (int j = 0; j < 4; ++j) { const int kt = IX_TILE(j); na[j][0] = *(const bf16x8*)(kbase + (size_t)kt * 1024); na[j][1] = *(const bf16x8*)(kbase + (size_t)kt * 1024 + 32); }
#define IX_BODY(j) { \
                const bf16x8 a0 = na[(j) & 3][0], a1 = na[(j) & 3][1]; \
                if ((j) + 4 < 16) { const int ktn = IX_TILE((j) + 4); na[(j) & 3][0] = *(const bf16x8*)(kbase + (size_t)ktn * 1024); na[(j) & 3][1] = *(const bf16x8*)(kbase + (size_t)ktn * 1024 + 32); } \
                f32x4 dh[8]; \
                _Pragma("unroll") for (int h = 0; h < 8; ++h) dh[h] = __builtin_amdgcn_mfma_f32_16x16x32_bf16(a0, bq[h][0], (f32x4){0.f, 0.f, 0.f, 0.f}, 0, 0, 0); \
                _Pragma("unroll") for (int h = 0; h < 8; ++h) dh[h] = __builtin_amdgcn_mfma_f32_16x16x32_bf16(a1, bq[h][1], dh[h], 0, 0, 0); \
                f32x4 sc = {0.f, 0.f, 0.f, 0.f}; \
                _Pragma("unroll") for (int h = 0; h < 8; ++h) _Pragma("unroll") for (int e = 0; e < 4; ++e) { const int bi = (int)__float_as_uint(dh[h][e]); sc[e] += wv[h] * __uint_as_float((unsigned)(bi > 0 ? bi : 0)); } \
                scs[j] = sc; }
        if (ntl == 16) {
#pragma unroll
            for (int j = 0; j < 16; ++j) IX_BODY(j)
        } else {
#pragma unroll
            for (int j = 0; j < 16; ++j) { scs[j] = (f32x4){0.f, 0.f, 0.f, 0.f}; if (j < ntl) IX_BODY(j) }
        }
#undef IX_BODY
#pragma unroll
        for (int j = 0; j < 16; ++j) { if (j < ntl) *(f32x4*)(SC + qrow * SEQ + 16 * IX_TILE(j) + 4 * quad) = scs[j]; }
#undef IX_TILE
    }
}

constexpr int HG_QD = 0, HG_KD = 17408, HG_VT = 34816, HG_KET = 53248, HG_ATT = 71680, HG_TOT = 80896, HG_O = 83968;

__device__ __forceinline__ void hg_cum(Frame& F, float (&cum)[16], float& cum_last) {
    LAS float* tot = (LAS float*)(F.lds + HG_TOT);
    const int seg = F.tid >> 7, k = F.tid & 127;
    float run = 0.f;
#pragma unroll
    for (int i = 0; i < 16; ++i) { run += cum[i]; cum[i] = run; }
    tot[seg * 128 + k] = run;
    __syncthreads();
    float pre = 0.f, all = 0.f;
#pragma unroll
    for (int s = 0; s < 4; ++s) { const float t = tot[s * 128 + k]; all += t; if (s < seg) pre += t; }
#pragma unroll
    for (int i = 0; i < 16; ++i) cum[i] += pre;
    cum_last = all;
}

__device__ __forceinline__ void p3_hgrn_upd(Frame& F) {
    const float* LOGF = WSP(float, WS_LOGF); const bf16_t* KF = WSP(bf16_t, WS_KF); const bf16_t* HI = WSP(bf16_t, WS_HI);
    bf16_t* UPDT = WSP(bf16_t, WS_UPDT); float* DEC = WSP(float, WS_DECAY);
    LAS bf16_t* VT = (LAS bf16_t*)(F.lds + HG_VT); LAS bf16_t* KET = (LAS bf16_t*)(F.lds + HG_KET);
    const int seg = F.tid >> 7, k = F.tid & 127, lane = F.lane, r32 = lane & 31, hi = lane >> 5;
    float lf[16]; bf16_t lk[16], lv[16];
#define HGU_LOAD(tile_) do { const int b_ = (tile_) >> 9, n_ = ((tile_) >> 3) & 63, h_ = (tile_) & 7; const size_t ob_ = ((size_t)b_ * SEQ + 64 * n_ + 16 * seg) * 1024 + h_ * 128 + k; \
        _Pragma("unroll") for (int i = 0; i < 16; ++i) { lf[i] = LOGF[ob_ + i * 1024]; lk[i] = KF[ob_ + i * 1024]; lv[i] = HI[ob_ + i * 1024]; } } while (0)
    if (F.bid < 1024) HGU_LOAD(F.bid);
    for (int tile = F.bid; tile < 1024; tile += F.G) {
        __syncthreads();
        float cum[16], cl;
#pragma unroll
        for (int i = 0; i < 16; ++i) cum[i] = lf[i];
        hg_cum(F, cum, cl);
        { unsigned pk[8], pv[8];
#pragma unroll
          for (int i = 0; i < 16; i += 2) {
              const float k0 = bf2f(lk[i]) * fexp(cl - cum[i]), k1 = bf2f(lk[i + 1]) * fexp(cl - cum[i + 1]); pk[i >> 1] = pk2(k0, k1);
              pv[i >> 1] = (unsigned)lv[i] | ((unsigned)lv[i + 1] << 16); }
          LAS u32x4* dk = (LAS u32x4*)(KET + k * 72 + 16 * seg); dk[0] = (u32x4){pk[0], pk[1], pk[2], pk[3]}; dk[1] = (u32x4){pk[4], pk[5], pk[6], pk[7]};
          LAS u32x4* dv = (LAS u32x4*)(VT + k * 72 + 16 * seg); dv[0] = (u32x4){pv[0], pv[1], pv[2], pv[3]}; dv[1] = (u32x4){pv[4], pv[5], pv[6], pv[7]};
          if (seg == 0) DEC[(size_t)tile * 128 + k] = fexp(cl); }
        __builtin_amdgcn_sched_barrier(0);
        if (tile + F.G < 1024) HGU_LOAD(tile + F.G);
        __syncthreads();
        const int vt = F.wave & 3, kt0 = (F.wave >> 2) * 2;
        f32x16 c0 = {}, c1 = {};
#pragma unroll
        for (int ks = 0; ks < 4; ++ks) { const bf16x8 a = *(const LAS bf16x8*)(VT + (vt * 32 + r32) * 72 + 16 * ks + 8 * hi);
            const bf16x8 b0 = *(const LAS bf16x8*)(KET + (kt0 * 32 + r32) * 72 + 16 * ks + 8 * hi), b1 = *(const LAS bf16x8*)(KET + (kt0 * 32 + 32 + r32) * 72 + 16 * ks + 8 * hi);
            c0 = mfma32(a, b0, c0); c1 = mfma32(a, b1, c1); }
        bf16_t* U = UPDT + (size_t)tile * 16384;
#pragma unroll
        for (int r = 0; r < 16; ++r) { const int v = vt * 32 + crow(r, hi);
            const float n0 = __uint_as_float((unsigned)__builtin_amdgcn_update_dpp(0, (int)__float_as_uint(c0[r]), 0xB1, 0xF, 0xF, false));
            const float n1 = __uint_as_float((unsigned)__builtin_amdgcn_update_dpp(0, (int)__float_as_uint(c1[r]), 0xB1, 0xF, 0xF, false));
            if (!(lane & 1)) { *(unsigned*)(U + v * 128 + kt0 * 32 + r32) = pk2(c0[r], n0); *(unsigned*)(U + v * 128 + kt0 * 32 + 32 + r32) = pk2(c1[r], n1); } }
    }
#undef HGU_LOAD
}

__device__ __forceinline__ void p4_hgrn_scan(Frame& F) {
    const bf16_t* UPDT = WSP(bf16_t, WS_UPDT); const float* DEC = WSP(float, WS_DECAY); bf16_t* SP = WSP(bf16_t, WS_SPREVT);
    const int gt = F.bid * NTHREADS + F.tid, NGT = F.G * NTHREADS;
    for (int e = gt; e < 2 * 8 * 16384 / 2; e += NGT) {
        const int bh = e >> 13, vk = (e & 8191) * 2, b = bh >> 3, h = bh & 7, k = vk & 127;
        float s0 = 0.f, s1 = 0.f;
#pragma unroll 8
        for (int n = 0; n < 64; ++n) { const size_t tile = (size_t)(b * 64 + n) * 8 + h;
            const unsigned uu = __builtin_nontemporal_load((const unsigned*)(UPDT + tile * 16384 + vk)); const f32x2 d = *(const f32x2*)(DEC + tile * 128 + k);
            *(unsigned*)(SP + tile * 16384 + vk) = pk2(s0, s1);
            s0 = d.x * s0 + bf2f(uu & 0xffffu); s1 = d.y * s1 + bf2f(uu >> 16); }
    }
}

__device__ __forceinline__ void p5_hgrn_out(Frame& F) {
    const float* LOGF = WSP(float, WS_LOGF); const bf16_t* KF = WSP(bf16_t, WS_KF); const bf16_t* HI = WSP(bf16_t, WS_HI); const bf16_t* HQ = WSP(bf16_t, WS_HQ);
    const bf16_t* HOG = WSP(bf16_t, WS_HOG); const bf16_t* SP = WSP(bf16_t, WS_SPREVT); bf16_t* YHG = WSP(bf16_t, WS_YHG);
    LAS bf16_t* QD = (LAS bf16_t*)(F.lds + HG_QD); LAS bf16_t* KD = (LAS bf16_t*)(F.lds + HG_KD); LAS bf16_t* VT = (LAS bf16_t*)(F.lds + HG_VT);
    LAS bf16_t* ATT = (LAS bf16_t*)(F.lds + HG_ATT); LAS float* OB = (LAS float*)(F.lds + HG_O);
    const int seg = F.tid >> 7, k = F.tid & 127, lane = F.lane, r32 = lane & 31, hi = lane >> 5;
    float lf[16]; bf16_t lq[16], lk[16], lv[16];
#define HGO_LOAD(tile_) do { const int b_ = (tile_) >> 9, n_ = ((tile_) >> 3) & 63, h_ = (tile_) & 7; const size_t ob_ = ((size_t)b_ * SEQ + 64 * n_ + 16 * seg) * 1024 + h_ * 128 + k; \
        _Pragma("unroll") for (int i = 0; i < 16; ++i) { lf[i] = LOGF[ob_ + i * 1024]; lq[i] = HQ[ob_ + i * 1024]; lk[i] = KF[ob_ + i * 1024]; lv[i] = HI[ob_ + i * 1024]; } } while (0)
    if (F.bid < 1024) HGO_LOAD(F.bid);
    for (int tile = F.bid; tile < 1024; tile += F.G) {
        const int b = tile >> 9, n = (tile >> 3) & 63, h = tile & 7; const size_t m0 = (size_t)b * SEQ + 64 * n;
        __syncthreads();
        float cum[16], cl;
#pragma unroll
        for (int i = 0; i < 16; ++i) cum[i] = lf[i];
        hg_cum(F, cum, cl);
        { unsigned pv[8];
          __builtin_amdgcn_sched_barrier(0);
#pragma unroll
          for (int i = 0; i < 16; ++i) {
              const float qd = bf2f(lq[i]) * fexp(cum[i]), kd = bf2f(lk[i]) * fexp(-cum[i]);
              QD[(16 * seg + i) * 136 + k] = (bf16_t)(pk2(qd, 0.f) & 0xffffu); KD[(16 * seg + i) * 136 + k] = (bf16_t)(pk2(kd, 0.f) & 0xffffu);
              if (i & 1) pv[i >> 1] |= ((unsigned)lv[i] << 16); else pv[i >> 1] = (unsigned)lv[i]; }
          LAS u32x4* dv = (LAS u32x4*)(VT + k * 72 + 16 * seg); dv[0] = (u32x4){pv[0], pv[1], pv[2], pv[3]}; dv[1] = (u32x4){pv[4], pv[5], pv[6], pv[7]}; }
        const int tt = F.wave >> 2, vt = F.wave & 3;
        bf16x8 sb[8];
        { const bf16_t* S = SP + (size_t)tile * 16384 + (size_t)(vt * 32 + r32) * 128;
#pragma unroll
          for (int ks = 0; ks < 8; ++ks) sb[ks] = *(const bf16x8*)(S + 16 * ks + 8 * hi); }
        __builtin_amdgcn_sched_barrier(0);
        if (tile + F.G < 1024) HGO_LOAD(tile + F.G);
        __syncthreads();
        if (F.wave < 4) { const int ta = F.wave >> 1, sa = F.wave & 1; f32x16 c = {};
            if (sa <= ta) {
#pragma unroll
                for (int ks = 0; ks < 8; ++ks) { const bf16x8 a = *(const LAS bf16x8*)(QD + (ta * 32 + r32) * 136 + 16 * ks + 8 * hi), bb = *(const LAS bf16x8*)(KD + (sa * 32 + r32) * 136 + 16 * ks + 8 * hi); c = mfma32(a, bb, c); } }
#pragma unroll
            for (int r = 0; r < 16; ++r) { const int t = ta * 32 + crow(r, hi), s = sa * 32 + r32; const float v = (s <= t) ? c[r] : 0.f; ATT[t * 72 + s] = (bf16_t)(pk2(v, 0.f) & 0xffffu); } }
        f32x16 o = {};
        {
#pragma unroll
          for (int ks = 0; ks < 8; ++ks) { const bf16x8 a = *(const LAS bf16x8*)(QD + (tt * 32 + r32) * 136 + 16 * ks + 8 * hi); o = mfma32(a, sb[ks], o); } }
        __syncthreads();
#pragma unroll
        for (int ks = 0; ks < 4; ++ks) { const bf16x8 a = *(const LAS bf16x8*)(ATT + (tt * 32 + r32) * 72 + 16 * ks + 8 * hi), bb = *(const LAS bf16x8*)(VT + (vt * 32 + r32) * 72 + 16 * ks + 8 * hi); o = mfma32(a, bb, o); }
#pragma unroll
        for (int r = 0; r < 16; ++r) OB[(tt * 32 + crow(r, hi)) * 132 + vt * 32 + r32] = o[r];
        __syncthreads();
        { const int t = F.tid >> 3, part = F.tid & 7; float v[16], ss = 0.f;
#pragma unroll
          for (int i = 0; i < 16; i += 4) { const f32x4 x = *(const LAS f32x4*)(OB + t * 132 + part * 16 + i); v[i] = x[0]; v[i + 1] = x[1]; v[i + 2] = x[2]; v[i + 3] = x[3]; ss += (x[0] * x[0] + x[1] * x[1]) + (x[2] * x[2] + x[3] * x[3]); }
          ss += __shfl_xor(ss, 1); ss += __shfl_xor(ss, 2); ss += __shfl_xor(ss, 4);
          const float rs = 1.0f / sqrtf(ss * (1.0f / 128.0f) + EPS);
          const size_t off = (m0 + t) * 1024 + h * 128 + part * 16; unsigned w[8];
          const u32x4 g0 = *(const u32x4*)(HOG + off), g1 = *(const u32x4*)(HOG + off + 8); const unsigned gg[8] = {g0.x, g0.y, g0.z, g0.w, g1.x, g1.y, g1.z, g1.w};
          const float* ghp = F.g_head + h * 128 + part * 16; const f32x4 gh0 = *(const f32x4*)ghp, gh1 = *(const f32x4*)(ghp + 4), gh2 = *(const f32x4*)(ghp + 8), gh3 = *(const f32x4*)(ghp + 12);
          const float ghv[16] = {gh0[0], gh0[1], gh0[2], gh0[3], gh1[0], gh1[1], gh1[2], gh1[3], gh2[0], gh2[1], gh2[2], gh2[3], gh3[0], gh3[1], gh3[2], gh3[3]};
#pragma unroll
          for (int i = 0; i < 8; ++i) { w[i] = pk2(v[2 * i] * rs * ghv[2 * i] * bf2f(gg[i] & 0xffffu), v[2 * i + 1] * rs * ghv[2 * i + 1] * bf2f(gg[i] >> 16)); }
          *(u32x4*)(YHG + off) = (u32x4){w[0], w[1], w[2], w[3]}; *(u32x4*)(YHG + off + 8) = (u32x4){w[4], w[5], w[6], w[7]}; }
    }
}

__device__ __forceinline__ unsigned f2ord(float f) { const unsigned u = __float_as_uint(f); return (u & 0x80000000u) ? ~u : (u | 0x80000000u); }
__device__ __forceinline__ void p4_down_weights(Frame& F) {
    LAS float* scr = (LAS float*)(F.lds + F.wave * 16384);
    const int gw = F.bid * NWAVES + F.wave, NGW = F.G * NWAVES;
#define P4_DESC(it, d) do { const int e_ = (it) / 512; d.W = F.w_ed + (size_t)e_ * EFF * DM; d.K = EFF; d.N = DM; d.WT = WSP(bf16_t, WS_WD_T) + (size_t)e_ * DM * EFF; d.kind = 0; d.item = (it) % 512; } while (0)
    TD_STREAM(gw, NGW, NEXP * 512, P4_DESC, F.lane, scr);
#undef P4_DESC
}
__device__ __forceinline__ void p4_sel_load(const float* SC, int row, int lane, unsigned (&nu)[64]) {
    const int t = row & (SEQ - 1);
    if (t >= TOPK) { const float* srow = SC + (size_t)row * SEQ; const int ng = (t >> 9) + 1;
#pragma unroll
        for (int g = 0; g < 8; ++g) {
            if (g < ng) {
#pragma unroll
                for (int j = 0; j < 8; ++j) nu[8 * g + j] = __float_as_uint(__builtin_nontemporal_load(srow + 64 * (8 * g + j) + lane));
            }
        }
    }
}
__device__ __forceinline__ void p4_select(Frame& F) {
    const float* SC = WSP(float, WS_SCORES); unsigned long long* MASK = WSP(unsigned long long, WS_MASK);
    const int gw = F.bid * NWAVES + F.wave, NGW = F.G * NWAVES, lane = F.lane;
    constexpr int NPAIR = NBATCH * (SEQ / 2);
#define SEL_ROW(k_) ({ const int idx_ = gw + ((k_) >> 1) * NGW; const int b_ = idx_ / (SEQ / 2), p_ = idx_ % (SEQ / 2); b_ * SEQ + (((k_) & 1) ? (SEQ - 1 - p_) : p_); })
#define SEL_HAVE(k_) (gw + ((k_) >> 1) * NGW < NPAIR)
    unsigned nu[64];
#pragma unroll
    for (int i = 0; i < 64; ++i) nu[i] = 0u;
    int k = 0; bool have = SEL_HAVE(0); int row = have ? SEL_ROW(0) : 0;
    if (have) p4_sel_load(SC, row, lane, nu);
    while (have) {
        const int t = row & (SEQ - 1);
        unsigned long long mine = 0ull;
        unsigned u[64];
        const int ng = (t >> 9) + 1;
        if (t >= TOPK) {
#pragma unroll
            for (int g = 0; g < 8; ++g) {
                if (g < ng) {
#pragma unroll
                    for (int j = 0; j < 8; ++j) { const int i = 8 * g + j; const unsigned bits = nu[i]; u[i] = bits ^ ((unsigned)((int)bits >> 31) | 0x80000000u); }
                    if (g == ng - 1) {
#pragma unroll
                        for (int j = 0; j < 8; ++j) { const int i = 8 * g + j, s = 64 * i + lane; u[i] = (s <= t) ? u[i] : 0u; }
                    }
                } else {
#pragma unroll
                    for (int j = 0; j < 8; ++j) u[8 * g + j] = 0u;
                }
            }
        }
        __builtin_amdgcn_sched_barrier(0);
        ++k; const bool haveN = SEL_HAVE(k); const int rowN = haveN ? SEL_ROW(k) : 0;
        if (haveN) p4_sel_load(SC, rowN, lane, nu);
        __builtin_amdgcn_sched_barrier(0);
        if (t < TOPK) {
            const int lo = 64 * lane;
            mine = (t >= lo + 63) ? ~0ull : (t < lo ? 0ull : ((1ull << (t - lo + 1)) - 1ull));
        } else {
            const int ntot = 512 * ng;
            unsigned hp[32];
#pragma unroll
            for (int i = 0; i < 32; ++i) hp[i] = (u[2 * i] >> 16) | (u[2 * i + 1] & 0xffff0000u);
            unsigned T = 0u; bool exact = false; int geT = ntot;
            { const unsigned one2 = 0x00010001u; unsigned Th = 0u;
              for (int bit = 15; bit >= 0; --bit) {
                  const unsigned ch = Th | (1u << bit); unsigned c2 = ch | (ch << 16), acc2 = 0u;
                  asm volatile("" : "+v"(c2));
#pragma unroll
                  for (int g = 0; g < 8; ++g) {
                      if (g < ng) {
#pragma unroll
                          for (int j = 0; j < 4; ++j) { unsigned d;
                              asm("v_pk_sub_u16 %0, %1, %2 clamp" : "=v"(d) : "v"(c2), "v"(hp[4 * g + j]));
                              asm("v_pk_min_u16 %0, %1, %2" : "=v"(d) : "v"(d), "v"(one2));
                              asm("v_pk_add_u16 %0, %1, %2" : "=v"(acc2) : "v"(acc2), "v"(d)); }
                      }
                  }
                  const int ge = ntot - wave_sum_i_dpp((int)((acc2 & 0xffffu) + (acc2 >> 16)));
                  if (ge >= TOPK) { Th = ch; geT = ge; if (ge == TOPK) { exact = true; break; } }
              }
              T = Th << 16; }
            if (!exact) {
                for (int bit = 15; bit >= 0; --bit) {
                    unsigned cand = T | (1u << bit); int c = 0;
                    asm volatile("" : "+v"(cand));
#pragma unroll
                    for (int g = 0; g < 8; ++g) {
                        if (g < ng) {
#pragma unroll
                            for (int j = 0; j < 8; j += 2) { unsigned d0, d1;
                                asm("v_sub_u32_e64 %0, %1, %2 clamp" : "=v"(d0) : "v"(cand), "v"(u[8 * g + j]));
                                asm("v_sub_u32_e64 %0, %1, %2 clamp" : "=v"(d1) : "v"(cand), "v"(u[8 * g + j + 1]));
                                asm("v_min_u32_e32 %0, 1, %1" : "=v"(d0) : "v"(d0));
                                asm("v_min_u32_e32 %0, 1, %1" : "=v"(d1) : "v"(d1));
                                c += (int)(d0 + d1); }
                        }
                    }
                    const int ge = ntot - wave_sum_i_dpp(c);
                    if (ge >= TOPK) { T = cand; geT = ge; if (ge == TOPK) break; }
                }
            }
            const bool allties = (geT == TOPK);
            int need = 0;
            if (!allties) { int cg = 0;
#pragma unroll
                for (int g = 0; g < 8; ++g) {
                    if (g < ng) {
#pragma unroll
                        for (int j = 0; j < 8; ++j) cg += (u[8 * g + j] > T) ? 1 : 0;
                    }
                }
                need = TOPK - wave_sum_i_dpp(cg); }
            int running = 0; const unsigned long long lt = (1ull << lane) - 1ull;
#pragma unroll
            for (int g = 0; g < 8; ++g) {
                if (g < ng) {
#pragma unroll
                    for (int j = 0; j < 8; ++j) { const int i = 8 * g + j;
                        unsigned long long sb;
                        if (allties) sb = __ballot(u[i] >= T);
                        else { const bool eq = (u[i] == T); const unsigned long long bal = __ballot(eq);
                            const int rank = running + __popcll(bal & lt); running += __popcll(bal);
                            sb = __ballot((u[i] > T) || (eq && rank < need)); }
                        if (lane == i) mine = sb; }
                }
            }
        }
        MASK[(size_t)row * 64 + lane] = mine;
        row = rowN; have = haveN;
    }
#undef SEL_ROW
#undef SEL_HAVE
}

constexpr int AT_K = 0, AT_V = 34816, AT_END = 34816 + 34816;
constexpr int AT_MRG = 0, AT_STG = 69632;
__device__ __forceinline__ void p5_attention(Frame& F) {
    const bf16_t* AQ = WSP(bf16_t, WS_AQ); const bf16_t* AK = WSP(bf16_t, WS_AK); const bf16_t* AVT = WSP(bf16_t, WS_AVT); const unsigned* MASK = WSP(unsigned, WS_MASK); bf16_t* YATT = WSP(bf16_t, WS_YATT);
    const int lane = F.lane, r32 = lane & 31, hi = lane >> 5, w = F.wave, kp = w >> 2, tid = F.tid;
    LAS unsigned char* lds = F.lds;
    for (int item = F.bid; item < 256; item += F.G) {
        const int b = item >> 7, hk = (item >> 6) & 1, jj = item & 63;
        for (int uu = 0; uu < 2; ++uu) {
            const int j = uu ? 127 - jj : jj;
            const int head = hk * 4 + (w & 3);
            const size_t qrow = (size_t)b * SEQ + 32 * j + r32;
            const int NT = (j + 2) >> 1, NI = (NT + 1) >> 1;
            bf16x8 qf[8];
#pragma unroll
            for (int ks = 0; ks < 8; ++ks) qf[ks] = *(const bf16x8*)(AQ + qrow * 1024 + head * 128 + 16 * ks + 8 * hi);
            f32x16 o[4]; o[0] = f32x16{}; o[1] = f32x16{}; o[2] = f32x16{}; o[3] = f32x16{};
            float mrun = -INFINITY, lrun = 0.f;
            u32x4 sk[4], sv[4];
#pragma unroll
            for (int c = 0; c < 4; ++c) { sk[c] = (u32x4){0u, 0u, 0u, 0u}; sv[c] = (u32x4){0u, 0u, 0u, 0u}; }
            const bf16_t* Kg = AK + (size_t)b * SEQ * 256 + hk * 128;
            const bf16_t* Vg = AVT + (size_t)((b * 2 + hk) * 128) * SEQ;
#define AT_LOAD(it_) do { int tv = tid; asm volatile("" : "+v"(tv)); const unsigned kb2 = (unsigned)(it_) * 128u; \
                const unsigned ko = ((kb2 + (unsigned)(tv >> 4)) * 256u + (unsigned)(tv & 15) * 8u) * 2u; \
                const unsigned vo = ((unsigned)(tv >> 3) * (unsigned)SEQ + kb2 + (unsigned)(tv & 7) * 8u) * 2u; \
                _Pragma("unroll") for (int c = 0; c < 4; ++c) { \
                    sk[c] = *(const u32x4*)((const char*)Kg + ko + (unsigned)c * 32u * 512u); \
                    sv[c] = *(const u32x4*)((const char*)Vg + vo + (unsigned)(c & 1) * 64u * (unsigned)SEQ * 2u + (unsigned)(c >> 1) * 128u); } } while (0)
#define AT_STORE(bo_) do { \
                _Pragma("unroll") for (int c = 0; c < 4; ++c) { const int id = c * 512 + tid; const int key = id >> 4, ch = id & 15; \
                    *(LAS u32x4*)(lds + (bo_) + AT_K + key * 272 + ch * 16) = sk[c]; \
                    const int vd = (id >> 3) & 127, vp = id >> 10, vc = id & 7; \
                    LAS u32x2* dst = (LAS u32x2*)(lds + (bo_) + AT_V + vp * 17408 + vd * 136 + vc * 16); dst[0] = (u32x2){sv[c].x, sv[c].y}; dst[1] = (u32x2){sv[c].z, sv[c].w}; } } while (0)
            AT_LOAD(0);
            u32x2 mwn = (kp < NT) ? *(const u32x2*)(MASK + qrow * 128 + 2 * kp) : (u32x2){0u, 0u};
            __syncthreads();
            AT_STORE(0);
            if (NI > 1) AT_LOAD(1);
            __syncthreads();
            for (int it = 0; it < NI; ++it) {
                const int bo = (it & 1) * 69632;
                if (kp == 1 && it + 1 < NI) { AT_STORE(((it + 1) & 1) * 69632); if (it + 2 < NI) AT_LOAD(it + 2); }
                const int kt = 2 * it + kp;
                const u32x2 mw = mwn;
                if (kt + 2 < NT) mwn = *(const u32x2*)(MASK + qrow * 128 + 2 * (kt + 2));
                if (kt < NT) {
                    const LAS unsigned char* Kp = lds + bo + AT_K + kp * 17408; const LAS unsigned char* Vp = lds + bo + AT_V + kp * 17408;
                    f32x16 p0 = {}, p1 = {};
                    { bf16x8 kf[2][2][2];
#define AT_KLOAD(ks_, buf_) do { kf[buf_][(ks_) & 1][0] = *(const LAS bf16x8*)(Kp + r32 * 272 + (16 * (ks_) + 8 * hi) * 2); kf[buf_][(ks_) & 1][1] = *(const LAS bf16x8*)(Kp + (32 + r32) * 272 + (16 * (ks_) + 8 * hi) * 2); } while (0)
                      AT_KLOAD(0, 0); AT_KLOAD(1, 0);
#pragma unroll
                      for (int kk = 0; kk < 4; ++kk) {
                          __builtin_amdgcn_sched_barrier(0);
                          if (kk < 3) { AT_KLOAD(2 * kk + 2, (kk + 1) & 1); AT_KLOAD(2 * kk + 3, (kk + 1) & 1); }
#pragma unroll
                          for (int k2 = 0; k2 < 2; ++k2) { p0 = mfma32(kf[kk & 1][k2][0], qf[2 * kk + k2], p0); p1 = mfma32(kf[kk & 1][k2][1], qf[2 * kk + k2], p1); } }
#undef AT_KLOAD
                    }
                    __builtin_amdgcn_sched_barrier(0);
                    u32x4 vf[2][4];
#define AT_VLOAD(dt_, buf_) do { _Pragma("unroll") for (int s = 0; s < 4; ++s) { const LAS unsigned char* vr = Vp + ((dt_) * 32 + r32) * 136 + (16 * s + 4 * hi) * 2; \
                        const u32x2 lo = *(const LAS u32x2*)vr, hh = *(const LAS u32x2*)(vr + 16); vf[buf_][s] = (u32x4){lo.x, lo.y, hh.x, hh.y}; } } while (0)
                    AT_VLOAD(0, 0);
                    float rm = fmaxf(p0[0], p1[0]);
#pragma unroll
                    for (int r = 1; r < 16; ++r) rm = fmaxf(rm, fmaxf(p0[r], p1[r]));
                    rm = fmaxf(rm, __shfl_xor(rm, 32));
                    if (__any(rm > mrun + 8.0f)) { const float mnew = fmaxf(mrun, rm), alpha = __builtin_amdgcn_exp2f(mrun - mnew); lrun *= alpha; mrun = mnew;
#pragma unroll
                        for (int dt = 0; dt < 4; ++dt)
#pragma unroll
                            for (int r = 0; r < 16; ++r) o[dt][r] *= alpha; }
                    const int mx0 = (int)(mw.x >> (4 * hi)), mx1 = (int)(mw.y >> (4 * hi));
                    float ps = 0.f;
#pragma unroll
                    for (int r = 0; r < 16; ++r) { const int bp = (r & 3) + 8 * (r >> 2);
                        int k0 = __builtin_amdgcn_sbfe(mx0, bp, 1), k1 = __builtin_amdgcn_sbfe(mx1, bp, 1);
                        asm volatile("" : "+v"(k0), "+v"(k1));
                        p0[r] = __uint_as_float(__float_as_uint(__builtin_amdgcn_exp2f(p0[r] - mrun)) & (unsigned)k0);
                        p1[r] = __uint_as_float(__float_as_uint(__builtin_amdgcn_exp2f(p1[r] - mrun)) & (unsigned)k1);
                        ps += p0[r] + p1[r]; }
                    lrun += ps;
                    bf16x8 pb[4];
#pragma unroll
                    for (int s = 0; s < 2; ++s) { u32x4 t0, t1;
                        t0.x = pk2(p0[8 * s + 0], p0[8 * s + 1]); t0.y = pk2(p0[8 * s + 2], p0[8 * s + 3]); t0.z = pk2(p0[8 * s + 4], p0[8 * s + 5]); t0.w = pk2(p0[8 * s + 6], p0[8 * s + 7]);
                        t1.x = pk2(p1[8 * s + 0], p1[8 * s + 1]); t1.y = pk2(p1[8 * s + 2], p1[8 * s + 3]); t1.z = pk2(p1[8 * s + 4], p1[8 * s + 5]); t1.w = pk2(p1[8 * s + 6], p1[8 * s + 7]);
                        pb[s] = __builtin_bit_cast(bf16x8, t0); pb[2 + s] = __builtin_bit_cast(bf16x8, t1); }
#pragma unroll
                    for (int dt = 0; dt < 4; ++dt) {
                        __builtin_amdgcn_sched_barrier(0);
                        if (dt < 3) AT_VLOAD(dt + 1, (dt + 1) & 1);
#pragma unroll
                        for (int s = 0; s < 4; ++s) o[dt] = mfma32(__builtin_bit_cast(bf16x8, vf[dt & 1][s]), pb[s], o[dt]); }
#undef AT_VLOAD
                    __builtin_amdgcn_sched_barrier(0);
                }
                if (kp == 0 && it + 1 < NI) { AT_STORE(((it + 1) & 1) * 69632); if (it + 2 < NI) AT_LOAD(it + 2); }
                __syncthreads();
            }
            __syncthreads();
            LAS float* mg = (LAS float*)(lds + AT_MRG) + (w & 3) * 66 * 64;
            if (kp == 1) { mg[lane] = mrun; mg[64 + lane] = lrun;
#pragma unroll
                for (int dt = 0; dt < 4; ++dt)
#pragma unroll
                    for (int r = 0; r < 16; ++r) mg[(2 + dt * 16 + r) * 64 + lane] = o[dt][r]; }
            __syncthreads();
            if (kp == 0) {
                const float m1 = mg[lane], l1 = mg[64 + lane];
                const float mt = fmaxf(mrun, m1), mu = (mt == -INFINITY) ? 0.f : mt;
                const float a0 = __builtin_amdgcn_exp2f(mrun - mu), a1 = __builtin_amdgcn_exp2f(m1 - mu);
                float l = lrun * a0 + l1 * a1; l += __shfl_xor(l, 32);
                const float inv = 1.0f / l;
                LAS bf16_t* stg = (LAS bf16_t*)(lds + AT_STG) + (w & 3) * 32 * 136;
#pragma unroll
                for (int dt = 0; dt < 4; ++dt)
#pragma unroll
                    for (int r = 0; r < 16; ++r) { const float v = (o[dt][r] * a0 + mg[(2 + dt * 16 + r) * 64 + lane] * a1) * inv; stg[r32 * 136 + dt * 32 + crow(r, hi)] = (bf16_t)(pk2(v, 0.f) & 0xffffu); }
                LDS_WAIT();
#pragma unroll
                for (int i = 0; i < 8; ++i) { const int rr = i * 4 + (lane >> 4), ch = lane & 15; const u32x4 v = *(const LAS u32x4*)(stg + rr * 136 + ch * 8);
                    *(u32x4*)(YATT + ((size_t)b * SEQ + 32 * j + rr) * 1024 + head * 128 + ch * 8) = v; }
            }
        }
    }
#undef AT_LOAD
#undef AT_STORE
}

struct ProbMerge : ProbBase {
    static constexpr bool PERM = true;
    unsigned char* ws;
    __device__ __forceinline__ bool next(int i, U& u) const { u.aux = i & 1; return pg8::static_tile((i >> 1) * G + c, M / 256, DM / 256, u.pm, u.pn); }
    __device__ __forceinline__ void bases(const U& u, const char*& a, const char*& b) const {
        a = (const char*)(ws + (u.aux ? WS_YHG : WS_YATT)) + (size_t)u.pm * 256 * K * 2; b = (const char*)(ws + (u.aux ? WS_WHU_T : WS_WAU_T)) + (size_t)u.pn * 256 * K * 2; }
    __device__ __forceinline__ void lane_offs(const U&, const int (&stR)[2], const int (&stC)[2], unsigned (&va)[2][2]) const { lane_offs_plain(stR, stC, va); }
    __device__ __forceinline__ bool keep(const U& u) const { return u.aux == 0; }
    __device__ __forceinline__ void epi(f32x4 (&acc)[2][2][4][2], const U& u, int wr, int wc, int fr, int fq) const {
        const bf16_t* GA = (const bf16_t*)(ws + WS_GA); const bf16_t* GH = (const bf16_t*)(ws + WS_GH); bf16_t* O = (bf16_t*)(ws + WS_MERGED);
        const int row0 = u.pm * 256 + wr * 64 + fr, colw = u.pn * 256 + wc * 32 + 8 * fq;
#pragma unroll
        for (int ai = 0; ai < 2; ++ai) {
            u32x4 gh[4][2], ga[4][2];
#pragma unroll
            for (int m = 0; m < 4; ++m)
#pragma unroll
                for (int bj = 0; bj < 2; ++bj) { const size_t off = (size_t)(row0 + ai * 128 + m * 16) * DM + colw + bj * 128; gh[m][bj] = *(const u32x4*)(GH + off); if (u.aux == 0) ga[m][bj] = __builtin_nontemporal_load((const u32x4*)(GA + off)); else ga[m][bj] = gh[m][bj]; }
            __builtin_amdgcn_sched_barrier(0);
#pragma unroll
            for (int m = 0; m < 4; ++m)
#pragma unroll
                for (int bj = 0; bj < 2; ++bj) { const size_t off = (size_t)(row0 + ai * 128 + m * 16) * DM + colw + bj * 128;
                    const unsigned ghw[4] = {gh[m][bj].x, gh[m][bj].y, gh[m][bj].z, gh[m][bj].w}; const unsigned gaw[4] = {ga[m][bj].x, ga[m][bj].y, ga[m][bj].z, ga[m][bj].w};
                    if (u.aux == 0) {
#pragma unroll
                        for (int n = 0; n < 2; ++n)
#pragma unroll
                            for (int e = 0; e < 4; ++e) { const int wi = 2 * n + (e >> 1); const float a = (e & 1) ? bf2f(gaw[wi] >> 16) : bf2f(gaw[wi] & 0xffffu), h = (e & 1) ? bf2f(ghw[wi] >> 16) : bf2f(ghw[wi] & 0xffffu);
                                acc[ai][bj][m][n][e] *= a * frcp(fmaxf(h, 1e-20f)); } }
                    else { float v[8];
#pragma unroll
                        for (int n = 0; n < 2; ++n)
#pragma unroll
                            for (int e = 0; e < 4; ++e) { const int wi = 2 * n + (e >> 1); const float h = (e & 1) ? bf2f(ghw[wi] >> 16) : bf2f(ghw[wi] & 0xffffu); v[4 * n + e] = acc[ai][bj][m][n][e] * h; }
                        u32x4 w; w.x = pk2(v[0], v[1]); w.y = pk2(v[2], v[3]); w.z = pk2(v[4], v[5]); w.w = pk2(v[6], v[7]); *(u32x4*)(O + off) = w; } }
            __builtin_amdgcn_sched_barrier(0);
        }
    }
};

struct ProbOut : ProbBase {
    static constexpr bool PERM = false;
    unsigned char* ws; const float* x; float* out;
    __device__ __forceinline__ bool next(int i, U& u) const { u.aux = 0; return pg8::static_tile(i * G + c, M / 256, DM / 256, u.pm, u.pn); }
    __device__ __forceinline__ void bases(const U& u, const char*& a, const char*& b) const { a = (const char*)(ws + WS_MERGED) + (size_t)u.pm * 256 * K * 2; b = (const char*)(ws + WS_WOUT_T) + (size_t)u.pn * 256 * K * 2; }
    __device__ __forceinline__ void lane_offs(const U&, const int (&stR)[2], const int (&stC)[2], unsigned (&va)[2][2]) const { lane_offs_plain(stR, stC, va); }
    __device__ __forceinline__ void epi(f32x4 (&acc)[2][2][4][2], const U& u, int wr, int wc, int fr, int fq) const {
        const float* MOD = (const float*)(ws + WS_MOD);
        const int row0 = u.pm * 256 + wr * 64 + fr, col0 = u.pn * 256 + wc * 32 + 4 * fq, b = (u.pm * 256) >> 12;
#pragma unroll
        for (int bj = 0; bj < 2; ++bj)
#pragma unroll
            for (int n = 0; n < 2; ++n) { const int col = col0 + bj * 128 + n * 16; const f32x4 gt = *(const f32x4*)(MOD + b * 12288 + 2 * DM + col);
                f32x4 xv[8];
#pragma unroll
                for (int ai = 0; ai < 2; ++ai)
#pragma unroll
                    for (int m = 0; m < 4; ++m) xv[ai * 4 + m] = __builtin_nontemporal_load((const f32x4*)(x + (size_t)(row0 + ai * 128 + m * 16) * DM + col));
                __builtin_amdgcn_sched_barrier(0);
#pragma unroll
                for (int ai = 0; ai < 2; ++ai)
#pragma unroll
                    for (int m = 0; m < 4; ++m) { const size_t off = (size_t)(row0 + ai * 128 + m * 16) * DM + col; *(f32x4*)(out + off) = xv[ai * 4 + m] + gt * acc[ai][bj][m][n]; }
                __builtin_amdgcn_sched_barrier(0); }
    }
};

__device__ __forceinline__ void p8_norm2_route(Frame& F) {
    LAS float* CA = (LAS float*)F.lds; LAS float* CB = CA + DM;
    LAS float* WB = CB + DM;
    LAS float* LOGI = WB + 2 * 9216;
    const float* MOD = WSP(float, WS_MOD); bf16_t* XN = WSP(bf16_t, WS_XN); const float* X1 = F.out;
    int* LIST = WSP(int, WS_LIST); float* LISTW = WSP(float, WS_LISTW);
    const int lane = F.lane, tid = F.tid;
#define RT_STAGE(j_, buf_) do { int lv_ = lane; asm volatile("" : "+v"(lv_)); _Pragma("unroll") for (int i_ = 0; i_ < 5; ++i_) { const int id0_ = i_ * 512 + F.wave * 64; if (id0_ < 2304) { const int id_ = id0_ + lv_, rho_ = id_ / 9, q_ = id_ - rho_ * 9; \
            const int k_ = (j_) * 256 + 4 * (rho_ & 63) + (rho_ >> 6); const float* src_ = (q_ == 0) ? (F.w_rg + (size_t)k_ * 4) : (F.w_re + (size_t)k_ * 32 + (q_ - 1) * 4); \
            __builtin_amdgcn_global_load_lds((const unsigned*)src_, (LAS unsigned*)(WB + (buf_) * 9216 + id0_ * 4), 16, 0, 0); } } } while (0)
    for (int rb = F.bid; rb < M / 32; rb += F.G) {
        const int b = (rb * 32) / SEQ;
        __syncthreads();
        for (int k = tid; k < DM; k += NTHREADS) { CA[k] = F.g_norm2[k] * (1.0f + MOD[b * 12288 + 4 * DM + k]); CB[k] = MOD[b * 12288 + 3 * DM + k]; }
        RT_STAGE(0, 0);
        __syncthreads();
        const int mb = rb * 32 + F.wave * 4;
        float rs[4];
#pragma unroll
        for (int r = 0; r < 4; ++r) { __builtin_amdgcn_sched_barrier(0); f32x4 v[8]; rs[r] = row_rstd(X1 + (size_t)(mb + r) * DM, lane, v);
#pragma unroll
            for (int j = 0; j < 8; ++j) { const int k = 4 * (lane + 64 * j); const f32x4 a = *(const LAS f32x4*)(CA + k), bb = *(const LAS f32x4*)(CB + k);
                const f32x4 h = v[j] * rs[r] * a + bb; u32x2 o; o.x = pk2(h.x, h.y); o.y = pk2(h.z, h.w); *(u32x2*)(XN + (size_t)(mb + r) * DM + k) = o; } }
        LAS float* red = WB + F.wave * 2304;
#pragma unroll 1
        for (int half = 0; half < 2; ++half) {
            const int m0 = mb + 2 * half;
            const float rs0 = half ? rs[2] : rs[0], rs1 = half ? rs[3] : rs[1];
            float acc[2][36];
#pragma unroll
            for (int r = 0; r < 2; ++r)
#pragma unroll
                for (int j = 0; j < 36; ++j) acc[r][j] = 0.f;
            if (half) { __syncthreads(); RT_STAGE(0, 0); }
            f32x4 xc[2];
            xc[0] = *(const f32x4*)(X1 + (size_t)m0 * DM + 4 * lane); xc[1] = *(const f32x4*)(X1 + (size_t)(m0 + 1) * DM + 4 * lane);
#pragma unroll 1
            for (int j = 0; j < 8; ++j) {
                __syncthreads();
                if (j < 7) RT_STAGE(j + 1, (j + 1) & 1);
                const f32x4 ca = *(const LAS f32x4*)(CA + 256 * j + 4 * lane), cb = *(const LAS f32x4*)(CB + 256 * j + 4 * lane);
                const f32x4 h0 = xc[0] * rs0 * ca + cb, h1 = xc[1] * rs1 * ca + cb;
                if (j < 7) { xc[0] = *(const f32x4*)(X1 + (size_t)m0 * DM + 256 * (j + 1) + 4 * lane); xc[1] = *(const f32x4*)(X1 + (size_t)(m0 + 1) * DM + 256 * (j + 1) + 4 * lane); }
                const LAS float* wb = WB + (j & 1) * 9216;
#pragma unroll
                for (int e = 0; e < 4; ++e)
#pragma unroll
                    for (int q = 0; q < 9; ++q) { const f32x4 wv = *(const LAS f32x4*)(wb + (e * 64 + lane) * 36 + q * 4);
#pragma unroll
                        for (int c = 0; c < 4; ++c) { acc[0][q * 4 + c] += h0[e] * wv[c]; acc[1][q * 4 + c] += h1[e] * wv[c]; } }
            }
            __syncthreads();
#pragma unroll
            for (int r = 0; r < 2; ++r) {
#pragma unroll
                for (int q = 0; q < 9; ++q) *(LAS f32x4*)(red + lane * 36 + q * 4) = (f32x4){acc[r][q * 4], acc[r][q * 4 + 1], acc[r][q * 4 + 2], acc[r][q * 4 + 3]};
                LDS_WAIT(); asm volatile("" ::: "memory");
                if (lane < 36) { float sm = 0.f;
#pragma unroll 16
                    for (int l = 0; l < 64; ++l) sm += red[l * 36 + lane];
                    LOGI[(F.wave * 2 + r) * 36 + lane] = sm + (lane < 4 ? F.b_rg[lane] : F.b_re[lane - 4]); }
                LDS_WAIT(); asm volatile("" ::: "memory");
            }
            if (lane < 2) {
                const LAS float* lg = LOGI + (F.wave * 2 + lane) * 36;
                int grp = 0; float gm = lg[0];
#pragma unroll
                for (int g = 1; g < 4; ++g) if (lg[g] > gm) { gm = lg[g]; grp = g; }
                float gs = 0.f;
#pragma unroll
                for (int g = 0; g < 4; ++g) gs += expf(lg[g] - gm);
                const float pgrp = 1.0f / gs;
                float el[8];
#pragma unroll
                for (int e = 0; e < 8; ++e) { el[e] = lg[4 + e]; if (grp == 1) el[e] = lg[12 + e]; if (grp == 2) el[e] = lg[20 + e]; if (grp == 3) el[e] = lg[28 + e]; }
                int e0 = 0; float v0 = el[0];
#pragma unroll
                for (int e = 1; e < 8; ++e) if (el[e] > v0) { v0 = el[e]; e0 = e; }
                int e1 = -1; float v1 = -INFINITY;
#pragma unroll
                for (int e = 0; e < 8; ++e) if (e != e0 && el[e] > v1) { v1 = el[e]; e1 = e; }
                const float p1 = expf(v1 - v0), w0 = pgrp / (1.0f + p1), w1 = pgrp * p1 / (1.0f + p1);
                const int m = m0 + lane;
                const int ea = grp * 8 + e0, eb = grp * 8 + e1;
                const unsigned sa = __hip_atomic_fetch_add(F.ctl + CW_CNT + 16 * ea, 1u, RLX_AGENT);
                const unsigned sb = __hip_atomic_fetch_add(F.ctl + CW_CNT + 16 * eb, 1u, RLX_AGENT);
                LIST[ea * M + sa] = 2 * m; LISTW[ea * M + sa] = w0;
                LIST[eb * M + sb] = 2 * m + 1; LISTW[eb * M + sb] = w1;
            }
            LDS_WAIT(); asm volatile("" ::: "memory");
        }
    }
#undef RT_STAGE
}

__device__ __forceinline__ void p8_expert_weights(Frame& F) {
    const int lane = F.lane;
    {
        __syncthreads();
        LAS float* scr = (LAS float*)(F.lds + F.wave * 16384);
        const int gw = F.bid * NWAVES + F.wave, NGW = F.G * NWAVES;
#define P8_DESC(it, d) do { const int e_ = (it) / 1024; const int r_ = (it) % 1024; \
            if (r_ < 512) { d.W = F.w_eg + (size_t)e_ * DM * EFF; d.K = DM; d.N = EFF; d.WT = WSP(bf16_t, WS_WGU_T) + (size_t)e_ * 1024 * DM; d.kind = 2; d.item = r_; } \
            else { d.W = F.w_eu + (size_t)e_ * DM * EFF; d.K = DM; d.N = EFF; d.WT = WSP(bf16_t, WS_WGU_T) + (size_t)e_ * 1024 * DM; d.kind = 3; d.item = r_ - 512; } } while (0)
        TD_STREAM(gw, NGW, NEXP * 1024, P8_DESC, lane, scr);
#undef P8_DESC
    }
}

constexpr int MOE_TAB_OFF = LDSCTL_OFF + 2048;
struct ProbMoe : ProbBase {
    unsigned char* ws; const LAS int* tab; int nct; unsigned* done;
    __device__ __forceinline__ bool decode(int L, U& u) const {
        const int l = (int)(threadIdx.x & 31); const bool in = (L >= tab[65 + l]) && (L < tab[66 + l]);
        const unsigned long long bal = __ballot(in);
        if (bal == 0ull) return false;
        const int e = __builtin_ctzll(bal); const int rem = L - tab[65 + e];
        u.aux = e; u.pm = rem / nct; u.pn = rem - u.pm * nct; return true;
    }
    __device__ __forceinline__ int rowbase(int e) const { return tab[32 + e]; }
    __device__ __forceinline__ int count(int e) const { return tab[e]; }
};
__device__ __forceinline__ void moe_table(LAS unsigned char* lds, const unsigned* cnt, int nct) {
    LAS int* tab = (LAS int*)(lds + MOE_TAB_OFF);
    __syncthreads();
    if (threadIdx.x < NEXP) tab[threadIdx.x] = (int)__hip_atomic_load(cnt + 16 * threadIdx.x, __ATOMIC_RELAXED, __HIP_MEMORY_SCOPE_AGENT);
    __syncthreads();
    if (threadIdx.x == 0) { int rb = 0, st = 0; for (int e = 0; e < NEXP; ++e) { tab[32 + e] = rb; tab[65 + e] = st; const int nrt = (tab[e] + 255) >> 8; rb += nrt * 256; st += nrt * nct; } tab[64] = rb; tab[97] = st; }
    __syncthreads();
}
struct ProbMoe1 : ProbMoe {
    static constexpr bool PERM = true;
    __device__ __forceinline__ bool next(int i, U& u) const { return decode(i * G + c, u); }
    __device__ __forceinline__ void bases(const U& u, const char*& a, const char*& b) const { a = (const char*)(ws + WS_XN); b = (const char*)(ws + WS_WGU_T) + ((size_t)u.aux * 1024 + u.pn * 256) * K * 2; }
    __device__ __forceinline__ void lane_offs(const U& u, const int (&stR)[2], const int (&stC)[2], unsigned (&va)[2][2]) const {
        const int* LIST = (const int*)(ws + WS_LIST); const int n = count(u.aux);
#pragma unroll
        for (int h = 0; h < 2; ++h)
#pragma unroll
            for (int i = 0; i < 2; ++i) { const int sl = u.pm * 256 + h * 128 + stR[i]; const int tok = LIST[u.aux * M + (sl < n ? sl : 0)] >> 1; va[h][i] = (unsigned)(tok * K + stC[i]) * 2u; }
    }
    __device__ __forceinline__ void epi(f32x4 (&acc)[2][2][4][2], const U& u, int wr, int wc, int fr, int fq) const {
        const float* LISTW = (const float*)(ws + WS_LISTW); bf16_t* ACT = (bf16_t*)(ws + WS_ACT);
        const int n = count(u.aux), rb = rowbase(u.aux);
        const int f0 = u.pn * 128 + wc * 16 + 4 * fq;
        float wts[8];
#pragma unroll
        for (int ai = 0; ai < 2; ++ai)
#pragma unroll
            for (int m = 0; m < 4; ++m) { const int sl = u.pm * 256 + ai * 128 + wr * 64 + m * 16 + fr; wts[ai * 4 + m] = LISTW[u.aux * M + (sl < n ? sl : 0)]; }
        __builtin_amdgcn_sched_barrier(0);
#pragma unroll
        for (int ai = 0; ai < 2; ++ai)
#pragma unroll
            for (int m = 0; m < 4; ++m) { const int sl = u.pm * 256 + ai * 128 + wr * 64 + m * 16 + fr;
                if (sl < n) { const float wt = wts[ai * 4 + m];
#pragma unroll
                    for (int bj = 0; bj < 2; ++bj) { const f32x4 g = acc[ai][bj][m][0], uu = acc[ai][bj][m][1]; float v[4];
#pragma unroll
                        for (int e = 0; e < 4; ++e) v[e] = siluf_(g[e]) * uu[e] * wt;
                        const unsigned long long w = (unsigned long long)pk2(v[0], v[1]) | ((unsigned long long)pk2(v[2], v[3]) << 32);
                        __hip_atomic_store((unsigned long long*)(ACT + (size_t)(rb + sl) * EFF + f0 + bj * 64), w, RLX_AGENT); } } }
        asm volatile("s_waitcnt vmcnt(0)" ::: "memory");
        if ((threadIdx.x & 63) == 0) __hip_atomic_fetch_add(done + 16 * ((rb >> 8) + u.pm), 1u, RLX_AGENT);
    }
};
struct ProbMoe2 : ProbMoe {
    static constexpr bool PERM = true;
    __device__ __forceinline__ void ready(const U& u, bool me) const {
        if (me) { unsigned* p = done + 16 * ((rowbase(u.aux) >> 8) + u.pm); unsigned sp = 0;
            while (__hip_atomic_load(p, RLX_AGENT) < 32u) { __builtin_amdgcn_s_sleep(2); if (++sp > (1u << 20)) break; }
            __builtin_amdgcn_fence(__ATOMIC_ACQUIRE, "agent"); asm volatile("s_waitcnt vmcnt(0)" ::: "memory"); }
    }
    __device__ __forceinline__ bool next(int i, U& u) const {
        const int u1 = tab[97] >> 1;
        const int base = u1 / G, rem = u1 - base * G, tot = tab[97];
        int n_early = 2 * base * G; if (n_early > tot) n_early = tot;
        int L;
        if (c >= rem) { const int W = G - rem, first = c - rem; const int ce = (n_early > first) ? (n_early - first + W - 1) / W : 0;
            L = (i < ce) ? (i * W + first) : (n_early + (i - ce) * G + c); }
        else L = n_early + i * G + c;
        return decode(L, u);
    }
    __device__ __forceinline__ void bases(const U& u, const char*& a, const char*& b) const { a = (const char*)(ws + WS_ACT) + (size_t)(rowbase(u.aux) + u.pm * 256) * K * 2; b = (const char*)(ws + WS_WD_T) + ((size_t)u.aux * DM + u.pn * 256) * K * 2; }
    __device__ __forceinline__ void lane_offs(const U&, const int (&stR)[2], const int (&stC)[2], unsigned (&va)[2][2]) const { lane_offs_plain(stR, stC, va); }
    __device__ __forceinline__ void epi(f32x4 (&acc)[2][2][4][2], const U& u, int wr, int wc, int fr, int fq) const {
        const int* LIST = (const int*)(ws + WS_LIST); bf16_t* YS = (bf16_t*)(ws + WS_YS);
        const int n = count(u.aux);
        const int colw = u.pn * 256 + wc * 32 + 8 * fq;
        int slots[8];
#pragma unroll
        for (int ai = 0; ai < 2; ++ai)
#pragma unroll
            for (int m = 0; m < 4; ++m) { const int sl = u.pm * 256 + ai * 128 + wr * 64 + m * 16 + fr; slots[ai * 4 + m] = LIST[u.aux * M + (sl < n ? sl : 0)]; }
        __builtin_amdgcn_sched_barrier(0);
#pragma unroll
        for (int ai = 0; ai < 2; ++ai)
#pragma unroll
            for (int m = 0; m < 4; ++m) { const int sl = u.pm * 256 + ai * 128 + wr * 64 + m * 16 + fr;
                if (sl < n) { const int slot = slots[ai * 4 + m];
#pragma unroll
                    for (int bj = 0; bj < 2; ++bj) { const f32x4 v0 = acc[ai][bj][m][0], v1 = acc[ai][bj][m][1];
                        u32x4 w; w.x = pk2(v0[0], v0[1]); w.y = pk2(v0[2], v0[3]); w.z = pk2(v1[0], v1[1]); w.w = pk2(v1[2], v1[3]);
                        *(u32x4*)(YS + (size_t)slot * DM + colw + bj * 128) = w; } } }
    }
};

__device__ __forceinline__ void p11_final(Frame& F, float* dst) {
    const float* MOD = WSP(float, WS_MOD); const bf16_t* YS = WSP(bf16_t, WS_YS);
    const int gw = F.bid * NWAVES + F.wave, NGW = F.G * NWAVES, lane = F.lane;
    for (int m = gw; m < M; m += NGW) {
        const int b = m >> 12; const float* row = F.out + (size_t)m * DM; float* orow = dst + (size_t)m * DM; f32x4 v[8]; float s = 0.f;
#pragma unroll
        for (int j = 0; j < 8; ++j) { const int k = 4 * (lane + 64 * j); const f32x4 xv = __builtin_nontemporal_load((const f32x4*)(row + k)), gt = *(const f32x4*)(MOD + b * 12288 + 5 * DM + k);
            const u32x2 y0 = __builtin_nontemporal_load((const u32x2*)(YS + (size_t)(2 * m) * DM + k)), y1 = __builtin_nontemporal_load((const u32x2*)(YS + (size_t)(2 * m + 1) * DM + k));
            f32x4 y; y.x = bf2f(y0.x & 0xffffu) + bf2f(y1.x & 0xffffu); y.y = bf2f(y0.x >> 16) + bf2f(y1.x >> 16); y.z = bf2f(y0.y & 0xffffu) + bf2f(y1.y & 0xffffu); y.w = bf2f(y0.y >> 16) + bf2f(y1.y >> 16);
            v[j] = xv + gt * y; s += (v[j].x * v[j].x + v[j].y * v[j].y) + (v[j].z * v[j].z + v[j].w * v[j].w); }
        f32x4 gf[8];
#pragma unroll
        for (int j = 0; j < 8; ++j) gf[j] = *(const f32x4*)(F.g_final + 4 * (lane + 64 * j));
        const float rs = 1.0f / sqrtf(wave_sum(s) * (1.0f / DM) + EPS);
#pragma unroll
        for (int j = 0; j < 8; ++j) { const int k = 4 * (lane + 64 * j); __builtin_nontemporal_store(v[j] * rs * gf[j], (f32x4*)(orow + k)); }
    }
}

constexpr int NPHASE = 12;
struct Args { const void* in[21]; float* out; unsigned char* ws; int ph_lo, ph_hi; };
__global__ void __launch_bounds__(NTHREADS, 2) hybrid_block_fwd(Args args) {
    extern __shared__ __attribute__((aligned(16))) unsigned char lds_raw[];
    Frame F;
    F.lds = (LAS unsigned char*)lds_raw;
    F.tid = threadIdx.x; F.lane = F.tid & 63; F.wave = __builtin_amdgcn_readfirstlane(F.tid >> 6); F.G = gridDim.x; F.bid = blockIdx.x;
    F.ws = args.ws; F.ctl = (unsigned*)(args.ws + WS_CTL); F.out = args.out;
    F.x = (const float*)args.in[0]; F.c = (const float*)args.in[1]; F.positions = (const int*)args.in[2]; F.w_ada = (const float*)args.in[3]; F.b_ada = (const float*)args.in[4];
    F.g_norm1 = (const float*)args.in[5]; F.w_in = (const float*)args.in[6]; F.g_head = (const float*)args.in[7]; F.hglb = (const float*)args.in[8]; F.w_attn_up = (const float*)args.in[9];
    F.w_hgrn_up = (const float*)args.in[10]; F.w_out = (const float*)args.in[11]; F.g_norm2 = (const float*)args.in[12]; F.w_rg = (const float*)args.in[13]; F.b_rg = (const float*)args.in[14];
    F.w_re = (const float*)args.in[15]; F.b_re = (const float*)args.in[16]; F.w_eg = (const float*)args.in[17]; F.w_eu = (const float*)args.in[18]; F.w_ed = (const float*)args.in[19]; F.g_final = (const float*)args.in[20];
    volatile LAS unsigned* MISC = (volatile LAS unsigned*)(F.lds + MISC_OFF);
    for (int u = F.tid; u < (LDS_EXTRA - LDSCTL_OFF) / 4; u += NTHREADS) ((LAS unsigned*)(F.lds + LDSCTL_OFF))[u] = 0u;
    __syncthreads();
    const int lo = args.ph_lo, hi = args.ph_hi;
    XcdBarrier bar; bar.bar = F.ctl + CW_BAR; bar.x = 0; bar.st = nullptr;
    if (hi - lo > 1) bar = xcd_barrier_post(F.ctl + CW_BAR, MISC + 8);
#ifndef PHMASK
#define PHMASK 0xfff
#endif
#define IN(k) (((PHMASK >> (k)) & 1) && lo <= (k) && (k) < hi)
#define SEAM(k) do { if (IN(k) && IN((k) + 1)) xcd_barrier(bar); } while (0)
#ifndef REPMASK
#define REPMASK 0
#endif
#define RUN2(k, BODY) do { if (IN(k)) { BODY } if (((REPMASK >> (k)) & 1) && IN(k)) { xcd_barrier(bar); BODY } } while (0)
    RUN2(0, p0_prologue(F);); SEAM(0);
    RUN2(1, p1_norm1(F);); SEAM(1);
#define BODY2 { ProbWin P; P.K = DM; P.G = F.G; P.c = F.bid; P.A = (const char*)(F.ws + WS_XN); P.B = (const char*)(F.ws + WS_WIN_T); P.ws = F.ws; P.hglb = F.hglb; pg8::gemm_phase(F.lds, P); }
    RUN2(2, BODY2); SEAM(2);
    RUN2(3, p3_indexer(F); p3_late_weights(F); p3_hgrn_upd(F);); if ((REPMASK >> 20) & 1) { xcd_barrier(bar); p3_indexer(F); } if ((REPMASK >> 21) & 1) { xcd_barrier(bar); p3_hgrn_upd(F); } SEAM(3);
    if (IN(4)) {
        if (F.wave >= 4) p4_down_weights(F);
        p4_select(F);
        if (F.wave < 4) p4_down_weights(F);
        p4_hgrn_scan(F); } if ((REPMASK >> 15) & 1) { xcd_barrier(bar); p4_select(F); } if ((REPMASK >> 16) & 1) { xcd_barrier(bar); p4_hgrn_scan(F); } SEAM(4);
    RUN2(5, p5_attention(F); p5_hgrn_out(F);); if ((REPMASK >> 13) & 1) { xcd_barrier(bar); p5_attention(F); } if ((REPMASK >> 14) & 1) { xcd_barrier(bar); p5_hgrn_out(F); } SEAM(5);
#define BODY6 { ProbMerge P; P.K = 1024; P.G = F.G; P.c = F.bid; P.ws = F.ws; pg8::gemm_phase(F.lds, P); }
    RUN2(6, BODY6); SEAM(6);
#define BODY7 { ProbOut P; P.K = DM; P.G = F.G; P.c = F.bid; P.ws = F.ws; P.x = F.x; P.out = F.out; pg8::gemm_phase(F.lds, P); }
    RUN2(7, BODY7); if (IN(7) && IN(8)) { p8_expert_weights(F); } SEAM(7);
    if (IN(8)) { if (!IN(7)) p8_expert_weights(F); if ((REPMASK >> 12) & 1) { xcd_barrier(bar); p8_expert_weights(F); } p8_norm2_route(F); if ((REPMASK >> 17) & 1) { xcd_barrier(bar); if (F.bid == 0 && F.tid < 32) __hip_atomic_store(F.ctl + CW_CNT + 16 * F.tid, 0u, RLX_AGENT); xcd_barrier(bar); p8_norm2_route(F); } } SEAM(8);
#define BODY9 { moe_table(F.lds, F.ctl + CW_CNT, 4); ProbMoe1 P; P.K = DM; P.G = F.G; P.c = F.bid; P.ws = F.ws; P.tab = (const LAS int*)(F.lds + MOE_TAB_OFF); P.nct = 4; P.done = F.ctl + CW_DONE; pg8::gemm_phase(F.lds, P); }
    if (IN(9)) BODY9;
#if MK_MULTI
    SEAM(9);
#endif
#define BODY10 { moe_table(F.lds, F.ctl + CW_CNT, 8); ProbMoe2 P; P.K = EFF; P.G = F.G; P.c = F.bid; P.ws = F.ws; P.tab = (const LAS int*)(F.lds + MOE_TAB_OFF); P.nct = 8; P.done = F.ctl + CW_DONE; pg8::gemm_phase(F.lds, P); }
    if (IN(10)) BODY10; SEAM(10);
    if (IN(11)) { if ((REPMASK >> 18) & 1) { p11_final(F, WSP(float, WS_UPDT)); xcd_barrier(bar); } p11_final(F, F.out); }
    if ((REPMASK >> 19) & 1) { xcd_barrier(bar); BODY2 }
#undef IN
#undef SEAM
}

extern "C" void kernel_launch(void* const* d_in, const int* in_sizes, int n_in, void* d_out, int out_size, void* d_ws, size_t ws_size, hipStream_t stream) {
    static int grid = 0;
    if (grid == 0) {
        if (n_in != 21 || in_sizes[0] != M * DM || out_size != M * DM || ws_size < WS_END) { fprintf(stderr, "kernel_launch: unexpected shapes/workspace (n_in %d, in0 %d, out %d, ws %zu)\n", n_in, n_in > 0 ? in_sizes[0] : -1, out_size, ws_size); grid = -1; return; }
        int dev = 0, cus = 0, per_cu = 0;
        if (hipGetDevice(&dev) != hipSuccess || hipDeviceGetAttribute(&cus, hipDeviceAttributeMultiprocessorCount, dev) != hipSuccess) { grid = -1; return; }
        if (hipFuncSetAttribute((const void*)hybrid_block_fwd, hipFuncAttributeMaxDynamicSharedMemorySize, LDS_BYTES) != hipSuccess) { fprintf(stderr, "kernel_launch: hipFuncSetAttribute failed\n"); grid = -1; return; }
        if (hipOccupancyMaxActiveBlocksPerMultiprocessor(&per_cu, (const void*)hybrid_block_fwd, NTHREADS, LDS_BYTES) != hipSuccess || per_cu < 1) fprintf(stderr, "kernel_launch: occupancy query reports %d\n", per_cu);
        (void)hipGetLastError();
        grid = cus;
    }
    if (grid < 0) return;
    (void)hipMemsetAsync((char*)d_ws + WS_CTL, 0, CTL_ZERO_BYTES, stream);
    Args a{};
    for (int i = 0; i < 21; ++i) a.in[i] = d_in[i];
    a.out = (float*)d_out; a.ws = (unsigned char*)d_ws;
#if MK_MULTI
    for (int p = 0; p < NPHASE; ++p) { a.ph_lo = p; a.ph_hi = p + 1; hipLaunchKernelGGL(hybrid_block_fwd, dim3(grid), dim3(NTHREADS), LDS_BYTES, stream, a); }
#else
    a.ph_lo = 0; a.ph_hi = NPHASE; hipLaunchKernelGGL(hybrid_block_fwd, dim3(grid), dim3(NTHREADS), LDS_BYTES, stream, a);
#endif
}
```

```cpp
#include <hip/hip_runtime.h>
#include <cstdio>
#include <cstdint>

#define REPMASK 0x0
#ifndef MK_MULTI
#define MK_MULTI 0
#endif

#define GAS __attribute__((address_space(1)))
#define LAS __attribute__((address_space(3)))
typedef unsigned short bf16_t;
typedef short bf16x8 __attribute__((ext_vector_type(8)));
typedef short s16x4 __attribute__((ext_vector_type(4)));
typedef short v4i16_t __attribute__((ext_vector_type(4)));
typedef float f32x4 __attribute__((ext_vector_type(4)));
typedef float f32x2 __attribute__((ext_vector_type(2)));
typedef float f32x16 __attribute__((ext_vector_type(16)));
typedef unsigned u32x4 __attribute__((ext_vector_type(4)));
typedef unsigned u32x2 __attribute__((ext_vector_type(2)));

constexpr int DM = 2048, NBATCH = 2, SEQ = 4096, M = NBATCH * SEQ;
constexpr int NLOG = 10312, NPHYS = 10240;
constexpr int NEXP = 32, EFF = 512;
constexpr float EPS = 1e-6f;
constexpr float ATT_SCALE_L2E = 0.08838834764831845f * 1.4426950408889634f;
constexpr float IDX_SCALE = 0.04419417382415922f;
constexpr int TOPK = 256;

constexpr size_t MiB = 1u << 20;
constexpr size_t WS_CTL = 0, CTL_ZERO_BYTES = 1 * MiB;
constexpr size_t WS_WIN_T = 1 * MiB, WS_WAU_T = 42 * MiB, WS_WHU_T = 46 * MiB, WS_WOUT_T = 50 * MiB;
constexpr size_t WS_XN = 58 * MiB, WS_MODP = 90 * MiB, WS_MOD = 92 * MiB, WS_TABA = 93 * MiB, WS_TABI = 97 * MiB, WS_MASK = 99 * MiB;
constexpr size_t WS_WRF = 103 * MiB + 512 * 1024;
constexpr size_t WS_W40T = 104 * MiB;
constexpr size_t WS_DECAY = 103 * MiB, WS_LIST = 105 * MiB, WS_LISTW = 106 * MiB, WS_SPREVT = 107 * MiB, WS_YATT = 139 * MiB, WS_YHG = 155 * MiB, WS_UPDT = 171 * MiB;
constexpr size_t WS_AQ = 235 * MiB, WS_AK = 251 * MiB, WS_AVT = 255 * MiB, WS_IQ = 259 * MiB, WS_IK = 267 * MiB, WS_IW = 268 * MiB, WS_HQ = 269 * MiB, WS_LOGF = 285 * MiB,
                 WS_KF = 317 * MiB, WS_HI = 333 * MiB, WS_HOG = 349 * MiB, WS_GA = 365 * MiB, WS_GH = 397 * MiB;
constexpr size_t WS_WGU_T = 235 * MiB;
constexpr size_t WS_X1 = 203 * MiB;
constexpr size_t WS_WD_T = 581 * MiB;
constexpr size_t WS_SCORES = 429 * MiB;
constexpr size_t WS_MERGED = 429 * MiB, WS_YS = 461 * MiB, WS_ACT = 557 * MiB;
constexpr size_t WS_END = 645 * MiB;
constexpr int NEARLY = 10;
__device__ __forceinline__ size_t wgu_off(int e) { return (size_t)(e < NEARLY ? 1 + 4 * e : 235 + 4 * (e - NEARLY)) * MiB; }
constexpr int CW_BAR = 4096, CW_CNT = 16384, CNT_STRIDE = 1024, CW_DONE = 65536;

constexpr int RING_BYTES = 139264, LDSCTL_OFF = RING_BYTES, MISC_OFF = LDSCTL_OFF + 320, LDS_EXTRA = 147456, LDS_BYTES = 163840;
constexpr int NWAVES = 8, NTHREADS = 512;

constexpr int NKS = 4;
#define SPREAD_FOR(e_, total_, gt_, ngt_) const int s_##e_ = ((ngt_) / (total_)) > 1 ? ((ngt_) / (total_)) : 1; \
    for (int e_ = ((gt_) % s_##e_ == 0) ? (gt_) / s_##e_ : (total_); e_ < (total_); e_ += ((ngt_) + s_##e_ - 1) / s_##e_)
#define RLX_AGENT __ATOMIC_RELAXED, __HIP_MEMORY_SCOPE_AGENT
#define LDS_WAIT() asm volatile("s_waitcnt lgkmcnt(0)" ::: "memory")
#define VM_WAIT() asm volatile("s_waitcnt vmcnt(0)" ::: "memory")
__device__ __forceinline__ float bf2f(unsigned b) { return __uint_as_float(b << 16); }
__device__ __forceinline__ unsigned pk2(float lo, float hi) { unsigned r; asm("v_cvt_pk_bf16_f32 %0, %1, %2" : "=v"(r) : "v"(lo), "v"(hi)); return r; }
__device__ __forceinline__ float fexp(float x) { return __builtin_amdgcn_exp2f(x * 1.4426950408889634f); }
__device__ __forceinline__ float frcp(float x) { return __builtin_amdgcn_rcpf(x); }
__device__ __forceinline__ float sigmoidf_(float x) { return frcp(1.0f + fexp(-x)); }
__device__ __forceinline__ float siluf_(float x) { return x * sigmoidf_(x); }
__device__ __forceinline__ float wave_sum(float v) {
#pragma unroll
    for (int o = 1; o < 64; o <<= 1) v += __shfl_xor(v, o);
    return v;
}
__device__ __forceinline__ int wave_sum_i_dpp(int v) {
    v += __builtin_amdgcn_update_dpp(0, v, 0xB1, 0xF, 0xF, false);
    v += __builtin_amdgcn_update_dpp(0, v, 0x4E, 0xF, 0xF, false);
    v += __builtin_amdgcn_update_dpp(0, v, 0x124, 0xF, 0xF, false);
    v += __builtin_amdgcn_update_dpp(0, v, 0x128, 0xF, 0xF, false);
    return __builtin_amdgcn_readlane(v, 0) + __builtin_amdgcn_readlane(v, 16) + __builtin_amdgcn_readlane(v, 32) + __builtin_amdgcn_readlane(v, 48);
}
__device__ __forceinline__ int wave_sum_i(int v) {
#pragma unroll
    for (int o = 1; o < 64; o <<= 1) v += __shfl_xor(v, o);
    return v;
}

#define XB_TMO      128
#define XB_XCNT(j)  (256  + 64 * (j))
#define XB_XSUB(j)  (1280 + 64 * (j))
#define XB_XGEN(j)  (2304 + 64 * (j))
#define XB_TOP      3328
#define XB_TOPGEN   3392
#define XCD_BAR_WORDS 3456
#define XB_SPIN_CAP (1u << 18)
__device__ __forceinline__ unsigned xb_ld(unsigned* p)              { return __hip_atomic_load(p, __ATOMIC_RELAXED, __HIP_MEMORY_SCOPE_AGENT); }
__device__ __forceinline__ unsigned xb_add(unsigned* p, unsigned v) { return __hip_atomic_fetch_add(p, v, __ATOMIC_RELAXED, __HIP_MEMORY_SCOPE_AGENT); }
__device__ __forceinline__ unsigned xb_xcc_id() { return (unsigned)__builtin_amdgcn_s_getreg((3 << 11) | 20) & 0xFu; }
#define XB_SPIN(cond, bar) do { unsigned _sp = 0; while (cond) { __builtin_amdgcn_s_sleep(1); \
    if ((++_sp & 255u) == 0u) { if (xb_ld(&(bar)[XB_TMO])) break; if (_sp > XB_SPIN_CAP) { atomicAdd(&(bar)[XB_TMO], 1u); break; } } } } while (0)
struct XcdBarrier { unsigned* bar; unsigned x; volatile LAS unsigned* st; };
__device__ __forceinline__ XcdBarrier xcd_barrier_post(unsigned* bar, volatile LAS unsigned* st) {
    XcdBarrier b; b.bar = bar; b.x = xb_xcc_id(); b.st = st;
    if (threadIdx.x == 0) (void)xb_add(&bar[XB_XCNT(b.x)], 1u);
    return b;
}
__device__ __forceinline__ void xcd_barrier_complete(unsigned* bar, unsigned x, unsigned& nloc, unsigned& nx) {
    const unsigned G = gridDim.x * gridDim.y * gridDim.z;
    unsigned sum, cnt, mine, sp = 0u;
    for (;;) {
        sum = 0u; cnt = 0u; mine = 0u;
#pragma unroll
        for (unsigned j = 0; j < 16; ++j) { const unsigned c = xb_ld(&bar[XB_XCNT(j)]); sum += c; cnt += (c > 0u) ? 1u : 0u; mine = (j == x) ? c : mine; }
        if (sum == G) break;
        __builtin_amdgcn_s_sleep(1);
        if ((++sp & 255u) == 0u) { if (xb_ld(&bar[XB_TMO])) break; if (sp > XB_SPIN_CAP) { atomicAdd(&bar[XB_TMO], 1u); break; } }
    }
    nloc = mine > 0u ? mine : 1u; nx = cnt > 0u ? cnt : 1u;
}
__device__ __forceinline__ void xcd_barrier(const XcdBarrier& b) {
    asm volatile("s_waitcnt vmcnt(0)" ::: "memory");
    __syncthreads();
    if (threadIdx.x == 0) {
        unsigned* bar = b.bar;
        __builtin_amdgcn_s_waitcnt(0);
        unsigned nloc = b.st[0], nx = b.st[1];
        if (nloc == 0u) { xcd_barrier_complete(bar, b.x, nloc, nx); b.st[0] = nloc; b.st[1] = nx; }
        const unsigned old = xb_add(&bar[XB_XSUB(b.x)], 1u);
        const unsigned gen = old / nloc;
        if (old + 1u == (gen + 1u) * nloc) {
            __builtin_amdgcn_fence(__ATOMIC_RELEASE, "agent");
            asm volatile("s_waitcnt vmcnt(0)" ::: "memory");
            const unsigned og = xb_add(&bar[XB_TOP], 1u);
            const unsigned tg = og / nx;
            if (og + 1u == (tg + 1u) * nx) xb_add(&bar[XB_TOPGEN], 1u);
            else XB_SPIN(xb_ld(&bar[XB_TOPGEN]) == tg, bar);
            __builtin_amdgcn_fence(__ATOMIC_ACQUIRE, "agent");
            asm volatile("s_waitcnt vmcnt(0)" ::: "memory");
        } else {
            XB_SPIN(xb_ld(&bar[XB_TOPGEN]) == gen, bar);
            __builtin_amdgcn_fence(__ATOMIC_ACQUIRE, "agent");
            asm volatile("s_waitcnt vmcnt(0)" ::: "memory");
        }
    }
    __syncthreads();
}

namespace pg8 {
constexpr int BM = 256, BK = 64, HALF = 128, HTB = HALF * BK * 2, NXCD = 8, WGM = 8;
__host__ __device__ __forceinline__ int lds_byte(int r, int c) { const int st = (r >> 4) * 2 + (c >> 5), rr = r & 15, cc = c & 31, ob = rr * 64 + cc * 2; return st * 1024 + (ob ^ (((ob >> 9) & 1) << 5)); }
__host__ __device__ __forceinline__ void stage_rc(int b, int& R, int& C) { const int st = b / 1024, sb = b % 1024, swz = sb ^ (((sb >> 9) & 1) << 5); R = (st >> 1) * 16 + swz / 64; C = (st & 1) * 32 + (swz % 64) / 2; }
__host__ __device__ __forceinline__ int perm32(int rho) { const int n = rho >> 4, i = rho & 15; return 8 * (i >> 2) + 4 * n + (i & 3); }

__device__ __forceinline__ bool static_tile(int L, int nM, int nN, int& pm, int& pn) {
    const int nwg = nM * nN; if (L >= nwg) return false;
    int wgid = L; { const int q = nwg / NXCD, r = nwg % NXCD, xcd = wgid % NXCD, off = wgid / NXCD; wgid = (xcd < r ? xcd * (q + 1) : r * (q + 1) + (xcd - r) * q) + off; }
    const int nig = WGM * nN, gid = wgid / nig, fm = gid * WGM, gsz = (nM - fm) < WGM ? (nM - fm) : WGM;
    pm = fm + ((wgid % nig) % gsz); pn = (wgid % nig) / gsz; return true;
}

template <class P>
__device__ __forceinline__ void gemm_phase(LAS unsigned char* lds, P& prob) {
    typedef typename P::U Unit;
    const int tid = threadIdx.x, wid = __builtin_amdgcn_readfirstlane(tid >> 6), lane = tid & 63, wr = wid >> 2, wc = wid & 3, fr = lane & 15, fq = lane >> 4;
    const int K = prob.K, nt = K / BK;
    unsigned voffB[2]; int stR[2], stC[2];
#pragma unroll
    for (int i = 0; i < 2; ++i) { int R, C; stage_rc(tid * 16 + i * 8192, R, C); stR[i] = R; stC[i] = C; const int Rb = P::PERM ? ((R & ~31) + perm32(R & 31)) : R; voffB[i] = (unsigned)(Rb * K + C) * 2u; }
    const size_t kstep = (size_t)(BK * 2);
    const size_t hstep = (size_t)HALF * K * 2;
    const unsigned ldsw = (unsigned)wid * 1024u;
    const int aoff = lds_byte(wr * 64 + fr, fq * 8), boff = lds_byte(wc * 32 + fr, fq * 8);
#define PG8_SA(b, h) (((b) * 2 + (h)) * HTB)
#define PG8_SB(b, h) ((4 + (b) * 2 + (h)) * HTB)
#define PG8_STAGE2(bufoff, gbase, o0, o1) do { \
        __builtin_amdgcn_global_load_lds((const unsigned*)((const char*)(gbase) + (o0)), (LAS unsigned*)(lds + (bufoff) + ldsw), 16, 0, 0); \
        __builtin_amdgcn_global_load_lds((const unsigned*)((const char*)(gbase) + (o1)), (LAS unsigned*)(lds + (bufoff) + ldsw + 8192), 16, 0, 0); } while (0)
#define PG8_STAGE_B(bufoff, gbase, h) PG8_STAGE2(bufoff, (gbase) + (h) * hstep, voffB[0], voffB[1])
#define PG8_LDA(dst, b, h) do { _Pragma("unroll") for (int m = 0; m < 4; ++m) _Pragma("unroll") for (int k = 0; k < 2; ++k) dst[m][k] = *(const LAS bf16x8*)(lds + PG8_SA(b, h) + aoff + m * 2048 + k * 1024); } while (0)
#define PG8_LDB(dst, b, h) do { _Pragma("unroll") for (int n = 0; n < 2; ++n) _Pragma("unroll") for (int k = 0; k < 2; ++k) dst[n][k] = *(const LAS bf16x8*)(lds + PG8_SB(b, h) + boff + n * 2048 + k * 1024); } while (0)
#define PG8_MMA(ai, bj, At, Bt) do { __builtin_amdgcn_s_setprio(1); _Pragma("unroll") for (int m = 0; m < 4; ++m) _Pragma("unroll") for (int n = 0; n < 2; ++n) _Pragma("unroll") for (int k = 0; k < 2; ++k) \
        acc[ai][bj][m][n] = __builtin_amdgcn_mfma_f32_16x16x32_bf16(Bt[n][k], At[m][k], acc[ai][bj][m][n], 0, 0, 0); __builtin_amdgcn_s_setprio(0); } while (0)
#define PG8_WAIT_V(n) asm volatile("s_waitcnt vmcnt(" #n ")" ::: "memory")
#define PG8_WAIT_L(n) asm volatile("s_waitcnt lgkmcnt(" #n ")" ::: "memory")
#define PG8_BAR __builtin_amdgcn_s_barrier()
#define PG8_SCHED __builtin_amdgcn_sched_barrier(0)
    Unit cur, nxt; int ui = 0;
    if (!prob.next(0, cur)) return;
    f32x4 acc[2][2][4][2];
#pragma unroll
    for (int a = 0; a < 2; ++a)
#pragma unroll
        for (int b = 0; b < 2; ++b)
#pragma unroll
            for (int m = 0; m < 4; ++m)
#pragma unroll
                for (int n = 0; n < 2; ++n) acc[a][b][m][n] = (f32x4){0.f, 0.f, 0.f, 0.f};
    bf16x8 At[4][2], B0[2][2], B1[2][2];
    const char* cA; const char* cB; unsigned vc[2][2], vn[2][2];
    prob.ready(cur, wid == 0); __syncthreads();
    prob.bases(cur, cA, cB); prob.lane_offs(cur, stR, stC, vc);
    PG8_STAGE_B(PG8_SB(0, 0), cB, 0); PG8_STAGE_B(PG8_SB(0, 1), cB, 1); PG8_STAGE2(PG8_SA(0, 0), cA, vc[0][0], vc[0][1]); PG8_STAGE2(PG8_SA(0, 1), cA, vc[1][0], vc[1][1]);
    if (wr == 1) PG8_BAR;
    PG8_WAIT_V(2); PG8_BAR;
    PG8_STAGE_B(PG8_SB(1, 0), cB + kstep, 0); PG8_STAGE2(PG8_SA(1, 0), cA + kstep, vc[0][0], vc[0][1]); PG8_STAGE_B(PG8_SB(1, 1), cB + kstep, 1);
    PG8_WAIT_V(6); PG8_BAR;
    for (;;) {
        const bool has_next = prob.next(ui + 1, nxt);
        const char* nA = cA; const char* nB = cB;
#pragma unroll
        for (int h = 0; h < 2; ++h) { vn[h][0] = vc[h][0]; vn[h][1] = vc[h][1]; }
        if (has_next) { prob.bases(nxt, nA, nB); prob.lane_offs(nxt, stR, stC, vn); }
        for (int t = 0; t < nt; t += 2) {
            const bool last = (t == nt - 2);
            if (last && has_next) prob.ready(nxt, wid == 0);
            const char* a1 = cA + (size_t)(t + 1) * kstep;
            const char* a2 = last ? nA : cA + (size_t)(t + 2) * kstep; const char* b2 = last ? nB : cB + (size_t)(t + 2) * kstep;
            const char* a3 = a2 + kstep; const char* b3 = b2 + kstep;
            const unsigned v00 = last ? vn[0][0] : vc[0][0], v01 = last ? vn[0][1] : vc[0][1], v10 = last ? vn[1][0] : vc[1][0], v11 = last ? vn[1][1] : vc[1][1];
            PG8_LDB(B0, 0, 0); PG8_LDB(B1, 0, 1); PG8_SCHED; PG8_LDA(At, 0, 0); PG8_STAGE2(PG8_SA(1, 1), a1, vc[1][0], vc[1][1]);
            PG8_WAIT_V(8); PG8_WAIT_L(0); PG8_BAR; PG8_MMA(0, 0, At, B0); PG8_MMA(0, 1, At, B1); PG8_BAR; PG8_SCHED;
            PG8_LDA(At, 0, 1); PG8_STAGE_B(PG8_SB(0, 0), b2, 0); PG8_STAGE_B(PG8_SB(0, 1), b2, 1); PG8_STAGE2(PG8_SA(0, 0), a2, v00, v01);
            PG8_WAIT_V(8); PG8_WAIT_L(0); PG8_BAR; PG8_MMA(1, 0, At, B0); PG8_MMA(1, 1, At, B1); PG8_BAR; PG8_SCHED;
            PG8_LDB(B0, 1, 0); PG8_LDB(B1, 1, 1); PG8_SCHED; PG8_LDA(At, 1, 0); PG8_STAGE2(PG8_SA(0, 1), a2, v10, v11);
            PG8_WAIT_V(8); PG8_WAIT_L(0); PG8_BAR; PG8_MMA(0, 0, At, B0); PG8_MMA(0, 1, At, B1); PG8_BAR; PG8_SCHED;
            PG8_LDA(At, 1, 1); PG8_STAGE_B(PG8_SB(1, 0), b3, 0); PG8_STAGE_B(PG8_SB(1, 1), b3, 1); PG8_STAGE2(PG8_SA(1, 0), a3, v00, v01);
            PG8_WAIT_V(8); PG8_WAIT_L(0); PG8_BAR; PG8_MMA(1, 0, At, B0); PG8_MMA(1, 1, At, B1); PG8_BAR; PG8_SCHED;
        }
        if (wr == 0) PG8_BAR;
        prob.epi(acc, cur, wr, wc, fr, fq);
        if (!has_next) break;
        if (!prob.keep(cur)) {
#pragma unroll
            for (int a = 0; a < 2; ++a)
#pragma unroll
                for (int b = 0; b < 2; ++b)
#pragma unroll
                    for (int m = 0; m < 4; ++m)
#pragma unroll
                        for (int n = 0; n < 2; ++n) acc[a][b][m][n] = (f32x4){0.f, 0.f, 0.f, 0.f};
        }
        cur = nxt; cA = nA; cB = nB; ++ui;
#pragma unroll
        for (int h = 0; h < 2; ++h) { vc[h][0] = vn[h][0]; vc[h][1] = vn[h][1]; }
        if (wr == 1) PG8_BAR;
    }
    PG8_WAIT_V(0);
    PG8_BAR;
#undef PG8_SA
#undef PG8_SB
#undef PG8_STAGE2
#undef PG8_STAGE_B
#undef PG8_LDA
#undef PG8_LDB
#undef PG8_MMA
#undef PG8_WAIT_V
#undef PG8_WAIT_L
#undef PG8_BAR
#undef PG8_SCHED
}
}

struct Frame {
    LAS unsigned char* lds;
    unsigned* ctl;
    unsigned char* ws;
    int tid, lane, wave, G, bid;
    const float *x, *c, *w_ada, *b_ada, *g_norm1, *w_in, *g_head, *hglb, *w_attn_up, *w_hgrn_up, *w_out, *g_norm2, *w_rg, *b_rg, *w_re, *b_re, *w_eg, *w_eu, *w_ed, *g_final;
    const int* positions;
    float* out;
};
#define WSP(T, off) ((T*)(F.ws + (off)))

__device__ __forceinline__ int win_phys(int n) {
    if (n < 1280) { const int head = n >> 7, j = n & 127; return head * 128 + (j < 64 ? 2 * j : 2 * (j - 64) + 1); }
    if (n < 1536) return n;
    if (n < 2048) { const int q = n - 1536, head = q >> 6, j = q & 63; return 1536 + head * 64 + (j < 32 ? 2 * j : 2 * (j - 32) + 1); }
    if (n < 2120) return -1;
    return n - 2120 + 2048;
}
struct RmWin { __device__ __forceinline__ int operator()(int n) const { return win_phys(n); } };
struct RmId  { __device__ __forceinline__ int operator()(int n) const { return n; } };
struct RmGate { int up; __device__ __forceinline__ int operator()(int f) const { return 8 * (f >> 2) + 4 * up + (f & 3); } };
template <class RM>
__device__ __forceinline__ void transpose_item(const float* W, int K, int N, bf16_t* WT, LAS float* scr, int item, int lane, RM rm) {
    const int nblk = (N + 31) / 32, kb = item / nblk, nb = item % nblk, k0 = 64 * kb, n0 = 32 * nb;
    const int nn = n0 + (lane & 31);
    float tv[32];
#pragma unroll
    for (int i = 0; i < 32; ++i) { const int kk = 2 * i + (lane >> 5); tv[i] = (nn < N) ? W[(size_t)(k0 + kk) * N + nn] : 0.f; }
#pragma unroll
    for (int i = 0; i < 32; ++i) { const int kk = 2 * i + (lane >> 5); scr[kk * 33 + (lane & 31)] = tv[i]; }
    LDS_WAIT(); asm volatile("" ::: "memory");
    const int c = lane & 7;
#pragma unroll
    for (int j = 0; j < 4; ++j) { const int n = (lane >> 3) + 8 * j; const LAS float* s = scr + (8 * c) * 33 + n;
        u32x4 o; o.x = pk2(s[0 * 33], s[1 * 33]); o.y = pk2(s[2 * 33], s[3 * 33]); o.z = pk2(s[4 * 33], s[5 * 33]); o.w = pk2(s[6 * 33], s[7 * 33]);
        if (n0 + n < N) { const int rr = rm(n0 + n); if (rr >= 0) *(u32x4*)(WT + (size_t)rr * K + k0 + 8 * c) = o; } }
    LDS_WAIT(); asm volatile("" ::: "memory");
}

struct TDesc { const float* W; bf16_t* WT; int K, N, kind, item; };
__device__ __forceinline__ int td_row(int kind, int n) { return kind == 0 ? n : kind == 1 ? win_phys(n) : (8 * (n >> 2) + 4 * (kind - 2) + (n & 3)); }
__device__ __forceinline__ void td_load(const TDesc& d, int lane, float (&tv)[32]) {
    const int nblk = (d.N + 31) / 32, kb = d.item / nblk, nb = d.item % nblk, k0 = 64 * kb, n0 = 32 * nb;
    int nn = n0 + (lane & 31); nn = nn < d.N ? nn : d.N - 1;
    const float* p = d.W + (size_t)(k0 + (lane >> 5)) * d.N + nn;
#pragma unroll
    for (int i = 0; i < 32; ++i) tv[i] = __builtin_nontemporal_load(p + (size_t)(2 * i) * d.N);
}
__device__ __forceinline__ void td_lds(const float (&tv)[32], int lane, LAS float* scr) {
#pragma unroll
    for (int i = 0; i < 32; ++i) { const int kk = 2 * i + (lane >> 5); scr[kk * 33 + (lane & 31)] = tv[i]; }
}
__device__ __forceinline__ void td_store(const TDesc& d, int lane, LAS float* scr) {
    const int nblk = (d.N + 31) / 32, kb = d.item / nblk, nb = d.item % nblk, k0 = 64 * kb, n0 = 32 * nb;
    const int c = lane & 7;
#pragma unroll
    for (int j = 0; j < 4; ++j) { const int n = (lane >> 3) + 8 * j; const LAS float* sp = scr + (8 * c) * 33 + n;
        u32x4 o; o.x = pk2(sp[0 * 33], sp[1 * 33]); o.y = pk2(sp[2 * 33], sp[3 * 33]); o.z = pk2(sp[4 * 33], sp[5 * 33]); o.w = pk2(sp[6 * 33], sp[7 * 33]);
        if (n0 + n < d.N) { const int rr = td_row(d.kind, n0 + n); if (rr >= 0) *(u32x4*)(d.WT + (size_t)rr * d.K + k0 + 8 * c) = o; } }
}
#define TD_STREAM(it0_, stride_, total_, DESC, lane_, scr_) do { float tv_[32]; TDesc dc_, dn_; int it_ = (it0_); \
    if (it_ < (total_)) { DESC(it_, dc_); td_load(dc_, (lane_), tv_); } \
    for (; it_ < (total_); it_ += (stride_)) { td_lds(tv_, (lane_), (scr_)); __builtin_amdgcn_sched_barrier(0); \
        const bool hn_ = it_ + (stride_) < (total_); if (hn_) { DESC(it_ + (stride_), dn_); td_load(dn_, (lane_), tv_); } \
        LDS_WAIT(); asm volatile("" ::: "memory"); td_store(dc_, (lane_), (scr_)); LDS_WAIT(); asm volatile("" ::: "memory"); if (hn_) dc_ = dn_; } } while (0)

#define TD_STREAM2(it0_, stride_, total_, DESC, lane_, scr_) do { float ta_[32], tb_[32]; TDesc da_, db_, dc_; int it_ = (it0_); const int st_ = (stride_), tl_ = (total_) - 1; \
    { const int i0_ = min(it_, tl_), i1_ = min(it_ + st_, tl_); DESC(i0_, da_); td_load(da_, (lane_), ta_); DESC(i1_, db_); td_load(db_, (lane_), tb_); } \
    for (; it_ <= tl_; it_ += 2 * st_) { \
        td_lds(ta_, (lane_), (scr_)); __builtin_amdgcn_sched_barrier(0); dc_ = da_; \
        { const int i2_ = min(it_ + 2 * st_, tl_); DESC(i2_, da_); td_load(da_, (lane_), ta_); } \
        LDS_WAIT(); asm volatile("" ::: "memory"); td_store(dc_, (lane_), (scr_)); LDS_WAIT(); asm volatile("" ::: "memory"); \
        td_lds(tb_, (lane_), (scr_)); __builtin_amdgcn_sched_barrier(0); dc_ = db_; \
        { const int i3_ = min(it_ + 3 * st_, tl_); DESC(i3_, db_); td_load(db_, (lane_), tb_); } \
        LDS_WAIT(); asm volatile("" ::: "memory"); if (it_ + st_ <= tl_) td_store(dc_, (lane_), (scr_)); LDS_WAIT(); asm volatile("" ::: "memory"); } } while (0)

__device__ __forceinline__ void p0_prologue(Frame& F) {
    const int gw = F.bid * NWAVES + F.wave, NGW = F.G * NWAVES;
    {
        LAS float* red = (LAS float*)F.lds;
        float* MODP = WSP(float, WS_MODP);
        for (int task = F.bid; task < 48 * NKS; task += F.G) {
            const int cg = task % 48, ks = task / 48;
            f32x4 a0 = {0.f, 0.f, 0.f, 0.f}, a1 = {0.f, 0.f, 0.f, 0.f};
            const int kb = ks * (DM / NKS) + F.wave * (DM / NKS / 8);
#pragma unroll 1
            for (int q = 0; q < DM / NKS / 8 / 16; ++q) {
#pragma unroll 16
                for (int i = 0; i < 16; ++i) { const int k = kb + 16 * q + i; const f32x4 wv = __builtin_nontemporal_load((const f32x4*)(F.w_ada + (size_t)k * 12288 + cg * 256 + 4 * F.lane));
                    const float s0 = siluf_(F.c[k]), s1 = siluf_(F.c[DM + k]); a0 += wv * s0; a1 += wv * s1; } }
            *(LAS f32x4*)(red + (F.wave * 2 + 0) * 256 + 4 * F.lane) = a0; *(LAS f32x4*)(red + (F.wave * 2 + 1) * 256 + 4 * F.lane) = a1;
            __syncthreads();
            { const int b = F.tid >> 8, col = F.tid & 255; float s = 0.f;
#pragma unroll
              for (int w = 0; w < 8; ++w) s += red[(w * 2 + b) * 256 + col];
              MODP[((size_t)ks * 2 + b) * 12288 + cg * 256 + col] = s; }
            __syncthreads();
        }
    }
    {
        LAS float* scr = (LAS float*)(F.lds + F.wave * 16384);
        constexpr int I_IN = 32 * 323;
#define P0_DESC(it, d) do { d.W = F.w_in; d.K = DM; d.N = NLOG; d.WT = WSP(bf16_t, WS_WIN_T); d.kind = 1; d.item = (it); } while (0)
        if (F.G == 256 && 48 * NKS == 192) {
            if (F.bid < 192) TD_STREAM(gw, 1536, 6144, P0_DESC, F.lane, scr);
            else TD_STREAM(6144 + (gw - 1536), 512, I_IN, P0_DESC, F.lane, scr);
        } else TD_STREAM(gw, NGW, I_IN, P0_DESC, F.lane, scr);
#undef P0_DESC
        { bf16_t* W40 = WSP(bf16_t, WS_W40T); const int gt = F.bid * NTHREADS + F.tid, NGT = F.G * NTHREADS;
          SPREAD_FOR(e, 96 * 256, gt, NGT) { const int n = e >> 8, k0 = (e & 255) * 8; u32x4 o = {0u, 0u, 0u, 0u};
              if (n < 72) { const int col = (n < 64) ? (2048 + (n >> 1) + 32 * (n & 1)) : (2112 + (n - 64)); const float* p = F.w_in + (size_t)k0 * NLOG + col;
                  o.x = pk2(p[0], p[NLOG]); o.y = pk2(p[2 * (size_t)NLOG], p[3 * (size_t)NLOG]); o.z = pk2(p[4 * (size_t)NLOG], p[5 * (size_t)NLOG]); o.w = pk2(p[6 * (size_t)NLOG], p[7 * (size_t)NLOG]); }
              *(u32x4*)(W40 + (size_t)n * DM + k0) = o; } }
    }
    {
        u32x4* WRH = WSP(u32x4, WS_WRF); u32x4* WRL = WRH + 64 * 3 * 64;
        const int gt = F.bid * NTHREADS + F.tid, NGT = F.G * NTHREADS;
        SPREAD_FOR(e, 64 * 3 * 64, gt, NGT) { const int ln = e & 63, t = (e >> 6) % 3, sg = e / 192, n = 16 * t + (ln & 15), kq = ln >> 4;
            float w[8];
#pragma unroll
            for (int j = 0; j < 8; ++j) { const int k = 32 * sg + 8 * kq + j; w[j] = n < 4 ? F.w_rg[(size_t)k * 4 + n] : n < 36 ? F.w_re[(size_t)k * 32 + (n - 4)] : 0.f; }
            unsigned hp[4], lp[4];
#pragma unroll
            for (int j = 0; j < 4; ++j) { const unsigned h_ = pk2(w[2 * j], w[2 * j + 1]); hp[j] = h_; lp[j] = pk2(w[2 * j] - bf2f(h_ & 0xffffu), w[2 * j + 1] - __uint_as_float(h_ & 0xffff0000u)); }
            const u32x4 hi = {hp[0], hp[1], hp[2], hp[3]}, lo = {lp[0], lp[1], lp[2], lp[3]};
            WRH[e] = hi; WRL[e] = lo; }
    }
    {
        f32x2* TA = WSP(f32x2, WS_TABA); f32x2* TI = WSP(f32x2, WS_TABI);
        LAS float* INV = (LAS float*)F.lds;
        __syncthreads();
        if (F.tid < 96) INV[F.tid] = (F.tid < 64) ? powf(10000.0f, -(float)(2 * F.tid) / 128.0f) : powf(10000.0f, -(float)(2 * (F.tid - 64)) / 64.0f);
        __syncthreads();
        const int gt = F.bid * NTHREADS + F.tid, NGT = F.G * NTHREADS;
        for (int e = gt; e < M * 96; e += NGT) {
            const int m = e / 96, r = e % 96; const float pos = (float)F.positions[m];
            const float ang = pos * INV[r]; float sn, cs;
            if (fabsf(ang) < 5.0e4f) {
                const float k = rintf(ang * 0.636619772f);
                float rr = fmaf(k, -1.57079601e+00f, ang); rr = fmaf(k, -3.13916473e-07f, rr); rr = fmaf(k, -5.39030253e-15f, rr);
                const float r2 = rr * rr;
                float ps = fmaf(r2, -1.9515295891e-4f, 8.3321608736e-3f); ps = fmaf(r2, ps, -1.6666654611e-1f);
                const float s_ = fmaf(r2 * rr, ps, rr);
                float pc = fmaf(r2, 2.443315711809948e-5f, -1.388731625493765e-3f); pc = fmaf(r2, pc, 4.166664568298827e-2f);
                const float c_ = fmaf(r2 * r2, pc, fmaf(r2, -0.5f, 1.0f));
                const int q = (int)k & 3;
                sn = (q == 0) ? s_ : (q == 1) ? c_ : (q == 2) ? -s_ : -c_;
                cs = (q == 0) ? c_ : (q == 1) ? -s_ : (q == 2) ? -c_ : s_;
            } else sincosf(ang, &sn, &cs);
            if (r < 64) TA[(size_t)m * 64 + r] = (f32x2){cs, sn}; else TI[(size_t)m * 32 + (r - 64)] = (f32x2){cs, sn};
        }
    }
}

__device__ __forceinline__ void p3_late_weights(Frame& F) {
    LAS float* scr = (LAS float*)(F.lds + F.wave * 16384);
    const int gw = F.bid * NWAVES + F.wave, NGW = F.G * NWAVES;
    constexpr int I_AU = 16 * 64, I_HU = 16 * 64, I_OUT = 32 * 64;
#define P3_DESC(it, d) do { int r_ = (it); \
        if (r_ < I_AU) { d.W = F.w_attn_up; d.K = 1024; d.N = DM; d.WT = WSP(bf16_t, WS_WAU_T); d.kind = 0; d.item = r_; } \
        else if ((r_ -= I_AU) < I_HU) { d.W = F.w_hgrn_up; d.K = 1024; d.N = DM; d.WT = WSP(bf16_t, WS_WHU_T); d.kind = 0; d.item = r_; } \
        else { r_ -= I_HU; d.W = F.w_out; d.K = DM; d.N = DM; d.WT = WSP(bf16_t, WS_WOUT_T); d.kind = 0; d.item = r_; } } while (0)
    TD_STREAM(NGW - 1 - gw, NGW, I_AU + I_HU + I_OUT, P3_DESC, F.lane, scr);
#undef P3_DESC
}

__device__ __forceinline__ float row_rstd_nt(const float* xrow, int lane, f32x4 (&v)[8]) {
    float s = 0.f;
#pragma unroll
    for (int j = 0; j < 8; ++j) { v[j] = __builtin_nontemporal_load((const f32x4*)xrow + lane + 64 * j); s += (v[j].x * v[j].x + v[j].y * v[j].y) + (v[j].z * v[j].z + v[j].w * v[j].w); }
    return 1.0f / sqrtf(wave_sum(s) * (1.0f / DM) + EPS);
}
__device__ __forceinline__ float row_rstd(const float* xrow, int lane, f32x4 (&v)[8]) {
    float s = 0.f;
#pragma unroll
    for (int j = 0; j < 8; ++j) { v[j] = ((const f32x4*)xrow)[lane + 64 * j]; s += (v[j].x * v[j].x + v[j].y * v[j].y) + (v[j].z * v[j].z + v[j].w * v[j].w); }
    return 1.0f / sqrtf(wave_sum(s) * (1.0f / DM) + EPS);
}

__device__ __forceinline__ f32x16 mfma32(bf16x8 a, bf16x8 b, f32x16 c) { return __builtin_amdgcn_mfma_f32_32x32x16_bf16(a, b, c, 0, 0, 0); }
__device__ __forceinline__ int crow(int r, int hi) { return (r & 3) + 8 * (r >> 2) + 4 * hi; }
__device__ __forceinline__ void p1_norm1(Frame& F) {
    LAS float* CA = (LAS float*)(F.lds + LDS_EXTRA); LAS float* CB = CA + DM;
    LAS unsigned char* HB = F.lds;
    const float* MODP = WSP(float, WS_MODP); float* MOD = WSP(float, WS_MOD);
    const int lane = F.lane, r32 = lane & 31, hi = lane >> 5;
    SPREAD_FOR(idx, 2 * 12288, F.bid * NTHREADS + F.tid, F.G * NTHREADS) { const int b = idx / 12288, j = idx % 12288; float s = F.b_ada[j]; float pv[NKS];
#pragma unroll
        for (int ks = 0; ks < NKS; ++ks) pv[ks] = MODP[((size_t)ks * 2 + b) * 12288 + j];
        __builtin_amdgcn_sched_barrier(0);
#pragma unroll
        for (int ks = 0; ks < NKS; ++ks) s += pv[ks];
        MOD[idx] = s; }
    for (int rb = F.bid; rb < M / 32; rb += F.G) {
        const int b = (rb * 32) / SEQ;
        __syncthreads();
#pragma unroll
        for (int kk = 0; kk < DM / NTHREADS; ++kk) { __builtin_amdgcn_sched_barrier(0); const int k = F.tid + kk * NTHREADS; float sh = F.b_ada[k], sc = F.b_ada[DM + k]; const float gn = F.g_norm1[k]; float p0[16], p1[16];
#pragma unroll
            for (int ks = 0; ks < NKS; ++ks) { p0[ks] = MODP[((size_t)ks * 2 + b) * 12288 + k]; p1[ks] = MODP[((size_t)ks * 2 + b) * 12288 + DM + k]; }
            __builtin_amdgcn_sched_barrier(0);
#pragma unroll
            for (int ks = 0; ks < NKS; ++ks) { sh += p0[ks]; sc += p1[ks]; }
            CA[k] = gn * (1.0f + sc); CB[k] = sh; }
        __syncthreads();
        bf16_t* XN = WSP(bf16_t, WS_XN);
#pragma unroll 1
        for (int r = 0; r < 4; ++r) { const int rl = F.wave * 4 + r, m = rb * 32 + rl; f32x4 v[8]; const float rs = row_rstd_nt(F.x + (size_t)m * DM, lane, v);
#pragma unroll
            for (int j = 0; j < 8; ++j) { const int k = 4 * (lane + 64 * j); const f32x4 a = *(const LAS f32x4*)(CA + k), bb = *(const LAS f32x4*)(CB + k);
                const f32x4 h = v[j] * rs * a + bb; u32x2 o; o.x = pk2(h.x, h.y); o.y = pk2(h.z, h.w); *(u32x2*)(XN + (size_t)m * DM + k) = o; *(LAS u32x2*)(HB + rl * 4112 + k * 2) = o; } }
        __syncthreads();
        f32x16 acc[3]; acc[0] = f32x16{}; acc[1] = f32x16{}; acc[2] = f32x16{};
        { const bf16_t* W40 = WSP(bf16_t, WS_W40T) + (size_t)r32 * DM + 256 * F.wave + 8 * hi;
#pragma unroll
          for (int kb = 0; kb < 8; ++kb) { bf16x8 bq[2][3];
#pragma unroll
              for (int ks = 0; ks < 2; ++ks)
#pragma unroll
                  for (int nt = 0; nt < 3; ++nt) bq[ks][nt] = *(const bf16x8*)(W40 + (size_t)nt * 32 * DM + 16 * (2 * kb + ks));
              __builtin_amdgcn_sched_barrier(0);
#pragma unroll
              for (int ks = 0; ks < 2; ++ks) { const bf16x8 a = *(const LAS bf16x8*)(HB + r32 * 4112 + (256 * F.wave + 16 * (2 * kb + ks) + 8 * hi) * 2);
#pragma unroll
                  for (int nt = 0; nt < 3; ++nt) acc[nt] = mfma32(a, bq[ks][nt], acc[nt]); }
              __builtin_amdgcn_sched_barrier(0); } }
        __syncthreads();
        LAS float* PS = (LAS float*)HB;
#pragma unroll
        for (int nt = 0; nt < 3; ++nt)
#pragma unroll
            for (int r = 0; r < 16; ++r) PS[(F.wave * 96 + nt * 32 + r32) * 33 + crow(r, hi)] = acc[nt][r];
        __syncthreads();
        { bf16_t* IK = WSP(bf16_t, WS_IK); float* IW = WSP(float, WS_IW); const f32x2* TI = WSP(f32x2, WS_TABI);
          int tv = F.tid; asm volatile("" : "+v"(tv));
#pragma unroll
          for (int j = 0; j < 2; ++j) { const int idx = tv + 512 * j, row = idx >> 5, i = idx & 31; float x1 = 0.f, x2 = 0.f;
#pragma unroll
              for (int w = 0; w < 8; ++w) { x1 += PS[(w * 96 + 2 * i) * 33 + row]; x2 += PS[(w * 96 + 2 * i + 1) * 33 + row]; }
              const int m = rb * 32 + row; const f32x2 cs = TI[(size_t)m * 32 + i];
              *(unsigned*)(IK + (size_t)m * 64 + 2 * i) = pk2(x1 * cs.x - x2 * cs.y, x2 * cs.x + x1 * cs.y); }
          if (F.tid < 256) { const int row = F.tid >> 3, hh = F.tid & 7; float v = 0.f;
#pragma unroll
              for (int w = 0; w < 8; ++w) v += PS[(w * 96 + 64 + hh) * 33 + row];
              IW[(size_t)(rb * 32 + row) * 8 + hh] = v * IDX_SCALE; } }
    }
}

struct UnitT { int pm, pn, aux; };
struct ProbBase {
    typedef UnitT U;
    int K, G, c;
    __device__ __forceinline__ void lane_offs_plain(const int (&stR)[2], const int (&stC)[2], unsigned (&va)[2][2]) const {
#pragma unroll
        for (int h = 0; h < 2; ++h)
#pragma unroll
            for (int i = 0; i < 2; ++i) va[h][i] = (unsigned)((h * 128 + stR[i]) * K + stC[i]) * 2u;
    }
    __device__ __forceinline__ bool keep(const U&) const { return false; }
    __device__ __forceinline__ void ready(const U&, bool) const {}
};

struct ProbWin : ProbBase {
    static constexpr bool PERM = true;
    const char* A; const char* B; unsigned char* ws; const float* hglb;
    __device__ __forceinline__ bool next(int i, U& u) const { u.aux = 0; return pg8::static_tile(i * G + c, M / 256, NPHYS / 256, u.pm, u.pn); }
    __device__ __forceinline__ void bases(const U& u, const char*& a, const char*& b) const { a = A + (size_t)u.pm * 256 * K * 2; b = B + (size_t)u.pn * 256 * K * 2; }
    __device__ __forceinline__ void lane_offs(const U&, const int (&stR)[2], const int (&stC)[2], unsigned (&va)[2][2]) const { lane_offs_plain(stR, stC, va); }
    __device__ __forceinline__ void epi(f32x4 (&acc)[2][2][4][2], const U& u, int wr, int wc, int fr, int fq) const {
        const int pn = u.pn, row0 = u.pm * 256 + wr * 64 + fr, colw = wc * 32 + 8 * fq;
        if (pn <= 4 || pn == 6 || pn == 7 || pn == 40) {
            const bool d128 = (pn <= 4);
            const float* tab = d128 ? (const float*)(ws + WS_TABA) : (const float*)(ws + WS_TABI);
            const int tp = d128 ? 128 : 64;
            const int i0 = d128 ? (colw >> 1) : (((wc & 1) * 32 + 8 * fq) >> 1);
            bf16_t* O; int pitch, cb; float sc = 1.f;
            if (pn < 4) { O = (bf16_t*)(ws + WS_AQ); pitch = 1024; cb = pn * 256; sc = ATT_SCALE_L2E; }
            else if (pn == 4) { O = (bf16_t*)(ws + WS_AK); pitch = 256; cb = 0; }
            else if (pn < 8) { O = (bf16_t*)(ws + WS_IQ); pitch = 512; cb = (pn - 6) * 256; }
            else { O = (bf16_t*)(ws + WS_IK); pitch = 64; cb = 0; }
            f32x4 tt0[8], tt1[8];
#pragma unroll
            for (int ai = 0; ai < 2; ++ai)
#pragma unroll
                for (int m = 0; m < 4; ++m) { const int row = row0 + ai * 128 + m * 16; tt0[ai * 4 + m] = *(const f32x4*)(tab + (size_t)row * tp + 2 * i0); tt1[ai * 4 + m] = *(const f32x4*)(tab + (size_t)row * tp + 2 * i0 + 4); }
            __builtin_amdgcn_sched_barrier(0);
#pragma unroll
            for (int ai = 0; ai < 2; ++ai)
#pragma unroll
                for (int m = 0; m < 4; ++m) { const int row = row0 + ai * 128 + m * 16;
                    const f32x4 t0 = tt0[ai * 4 + m], t1 = tt1[ai * 4 + m];
#pragma unroll
                    for (int bj = 0; bj < 2; ++bj) {
                        if (pn == 40 && (bj == 1 || wc >= 2)) {
                            if (bj == 0 && wc == 2 && fq == 0) { float* IW = (float*)(ws + WS_IW);
                                *(f32x4*)(IW + (size_t)row * 8) = acc[ai][0][m][0] * IDX_SCALE; *(f32x4*)(IW + (size_t)row * 8 + 4) = acc[ai][0][m][1] * IDX_SCALE; }
                            continue; }
                        const f32x4 v0 = acc[ai][bj][m][0], v1 = acc[ai][bj][m][1];
                        const float o0 = v0[0] * t0[0] - v0[1] * t0[1], o1 = v0[1] * t0[0] + v0[0] * t0[1], o2 = v0[2] * t0[2] - v0[3] * t0[3], o3 = v0[3] * t0[2] + v0[2] * t0[3];
                        const float o4 = v1[0] * t1[0] - v1[1] * t1[1], o5 = v1[1] * t1[0] + v1[0] * t1[1], o6 = v1[2] * t1[2] - v1[3] * t1[3], o7 = v1[3] * t1[2] + v1[2] * t1[3];
                        u32x4 w; w.x = pk2(o0 * sc, o1 * sc); w.y = pk2(o2 * sc, o3 * sc); w.z = pk2(o4 * sc, o5 * sc); w.w = pk2(o6 * sc, o7 * sc);
                        *(u32x4*)(O + (size_t)row * pitch + cb + bj * 128 + colw) = w; } }
        } else if (pn == 5) {
            bf16_t* O = (bf16_t*)(ws + WS_AVT);
#pragma unroll
            for (int ai = 0; ai < 2; ++ai)
#pragma unroll
                for (int m = 0; m < 4; ++m) { const int row = row0 + ai * 128 + m * 16, b = row >> 12, s = row & 4095;
#pragma unroll
                    for (int bj = 0; bj < 2; ++bj)
#pragma unroll
                        for (int n = 0; n < 2; ++n)
#pragma unroll
                            for (int e = 0; e < 4; ++e) { const int d = colw + 4 * n + e; O[((size_t)((b * 2 + bj) * 128 + d)) * SEQ + s] = (bf16_t)(pk2(acc[ai][bj][m][n][e], 0.f) & 0xffffu); } }
        } else if (pn >= 12 && pn < 16) {
            float* LF = (float*)(ws + WS_LOGF);
            const int cb = (pn - 12) * 256;
            f32x4 lb[2][2];
#pragma unroll
            for (int bj = 0; bj < 2; ++bj)
#pragma unroll
                for (int n = 0; n < 2; ++n) { const int cc = cb + bj * 128 + colw + 4 * n; const f32x4 a0 = *(const f32x4*)(hglb + cc), a1 = *(const f32x4*)(hglb + 1024 + cc);
#pragma unroll
                    for (int e = 0; e < 4; ++e) lb[bj][n][e] = frcp(1.0f + fexp(a1[e] - a0[e])); }
#pragma unroll
            for (int ai = 0; ai < 2; ++ai)
#pragma unroll
                for (int m = 0; m < 4; ++m) { const int row = row0 + ai * 128 + m * 16;
#pragma unroll
                    for (int bj = 0; bj < 2; ++bj) { f32x4 lf[2];
#pragma unroll
                        for (int n = 0; n < 2; ++n)
#pragma unroll
                            for (int e = 0; e < 4; ++e) { float xx = acc[ai][bj][m][n][e]; xx = fminf(fmaxf(xx, -30.f), 30.f); const float ee = fexp(-xx), sg = frcp(1.0f + ee); const float l = lb[bj][n][e];
                                const float f = l + (1.0f - l) * sg; lf[n][e] = __logf(f); }
                        const size_t off = (size_t)row * 1024 + cb + bj * 128 + colw;
                        *(f32x4*)(LF + off) = lf[0]; *(f32x4*)(LF + off + 4) = lf[1]; } }
        } else {
            bf16_t* O; int pitch, cb, act;
            if (pn < 12) { O = (bf16_t*)(ws + WS_HQ); pitch = 1024; cb = (pn - 8) * 256; act = 1; }
            else if (pn < 20) { O = (bf16_t*)(ws + WS_HI); pitch = 1024; cb = (pn - 16) * 256; act = 0; }
            else if (pn < 24) { O = (bf16_t*)(ws + WS_HOG); pitch = 1024; cb = (pn - 20) * 256; act = 1; }
            else if (pn < 32) { O = (bf16_t*)(ws + WS_GA); pitch = 2048; cb = (pn - 24) * 256; act = 2; }
            else { O = (bf16_t*)(ws + WS_GH); pitch = 2048; cb = (pn - 32) * 256; act = 2; }
#pragma unroll
            for (int ai = 0; ai < 2; ++ai)
#pragma unroll
                for (int m = 0; m < 4; ++m) { const int row = row0 + ai * 128 + m * 16;
#pragma unroll
                    for (int bj = 0; bj < 2; ++bj) { f32x4 v0 = acc[ai][bj][m][0], v1 = acc[ai][bj][m][1];
                        if (act == 1) {
#pragma unroll
                            for (int e = 0; e < 4; ++e) { v0[e] = siluf_(v0[e]); v1[e] = siluf_(v1[e]); } }
                        else if (act == 2) {
#pragma unroll
                            for (int e = 0; e < 4; ++e) { v0[e] = sigmoidf_(v0[e]); v1[e] = sigmoidf_(v1[e]); } }
                        u32x4 w; w.x = pk2(v0[0], v0[1]); w.y = pk2(v0[2], v0[3]); w.z = pk2(v1[0], v1[1]); w.w = pk2(v1[2], v1[3]);
                        *(u32x4*)(O + (size_t)row * pitch + cb + bj * 128 + colw) = w; } }
        }
    }
};

constexpr int IX_NBI = 2 * 272;
__device__ __forceinline__ void ix_decode(int I, int& b, int& ch, int& g) {
    if (I < 480) { b = I / 240; int f = I % 240; ch = 0; while (f >= 30 - 2 * ch) { f -= 30 - 2 * ch; ++ch; } g = 2 + f; }
    else { const int l = I - 480; b = l >> 5; ch = (l & 31) >> 1; g = l & 1; }
}
__device__ __forceinline__ void p3_indexer(Frame& F) {
    const bf16_t* IQ = WSP(bf16_t, WS_IQ); const bf16_t* IK = WSP(bf16_t, WS_IK); const float* IW = WSP(float, WS_IW); float* SC = WSP(float, WS_SCORES);
    const int gw = F.bid * NWAVES + F.wave, NGW = F.G * NWAVES, lane = F.lane, q = lane & 15, quad = lane >> 4;
    const int full = (IX_NBI / F.G) * F.G;
    for (int I = F.bid; I < full; I += F.G) {
        int b, ch, g; ix_decode(I, b, ch, g);
        const int qi = 16 * ch + 8 * g + F.wave;
        const int kt0 = 16 * ch, kt1 = min(16 * ch + 16, qi + 1);
        const size_t qrow = (size_t)b * SEQ + 16 * qi + q;
        bf16x8 bq[8][2];
#pragma unroll
        for (int h = 0; h < 8; ++h)
#pragma unroll
            for (int ks = 0; ks < 2; ++ks) bq[h][ks] = *(const bf16x8*)(IQ + qrow * 512 + h * 64 + 32 * ks + 8 * quad);
        const f32x4 w0 = *(const f32x4*)(IW + qrow * 8), w1 = *(const f32x4*)(IW + qrow * 8 + 4);
        const float wv[8] = {w0[0], w0[1], w0[2], w0[3], w1[0], w1[1], w1[2], w1[3]};
        f32x4 scs[16];
        bf16x8 na[4][2];
        const bf16_t* kbase = IK + ((size_t)b * SEQ + q) * 64 + 8 * quad;
        const int ntl = kt1 - kt0, rot = (F.bid * 5 + (F.bid >> 4)) % ntl;
#define IX_TILE(j_) (kt0 + (((j_) + rot) % ntl))
#pragma unroll
        for (int j = 0; j < 4; ++j) { const int kt = IX_TILE(j); na[j][0] = *(const bf16x8*)(kbase + (size_t)kt * 1024); na[j][1] = *(const bf16x8*)(kbase + (size_t)kt * 1024 + 32); }
#define IX_BODY(j) { \
                const bf16x8 a0 = na[(j) & 3][0], a1 = na[(j) & 3][1]; \
                if ((j) + 4 < 16) { const int ktn = IX_TILE((j) + 4); na[(j) & 3][0] = *(const bf16x8*)(kbase + (size_t)ktn * 1024); na[(j) & 3][1] = *(const bf16x8*)(kbase + (size_t)ktn * 1024 + 32); } \
                f32x4 dh[8]; __builtin_amdgcn_s_setprio(1); \
                _Pragma("unroll") for (int h = 0; h < 8; ++h) dh[h] = __builtin_amdgcn_mfma_f32_16x16x32_bf16(a0, bq[h][0], (f32x4){0.f, 0.f, 0.f, 0.f}, 0, 0, 0); \
                _Pragma("unroll") for (int h = 0; h < 8; ++h) dh[h] = __builtin_amdgcn_mfma_f32_16x16x32_bf16(a1, bq[h][1], dh[h], 0, 0, 0); \
                __builtin_amdgcn_s_setprio(0); \
                f32x4 sc = {0.f, 0.f, 0.f, 0.f}; \
                _Pragma("unroll") for (int h = 0; h < 8; ++h) _Pragma("unroll") for (int e = 0; e < 4; ++e) { const int bi = (int)__float_as_uint(dh[h][e]); sc[e] += wv[h] * __uint_as_float((unsigned)(bi > 0 ? bi : 0)); } \
                scs[j] = sc; }
        if (ntl == 16) {
#pragma unroll
            for (int j = 0; j < 16; ++j) IX_BODY(j)
        } else {
#pragma unroll
            for (int j = 0; j < 16; ++j) { scs[j] = (f32x4){0.f, 0.f, 0.f, 0.f}; if (j < ntl) IX_BODY(j) }
        }
#undef IX_BODY
#pragma unroll
        for (int j = 0; j < 16; ++j) { if (j < ntl) *(f32x4*)(SC + qrow * SEQ + 16 * IX_TILE(j) + 4 * quad) = scs[j]; }
#undef IX_TILE
    }
    const int remw = (IX_NBI - full) * NWAVES;
    if (remw > 0) {
        const int S = min(16, max(1, NGW / remw)), PT = (16 + S - 1) / S, li = gw / S;
        if (li < remw) {
            int b, ch, g; ix_decode(full + (li >> 3), b, ch, g);
            const int qi = 16 * ch + 8 * g + (li & 7), p0 = (gw % S) * PT;
            const int kt0 = 16 * ch + p0, kt1 = min(16 * ch + min(16, p0 + PT), qi + 1);
            if (kt0 < kt1) {
                const size_t qrow = (size_t)b * SEQ + 16 * qi + q;
                bf16x8 bq[8][2];
#pragma unroll
                for (int h = 0; h < 8; ++h)
#pragma unroll
                    for (int ks = 0; ks < 2; ++ks) bq[h][ks] = *(const bf16x8*)(IQ + qrow * 512 + h * 64 + 32 * ks + 8 * quad);
                const f32x4 w0 = *(const f32x4*)(IW + qrow * 8), w1 = *(const f32x4*)(IW + qrow * 8 + 4);
                const float wv[8] = {w0[0], w0[1], w0[2], w0[3], w1[0], w1[1], w1[2], w1[3]};
                const bf16_t* kbase = IK + ((size_t)b * SEQ + q) * 64 + 8 * quad;
#pragma unroll 1
                for (int kt = kt0; kt < kt1; ++kt) {
                    const bf16x8 a0 = *(const bf16x8*)(kbase + (size_t)kt * 1024), a1 = *(const bf16x8*)(kbase + (size_t)kt * 1024 + 32);
                    f32x4 dh[8];
#pragma unroll
                    for (int h = 0; h < 8; ++h) dh[h] = __builtin_amdgcn_mfma_f32_16x16x32_bf16(a0, bq[h][0], (f32x4){0.f, 0.f, 0.f, 0.f}, 0, 0, 0);
#pragma unroll
                    for (int h = 0; h < 8; ++h) dh[h] = __builtin_amdgcn_mfma_f32_16x16x32_bf16(a1, bq[h][1], dh[h], 0, 0, 0);
                    f32x4 sc = {0.f, 0.f, 0.f, 0.f};
#pragma unroll
                    for (int h = 0; h < 8; ++h)
#pragma unroll
                        for (int e = 0; e < 4; ++e) { const int bi = (int)__float_as_uint(dh[h][e]); sc[e] += wv[h] * __uint_as_float((unsigned)(bi > 0 ? bi : 0)); }
                    *(f32x4*)(SC + qrow * SEQ + 16 * kt + 4 * quad) = sc;
                }
            }
        }
    }
}

constexpr int HG_QD = 0, HG_KD = 17408, HG_VT = 34816, HG_KET = 53248, HG_ATT = 71680, HG_TOT = 80896, HG_O = 83968;

__device__ __forceinline__ void hg_cum(Frame& F, float (&cum)[16], float& cum_last) {
    LAS float* tot = (LAS float*)(F.lds + HG_TOT);
    const int seg = F.tid >> 7, k = F.tid & 127;
    float run = 0.f;
#pragma unroll
    for (int i = 0; i < 16; ++i) { run += cum[i]; cum[i] = run; }
    tot[seg * 128 + k] = run;
    __syncthreads();
    float pre = 0.f, all = 0.f;
#pragma unroll
    for (int s = 0; s < 4; ++s) { const float t = tot[s * 128 + k]; all += t; if (s < seg) pre += t; }
#pragma unroll
    for (int i = 0; i < 16; ++i) cum[i] += pre;
    cum_last = all;
}

__device__ __forceinline__ void p3_hgrn_upd(Frame& F) {
    const float* LOGF = WSP(float, WS_LOGF); const bf16_t* KF = WSP(bf16_t, WS_KF); const bf16_t* HI = WSP(bf16_t, WS_HI);
    bf16_t* UPDT = WSP(bf16_t, WS_UPDT); float* DEC = WSP(float, WS_DECAY);
    LAS bf16_t* VT = (LAS bf16_t*)(F.lds + HG_VT); LAS bf16_t* KET = (LAS bf16_t*)(F.lds + HG_KET);
    const int seg = F.tid >> 7, k = F.tid & 127, lane = F.lane, r32 = lane & 31, hi = lane >> 5;
    float lf[16]; bf16_t lv[16];
#define HGU_LOAD(tile_) do { const int b_ = (tile_) >> 9, n_ = ((tile_) >> 3) & 63, h_ = (tile_) & 7; const size_t ob_ = ((size_t)b_ * SEQ + 64 * n_ + 16 * seg) * 1024 + h_ * 128 + k; \
        _Pragma("unroll") for (int i = 0; i < 16; ++i) { lf[i] = LOGF[ob_ + i * 1024]; lv[i] = HI[ob_ + i * 1024]; } } while (0)
    if (F.bid < 1024) HGU_LOAD(F.bid);
    for (int tile = F.bid; tile < 1024; tile += F.G) {
        __syncthreads();
        float cum[16], cl;
#pragma unroll
        for (int i = 0; i < 16; ++i) cum[i] = lf[i];
        hg_cum(F, cum, cl);
        { unsigned pk[8], pv[8];
#pragma unroll
          for (int i = 0; i < 16; i += 2) {
              const float k0 = (1.0f - fexp(lf[i])) * fexp(cl - cum[i]), k1 = (1.0f - fexp(lf[i + 1])) * fexp(cl - cum[i + 1]); pk[i >> 1] = pk2(k0, k1);
              pv[i >> 1] = (unsigned)lv[i] | ((unsigned)lv[i + 1] << 16); }
          LAS u32x4* dk = (LAS u32x4*)(KET + k * 72 + 16 * seg); dk[0] = (u32x4){pk[0], pk[1], pk[2], pk[3]}; dk[1] = (u32x4){pk[4], pk[5], pk[6], pk[7]};
          LAS u32x4* dv = (LAS u32x4*)(VT + k * 72 + 16 * seg); dv[0] = (u32x4){pv[0], pv[1], pv[2], pv[3]}; dv[1] = (u32x4){pv[4], pv[5], pv[6], pv[7]};
          if (seg == 0) DEC[(size_t)tile * 128 + k] = fexp(cl); }
        __builtin_amdgcn_sched_barrier(0);
        if (tile + F.G < 1024) HGU_LOAD(tile + F.G);
        __syncthreads();
        const int vt = F.wave & 3, kt0 = (F.wave >> 2) * 2;
        f32x16 c0 = {}, c1 = {};
#pragma unroll
        for (int ks = 0; ks < 4; ++ks) { const bf16x8 a = *(const LAS bf16x8*)(VT + (vt * 32 + r32) * 72 + 16 * ks + 8 * hi);
            const bf16x8 b0 = *(const LAS bf16x8*)(KET + (kt0 * 32 + r32) * 72 + 16 * ks + 8 * hi), b1 = *(const LAS bf16x8*)(KET + (kt0 * 32 + 32 + r32) * 72 + 16 * ks + 8 * hi);
            c0 = mfma32(a, b0, c0); c1 = mfma32(a, b1, c1); }
        bf16_t* U = UPDT + (size_t)tile * 16384;
#pragma unroll
        for (int r = 0; r < 16; ++r) { const int v = vt * 32 + crow(r, hi);
            const float n0 = __uint_as_float((unsigned)__builtin_amdgcn_update_dpp(0, (int)__float_as_uint(c0[r]), 0xB1, 0xF, 0xF, false));
            const float n1 = __uint_as_float((unsigned)__builtin_amdgcn_update_dpp(0, (int)__float_as_uint(c1[r]), 0xB1, 0xF, 0xF, false));
            if (!(lane & 1)) { *(unsigned*)(U + v * 128 + kt0 * 32 + r32) = pk2(c0[r], n0); *(unsigned*)(U + v * 128 + kt0 * 32 + 32 + r32) = pk2(c1[r], n1); } }
    }
#undef HGU_LOAD
}

__device__ __forceinline__ void p4_hgrn_scan(Frame& F) {
    const bf16_t* UPDT = WSP(bf16_t, WS_UPDT); const float* DEC = WSP(float, WS_DECAY); bf16_t* SP = WSP(bf16_t, WS_SPREVT);
    const int gt = F.bid * NTHREADS + F.tid, NGT = F.G * NTHREADS;
    for (int e = gt; e < 2 * 8 * 16384 / 2; e += NGT) {
        const int bh = e >> 13, vk = (e & 8191) * 2, b = bh >> 3, h = bh & 7, k = vk & 127;
        float s0 = 0.f, s1 = 0.f;
#pragma unroll 8
        for (int n = 0; n < 64; ++n) { const size_t tile = (size_t)(b * 64 + n) * 8 + h;
            const unsigned uu = __builtin_nontemporal_load((const unsigned*)(UPDT + tile * 16384 + vk)); const f32x2 d = *(const f32x2*)(DEC + tile * 128 + k);
            *(unsigned*)(SP + tile * 16384 + vk) = pk2(s0, s1);
            s0 = d.x * s0 + bf2f(uu & 0xffffu); s1 = d.y * s1 + bf2f(uu >> 16); }
    }
}

__device__ __forceinline__ void p5_hgrn_out(Frame& F) {
    const float* LOGF = WSP(float, WS_LOGF); const bf16_t* KF = WSP(bf16_t, WS_KF); const bf16_t* HI = WSP(bf16_t, WS_HI); const bf16_t* HQ = WSP(bf16_t, WS_HQ);
    const bf16_t* HOG = WSP(bf16_t, WS_HOG); const bf16_t* SP = WSP(bf16_t, WS_SPREVT); bf16_t* YHG = WSP(bf16_t, WS_YHG);
    LAS bf16_t* QD = (LAS bf16_t*)(F.lds + HG_QD); LAS bf16_t* KD = (LAS bf16_t*)(F.lds + HG_KD); LAS bf16_t* VT = (LAS bf16_t*)(F.lds + HG_VT);
    LAS bf16_t* ATT = (LAS bf16_t*)(F.lds + HG_ATT); LAS float* OB = (LAS float*)(F.lds + HG_O);
    const int seg = F.tid >> 7, k = F.tid & 127, lane = F.lane, r32 = lane & 31, hi = lane >> 5;
    float lf[16]; bf16_t lq[16], lv[16];
#define HGO_LOAD(tile_) do { const int b_ = (tile_) >> 9, n_ = ((tile_) >> 3) & 63, h_ = (tile_) & 7; const size_t ob_ = ((size_t)b_ * SEQ + 64 * n_ + 16 * seg) * 1024 + h_ * 128 + k; \
        _Pragma("unroll") for (int i = 0; i < 16; ++i) { lf[i] = LOGF[ob_ + i * 1024]; lq[i] = HQ[ob_ + i * 1024]; lv[i] = HI[ob_ + i * 1024]; } } while (0)
    if (F.bid < 1024) HGO_LOAD(F.bid);
    for (int tile = F.bid; tile < 1024; tile += F.G) {
        const int b = tile >> 9, n = (tile >> 3) & 63, h = tile & 7; const size_t m0 = (size_t)b * SEQ + 64 * n;
        __syncthreads();
        float cum[16], cl;
#pragma unroll
        for (int i = 0; i < 16; ++i) cum[i] = lf[i];
        hg_cum(F, cum, cl);
        { unsigned pv[8];
          __builtin_amdgcn_sched_barrier(0);
#pragma unroll
          for (int i = 0; i < 16; ++i) {
              const float qd = bf2f(lq[i]) * fexp(cum[i]), kd = (1.0f - fexp(lf[i])) * fexp(-cum[i]);
              QD[(16 * seg + i) * 136 + k] = (bf16_t)(pk2(qd, 0.f) & 0xffffu); KD[(16 * seg + i) * 136 + k] = (bf16_t)(pk2(kd, 0.f) & 0xffffu);
              if (i & 1) pv[i >> 1] |= ((unsigned)lv[i] << 16); else pv[i >> 1] = (unsigned)lv[i]; }
          LAS u32x4* dv = (LAS u32x4*)(VT + k * 72 + 16 * seg); dv[0] = (u32x4){pv[0], pv[1], pv[2], pv[3]}; dv[1] = (u32x4){pv[4], pv[5], pv[6], pv[7]}; }
        const int tt = F.wave >> 2, vt = F.wave & 3;
        bf16x8 sb[8];
        { const bf16_t* S = SP + (size_t)tile * 16384 + (size_t)(vt * 32 + r32) * 128;
#pragma unroll
          for (int ks = 0; ks < 8; ++ks) sb[ks] = *(const bf16x8*)(S + 16 * ks + 8 * hi); }
        __builtin_amdgcn_sched_barrier(0);
        if (tile + F.G < 1024) HGO_LOAD(tile + F.G);
        __syncthreads();
        if (F.wave < 4) { const int ta = F.wave >> 1, sa = F.wave & 1; f32x16 c = {};
            if (sa <= ta) {
#pragma unroll
                for (int ks = 0; ks < 8; ++ks) { const bf16x8 a = *(const LAS bf16x8*)(QD + (ta * 32 + r32) * 136 + 16 * ks + 8 * hi), bb = *(const LAS bf16x8*)(KD + (sa * 32 + r32) * 136 + 16 * ks + 8 * hi); c = mfma32(a, bb, c); } }
#pragma unroll
            for (int r = 0; r < 16; ++r) { const int t = ta * 32 + crow(r, hi), s = sa * 32 + r32; const float v = (s <= t) ? c[r] : 0.f; ATT[t * 72 + s] = (bf16_t)(pk2(v, 0.f) & 0xffffu); } }
        f32x16 o = {};
        {
#pragma unroll
          for (int ks = 0; ks < 8; ++ks) { const bf16x8 a = *(const LAS bf16x8*)(QD + (tt * 32 + r32) * 136 + 16 * ks + 8 * hi); o = mfma32(a, sb[ks], o); } }
        __syncthreads();
#pragma unroll
        for (int ks = 0; ks < 4; ++ks) { const bf16x8 a = *(const LAS bf16x8*)(ATT + (tt * 32 + r32) * 72 + 16 * ks + 8 * hi), bb = *(const LAS bf16x8*)(VT + (vt * 32 + r32) * 72 + 16 * ks + 8 * hi); o = mfma32(a, bb, o); }
#pragma unroll
        for (int r = 0; r < 16; ++r) OB[(tt * 32 + crow(r, hi)) * 132 + vt * 32 + r32] = o[r];
        __syncthreads();
        { const int t = F.tid >> 3, part = F.tid & 7; float v[16], ss = 0.f;
#pragma unroll
          for (int i = 0; i < 16; i += 4) { const f32x4 x = *(const LAS f32x4*)(OB + t * 132 + part * 16 + i); v[i] = x[0]; v[i + 1] = x[1]; v[i + 2] = x[2]; v[i + 3] = x[3]; ss += (x[0] * x[0] + x[1] * x[1]) + (x[2] * x[2] + x[3] * x[3]); }
          ss += __shfl_xor(ss, 1); ss += __shfl_xor(ss, 2); ss += __shfl_xor(ss, 4);
          const float rs = 1.0f / sqrtf(ss * (1.0f / 128.0f) + EPS);
          const size_t off = (m0 + t) * 1024 + h * 128 + part * 16; unsigned w[8];
          const u32x4 g0 = *(const u32x4*)(HOG + off), g1 = *(const u32x4*)(HOG + off + 8); const unsigned gg[8] = {g0.x, g0.y, g0.z, g0.w, g1.x, g1.y, g1.z, g1.w};
          const float* ghp = F.g_head + h * 128 + part * 16; const f32x4 gh0 = *(const f32x4*)ghp, gh1 = *(const f32x4*)(ghp + 4), gh2 = *(const f32x4*)(ghp + 8), gh3 = *(const f32x4*)(ghp + 12);
          const float ghv[16] = {gh0[0], gh0[1], gh0[2], gh0[3], gh1[0], gh1[1], gh1[2], gh1[3], gh2[0], gh2[1], gh2[2], gh2[3], gh3[0], gh3[1], gh3[2], gh3[3]};
#pragma unroll
          for (int i = 0; i < 8; ++i) { w[i] = pk2(v[2 * i] * rs * ghv[2 * i] * bf2f(gg[i] & 0xffffu), v[2 * i + 1] * rs * ghv[2 * i + 1] * bf2f(gg[i] >> 16)); }
          *(u32x4*)(YHG + off) = (u32x4){w[0], w[1], w[2], w[3]}; *(u32x4*)(YHG + off + 8) = (u32x4){w[4], w[5], w[6], w[7]}; }
    }
}

__device__ __forceinline__ unsigned f2ord(float f) { const unsigned u = __float_as_uint(f); return (u & 0x80000000u) ? ~u : (u | 0x80000000u); }
__device__ __forceinline__ void p4_down_weights(Frame& F) {
    LAS float* scr = (LAS float*)(F.lds + F.wave * 16384);
    const int gw = F.bid * NWAVES + F.wave, NGW = F.G * NWAVES;
#define P4_DESC(it, d) do { const int e_ = (it) / 512; d.W = F.w_ed + (size_t)e_ * EFF * DM; d.K = EFF; d.N = DM; d.WT = WSP(bf16_t, WS_WD_T) + (size_t)e_ * DM * EFF; d.kind = 0; d.item = (it) % 512; } while (0)
    TD_STREAM(gw, NGW, NEXP * 512, P4_DESC, F.lane, scr);
#undef P4_DESC
}
__device__ __forceinline__ void p4_sel_load(const float* SC, int row, int lane, unsigned (&nu)[64]) {
    const int t = row & (SEQ - 1);
    if (t >= TOPK) { const float* srow = SC + (size_t)row * SEQ; const int ng = (t >> 9) + 1;
#pragma unroll
        for (int g = 0; g < 8; ++g) {
            if (g < ng) {
#pragma unroll
                for (int j = 0; j < 8; ++j) nu[8 * g + j] = __float_as_uint(__builtin_nontemporal_load(srow + 64 * (8 * g + j) + lane));
            }
        }
    }
}
__device__ __forceinline__ void p4_select(Frame& F) {
    const float* SC = WSP(float, WS_SCORES); unsigned long long* MASK = WSP(unsigned long long, WS_MASK);
    const int gw = F.bid * NWAVES + F.wave, NGW = F.G * NWAVES, lane = F.lane;
    constexpr int NPAIR = NBATCH * (SEQ / 2);
#define SEL_ROW(k_) ({ const int idx_ = gw + ((k_) >> 1) * NGW; const int b_ = idx_ / (SEQ / 2), p_ = idx_ % (SEQ / 2); b_ * SEQ + (((k_) & 1) ? (SEQ - 1 - p_) : p_); })
#define SEL_HAVE(k_) (gw + ((k_) >> 1) * NGW < NPAIR)
    unsigned nu[64];
#pragma unroll
    for (int i = 0; i < 64; ++i) nu[i] = 0u;
    int k = 0; bool have = SEL_HAVE(0); int row = have ? SEL_ROW(0) : 0;
    if (have) p4_sel_load(SC, row, lane, nu);
    while (have) {
        const int t = row & (SEQ - 1);
        unsigned long long mine = 0ull;
        unsigned u[64];
        const int ng = (t >> 9) + 1;
        if (t >= TOPK) {
#pragma unroll
            for (int g = 0; g < 8; ++g) {
                if (g < ng) {
#pragma unroll
                    for (int j = 0; j < 8; ++j) { const int i = 8 * g + j; const unsigned bits = nu[i]; u[i] = bits ^ ((unsigned)((int)bits >> 31) | 0x80000000u); }
                    if (g == ng - 1) {
#pragma unroll
                        for (int j = 0; j < 8; ++j) { const int i = 8 * g + j, s = 64 * i + lane; u[i] = (s <= t) ? u[i] : 0u; }
                    }
                } else {
#pragma unroll
                    for (int j = 0; j < 8; ++j) u[8 * g + j] = 0u;
                }
            }
        }
        __builtin_amdgcn_sched_barrier(0);
        ++k; const bool haveN = SEL_HAVE(k); const int rowN = haveN ? SEL_ROW(k) : 0;
        if (haveN) p4_sel_load(SC, rowN, lane, nu);
        __builtin_amdgcn_sched_barrier(0);
        if (t < TOPK) {
            const int lo = 64 * lane;
            mine = (t >= lo + 63) ? ~0ull : (t < lo ? 0ull : ((1ull << (t - lo + 1)) - 1ull));
        } else {
            const int ntot = 512 * ng;
            unsigned hp[32];
#pragma unroll
            for (int i = 0; i < 32; ++i) hp[i] = (u[2 * i] >> 16) | (u[2 * i + 1] & 0xffff0000u);
            unsigned T = 0u; bool exact = false; int geT = ntot;
            { const unsigned one2 = 0x00010001u; unsigned Th = 0u;
              for (int bit = 15; bit >= 0; --bit) {
                  const unsigned ch = Th | (1u << bit); unsigned c2 = ch | (ch << 16), acc2 = 0u;
                  asm volatile("" : "+v"(c2));
#pragma unroll
                  for (int g = 0; g < 8; ++g) {
                      if (g < ng) {
#pragma unroll
                          for (int j = 0; j < 4; ++j) { unsigned d;
                              asm("v_pk_sub_u16 %0, %1, %2 clamp" : "=v"(d) : "v"(c2), "v"(hp[4 * g + j]));
                              asm("v_pk_min_u16 %0, %1, %2" : "=v"(d) : "v"(d), "v"(one2));
                              asm("v_pk_add_u16 %0, %1, %2" : "=v"(acc2) : "v"(acc2), "v"(d)); }
                      }
                  }
                  const int ge = ntot - wave_sum_i_dpp((int)((acc2 & 0xffffu) + (acc2 >> 16)));
                  if (ge >= TOPK) { Th = ch; geT = ge; if (ge == TOPK) { exact = true; break; } }
              }
              T = Th << 16; }
            if (!exact) {
                for (int bit = 15; bit >= 0; --bit) {
                    unsigned cand = T | (1u << bit); int c = 0;
                    asm volatile("" : "+v"(cand));
#pragma unroll
                    for (int g = 0; g < 8; ++g) {
                        if (g < ng) {
#pragma unroll
                            for (int j = 0; j < 8; j += 2) { unsigned d0, d1;
                                asm("v_sub_u32_e64 %0, %1, %2 clamp" : "=v"(d0) : "v"(cand), "v"(u[8 * g + j]));
                                asm("v_sub_u32_e64 %0, %1, %2 clamp" : "=v"(d1) : "v"(cand), "v"(u[8 * g + j + 1]));
                                asm("v_min_u32_e32 %0, 1, %1" : "=v"(d0) : "v"(d0));
                                asm("v_min_u32_e32 %0, 1, %1" : "=v"(d1) : "v"(d1));
                                c += (int)(d0 + d1); }
                        }
                    }
                    const int ge = ntot - wave_sum_i_dpp(c);
                    if (ge >= TOPK) { T = cand; geT = ge; if (ge == TOPK) break; }
                }
            }
            const bool allties = (geT == TOPK);
            int need = 0;
            if (!allties) { int cg = 0;
#pragma unroll
                for (int g = 0; g < 8; ++g) {
                    if (g < ng) {
#pragma unroll
                        for (int j = 0; j < 8; ++j) cg += (u[8 * g + j] > T) ? 1 : 0;
                    }
                }
                need = TOPK - wave_sum_i_dpp(cg); }
            int running = 0; const unsigned long long lt = (1ull << lane) - 1ull;
#pragma unroll
            for (int g = 0; g < 8; ++g) {
                if (g < ng) {
#pragma unroll
                    for (int j = 0; j < 8; ++j) { const int i = 8 * g + j;
                        unsigned long long sb;
                        if (allties) sb = __ballot(u[i] >= T);
                        else { const bool eq = (u[i] == T); const unsigned long long bal = __ballot(eq);
                            const int rank = running + __popcll(bal & lt); running += __popcll(bal);
                            sb = __ballot((u[i] > T) || (eq && rank < need)); }
                        if (lane == i) mine = sb; }
                }
            }
        }
        MASK[(size_t)row * 64 + lane] = mine;
        row = rowN; have = haveN;
    }
#undef SEL_ROW
#undef SEL_HAVE
}

constexpr int AT_K = 0, AT_V = 34816, AT_END = 34816 + 34816;
constexpr int AT_MRG = 0, AT_STG = 69632;
__device__ __forceinline__ void p5_attention(Frame& F) {
    const bf16_t* AQ = WSP(bf16_t, WS_AQ); const bf16_t* AK = WSP(bf16_t, WS_AK); const bf16_t* AVT = WSP(bf16_t, WS_AVT); const unsigned* MASK = WSP(unsigned, WS_MASK); bf16_t* YATT = WSP(bf16_t, WS_YATT);
    const int lane = F.lane, r32 = lane & 31, hi = lane >> 5, w = F.wave, kp = w >> 2, tid = F.tid;
    LAS unsigned char* lds = F.lds;
    const int lbid = (F.G % 8 == 0) ? ((F.bid & 7) * (F.G >> 3) + (F.bid >> 3)) : F.bid;
    for (int item = lbid; item < 256; item += F.G) {
        const int b = item >> 7, hk = (item >> 6) & 1, jj = item & 63;
        for (int uu = 0; uu < 2; ++uu) {
            const int j = uu ? 127 - jj : jj;
            const int head = hk * 4 + (w & 3);
            const size_t qrow = (size_t)b * SEQ + 32 * j + r32;
            const int NT = (j + 2) >> 1, NI = (NT + 1) >> 1;
            bf16x8 qf[8];
#pragma unroll
            for (int ks = 0; ks < 8; ++ks) qf[ks] = *(const bf16x8*)(AQ + qrow * 1024 + head * 128 + 16 * ks + 8 * hi);
            f32x16 o[4]; o[0] = f32x16{}; o[1] = f32x16{}; o[2] = f32x16{}; o[3] = f32x16{};
            float mrun = -INFINITY, lrun = 0.f;
            u32x4 sk[4], sv[4];
#pragma unroll
            for (int c = 0; c < 4; ++c) { sk[c] = (u32x4){0u, 0u, 0u, 0u}; sv[c] = (u32x4){0u, 0u, 0u, 0u}; }
            const bf16_t* Kg = AK + (size_t)b * SEQ * 256 + hk * 128;
            const bf16_t* Vg = AVT + (size_t)((b * 2 + hk) * 128) * SEQ;
#define AT_LOAD(it_) do { int tv = tid; asm volatile("" : "+v"(tv)); const unsigned kb2 = (unsigned)(it_) * 128u; \
                const unsigned ko = ((kb2 + (unsigned)(tv >> 4)) * 256u + (unsigned)(tv & 15) * 8u) * 2u; \
                const unsigned vo = ((unsigned)(tv >> 3) * (unsigned)SEQ + kb2 + (unsigned)(tv & 7) * 8u) * 2u; \
                _Pragma("unroll") for (int c = 0; c < 4; ++c) { \
                    sk[c] = *(const u32x4*)((const char*)Kg + ko + (unsigned)c * 32u * 512u); \
                    sv[c] = *(const u32x4*)((const char*)Vg + vo + (unsigned)(c & 1) * 64u * (unsigned)SEQ * 2u + (unsigned)(c >> 1) * 128u); } } while (0)
#define AT_STORE(bo_) do { \
                _Pragma("unroll") for (int c = 0; c < 4; ++c) { const int id = c * 512 + tid; const int key = id >> 4, ch = id & 15; \
                    *(LAS u32x4*)(lds + (bo_) + AT_K + key * 272 + ch * 16) = sk[c]; \
                    const int vd = (id >> 3) & 127, vp = id >> 10, vc = id & 7; \
                    LAS u32x2* dst = (LAS u32x2*)(lds + (bo_) + AT_V + vp * 17408 + vd * 136 + vc * 16); dst[0] = (u32x2){sv[c].x, sv[c].y}; dst[1] = (u32x2){sv[c].z, sv[c].w}; } } while (0)
            AT_LOAD(0);
            u32x2 mwn = (kp < NT) ? *(const u32x2*)(MASK + qrow * 128 + 2 * kp) : (u32x2){0u, 0u};
            __syncthreads();
            AT_STORE(0);
            if (NI > 1) AT_LOAD(1);
            __syncthreads();
            for (int it = 0; it < NI; ++it) {
                const int bo = (it & 1) * 69632;
                if (kp == 1 && it + 1 < NI) { AT_STORE(((it + 1) & 1) * 69632); if (it + 2 < NI) AT_LOAD(it + 2); }
                const int kt = 2 * it + kp;
                const u32x2 mw = mwn;
                if (kt + 2 < NT) mwn = *(const u32x2*)(MASK + qrow * 128 + 2 * (kt + 2));
                if (kt < NT) {
                    const LAS unsigned char* Kp = lds + bo + AT_K + kp * 17408; const LAS unsigned char* Vp = lds + bo + AT_V + kp * 17408;
                    f32x16 p0 = {}, p1 = {};
                    { bf16x8 kf[2][2][2];
#define AT_KLOAD(ks_, buf_) do { kf[buf_][(ks_) & 1][0] = *(const LAS bf16x8*)(Kp + r32 * 272 + (16 * (ks_) + 8 * hi) * 2); kf[buf_][(ks_) & 1][1] = *(const LAS bf16x8*)(Kp + (32 + r32) * 272 + (16 * (ks_) + 8 * hi) * 2); } while (0)
                      AT_KLOAD(0, 0); AT_KLOAD(1, 0);
#pragma unroll
                      for (int kk = 0; kk < 4; ++kk) {
                          __builtin_amdgcn_sched_barrier(0);
                          if (kk < 3) { AT_KLOAD(2 * kk + 2, (kk + 1) & 1); AT_KLOAD(2 * kk + 3, (kk + 1) & 1); }
#pragma unroll
                          for (int k2 = 0; k2 < 2; ++k2) { p0 = mfma32(kf[kk & 1][k2][0], qf[2 * kk + k2], p0); p1 = mfma32(kf[kk & 1][k2][1], qf[2 * kk + k2], p1); } }
#undef AT_KLOAD
                    }
                    __builtin_amdgcn_sched_barrier(0);
                    u32x4 vf[2][4];
#define AT_VLOAD(dt_, buf_) do { _Pragma("unroll") for (int s = 0; s < 4; ++s) { const LAS unsigned char* vr = Vp + ((dt_) * 32 + r32) * 136 + (16 * s + 4 * hi) * 2; \
                        const u32x2 lo = *(const LAS u32x2*)vr, hh = *(const LAS u32x2*)(vr + 16); vf[buf_][s] = (u32x4){lo.x, lo.y, hh.x, hh.y}; } } while (0)
                    AT_VLOAD(0, 0);
                    float rm = fmaxf(p0[0], p1[0]);
#pragma unroll
                    for (int r = 1; r < 16; ++r) rm = fmaxf(rm, fmaxf(p0[r], p1[r]));
                    rm = fmaxf(rm, __shfl_xor(rm, 32));
                    if (__any(rm > mrun + 8.0f)) { const float mnew = fmaxf(mrun, rm), alpha = __builtin_amdgcn_exp2f(mrun - mnew); lrun *= alpha; mrun = mnew;
#pragma unroll
                        for (int dt = 0; dt < 4; ++dt)
#pragma unroll
                            for (int r = 0; r < 16; ++r) o[dt][r] *= alpha; }
                    const int mx0 = (int)(mw.x >> (4 * hi)), mx1 = (int)(mw.y >> (4 * hi));
                    float ps = 0.f;
#pragma unroll
                    for (int r = 0; r < 16; ++r) { const int bp = (r & 3) + 8 * (r >> 2);
                        int k0 = __builtin_amdgcn_sbfe(mx0, bp, 1), k1 = __builtin_amdgcn_sbfe(mx1, bp, 1);
                        asm volatile("" : "+v"(k0), "+v"(k1));
                        p0[r] = __uint_as_float(__float_as_uint(__builtin_amdgcn_exp2f(p0[r] - mrun)) & (unsigned)k0);
                        p1[r] = __uint_as_float(__float_as_uint(__builtin_amdgcn_exp2f(p1[r] - mrun)) & (unsigned)k1);
                        ps += p0[r] + p1[r]; }
                    lrun += ps;
                    bf16x8 pb[4];
#pragma unroll
                    for (int s = 0; s < 2; ++s) { u32x4 t0, t1;
                        t0.x = pk2(p0[8 * s + 0], p0[8 * s + 1]); t0.y = pk2(p0[8 * s + 2], p0[8 * s + 3]); t0.z = pk2(p0[8 * s + 4], p0[8 * s + 5]); t0.w = pk2(p0[8 * s + 6], p0[8 * s + 7]);
                        t1.x = pk2(p1[8 * s + 0], p1[8 * s + 1]); t1.y = pk2(p1[8 * s + 2], p1[8 * s + 3]); t1.z = pk2(p1[8 * s + 4], p1[8 * s + 5]); t1.w = pk2(p1[8 * s + 6], p1[8 * s + 7]);
                        pb[s] = __builtin_bit_cast(bf16x8, t0); pb[2 + s] = __builtin_bit_cast(bf16x8, t1); }
#pragma unroll
                    for (int dt = 0; dt < 4; ++dt) {
                        __builtin_amdgcn_sched_barrier(0);
                        if (dt < 3) AT_VLOAD(dt + 1, (dt + 1) & 1);
#pragma unroll
                        for (int s = 0; s < 4; ++s) o[dt] = mfma32(__builtin_bit_cast(bf16x8, vf[dt & 1][s]), pb[s], o[dt]); }
#undef AT_VLOAD
                    __builtin_amdgcn_sched_barrier(0);
                }
                if (kp == 0 && it + 1 < NI) { AT_STORE(((it + 1) & 1) * 69632); if (it + 2 < NI) AT_LOAD(it + 2); }
                __syncthreads();
            }
            __syncthreads();
            LAS float* mg = (LAS float*)(lds + AT_MRG) + (w & 3) * 66 * 64;
            if (kp == 1) { mg[lane] = mrun; mg[64 + lane] = lrun;
#pragma unroll
                for (int dt = 0; dt < 4; ++dt)
#pragma unroll
                    for (int r = 0; r < 16; ++r) mg[(2 + dt * 16 + r) * 64 + lane] = o[dt][r]; }
            __syncthreads();
            if (kp == 0) {
                const float m1 = mg[lane], l1 = mg[64 + lane];
                const float mt = fmaxf(mrun, m1), mu = (mt == -INFINITY) ? 0.f : mt;
                const float a0 = __builtin_amdgcn_exp2f(mrun - mu), a1 = __builtin_amdgcn_exp2f(m1 - mu);
                float l = lrun * a0 + l1 * a1; l += __shfl_xor(l, 32);
                const float inv = 1.0f / l;
                LAS bf16_t* stg = (LAS bf16_t*)(lds + AT_STG) + (w & 3) * 32 * 136;
#pragma unroll
                for (int dt = 0; dt < 4; ++dt)
#pragma unroll
                    for (int r = 0; r < 16; ++r) { const float v = (o[dt][r] * a0 + mg[(2 + dt * 16 + r) * 64 + lane] * a1) * inv; stg[r32 * 136 + dt * 32 + crow(r, hi)] = (bf16_t)(pk2(v, 0.f) & 0xffffu); }
                LDS_WAIT();
#pragma unroll
                for (int i = 0; i < 8; ++i) { const int rr = i * 4 + (lane >> 4), ch = lane & 15; const u32x4 v = *(const LAS u32x4*)(stg + rr * 136 + ch * 8);
                    *(u32x4*)(YATT + ((size_t)b * SEQ + 32 * j + rr) * 1024 + head * 128 + ch * 8) = v; }
            }
        }
    }
#undef AT_LOAD
#undef AT_STORE
}

struct ProbMerge : ProbBase {
    static constexpr bool PERM = true;
    unsigned char* ws;
    __device__ __forceinline__ bool next(int i, U& u) const { u.aux = i & 1; return pg8::static_tile((i >> 1) * G + c, M / 256, DM / 256, u.pm, u.pn); }
    __device__ __forceinline__ void bases(const U& u, const char*& a, const char*& b) const {
        a = (const char*)(ws + (u.aux ? WS_YHG : WS_YATT)) + (size_t)u.pm * 256 * K * 2; b = (const char*)(ws + (u.aux ? WS_WHU_T : WS_WAU_T)) + (size_t)u.pn * 256 * K * 2; }
    __device__ __forceinline__ void lane_offs(const U&, const int (&stR)[2], const int (&stC)[2], unsigned (&va)[2][2]) const { lane_offs_plain(stR, stC, va); }
    __device__ __forceinline__ bool keep(const U& u) const { return u.aux == 0; }
    __device__ __forceinline__ void epi(f32x4 (&acc)[2][2][4][2], const U& u, int wr, int wc, int fr, int fq) const {
        const bf16_t* GA = (const bf16_t*)(ws + WS_GA); const bf16_t* GH = (const bf16_t*)(ws + WS_GH); bf16_t* O = (bf16_t*)(ws + WS_MERGED);
        const int row0 = u.pm * 256 + wr * 64 + fr, colw = u.pn * 256 + wc * 32 + 8 * fq;
#pragma unroll
        for (int ai = 0; ai < 2; ++ai) {
            u32x4 gh[4][2], ga[4][2];
#pragma unroll
            for (int m = 0; m < 4; ++m)
#pragma unroll
                for (int bj = 0; bj < 2; ++bj) { const size_t off = (size_t)(row0 + ai * 128 + m * 16) * DM + colw + bj * 128; gh[m][bj] = *(const u32x4*)(GH + off); if (u.aux == 0) ga[m][bj] = __builtin_nontemporal_load((const u32x4*)(GA + off)); else ga[m][bj] = gh[m][bj]; }
            __builtin_amdgcn_sched_barrier(0);
#pragma unroll
            for (int m = 0; m < 4; ++m)
#pragma unroll
                for (int bj = 0; bj < 2; ++bj) { const size_t off = (size_t)(row0 + ai * 128 + m * 16) * DM + colw + bj * 128;
                    const unsigned ghw[4] = {gh[m][bj].x, gh[m][bj].y, gh[m][bj].z, gh[m][bj].w}; const unsigned gaw[4] = {ga[m][bj].x, ga[m][bj].y, ga[m][bj].z, ga[m][bj].w};
                    if (u.aux == 0) {
#pragma unroll
                        for (int n = 0; n < 2; ++n)
#pragma unroll
                            for (int e = 0; e < 4; ++e) { const int wi = 2 * n + (e >> 1); const float a = (e & 1) ? bf2f(gaw[wi] >> 16) : bf2f(gaw[wi] & 0xffffu), h = (e & 1) ? bf2f(ghw[wi] >> 16) : bf2f(ghw[wi] & 0xffffu);
                                acc[ai][bj][m][n][e] *= a * frcp(fmaxf(h, 1e-20f)); } }
                    else { float v[8];
#pragma unroll
                        for (int n = 0; n < 2; ++n)
#pragma unroll
                            for (int e = 0; e < 4; ++e) { const int wi = 2 * n + (e >> 1); const float h = (e & 1) ? bf2f(ghw[wi] >> 16) : bf2f(ghw[wi] & 0xffffu); v[4 * n + e] = acc[ai][bj][m][n][e] * h; }
                        u32x4 w; w.x = pk2(v[0], v[1]); w.y = pk2(v[2], v[3]); w.z = pk2(v[4], v[5]); w.w = pk2(v[6], v[7]); *(u32x4*)(O + off) = w; } }
            __builtin_amdgcn_sched_barrier(0);
        }
    }
};

struct ProbOut : ProbBase {
    static constexpr bool PERM = true;
    unsigned char* ws; const float* x;
    __device__ __forceinline__ bool next(int i, U& u) const { u.aux = 0; return pg8::static_tile(i * G + c, M / 256, DM / 256, u.pm, u.pn); }
    __device__ __forceinline__ void bases(const U& u, const char*& a, const char*& b) const { a = (const char*)(ws + WS_MERGED) + (size_t)u.pm * 256 * K * 2; b = (const char*)(ws + WS_WOUT_T) + (size_t)u.pn * 256 * K * 2; }
    __device__ __forceinline__ void lane_offs(const U&, const int (&stR)[2], const int (&stC)[2], unsigned (&va)[2][2]) const { lane_offs_plain(stR, stC, va); }
    __device__ __forceinline__ void epi(f32x4 (&acc)[2][2][4][2], const U& u, int wr, int wc, int fr, int fq) const {
        const float* MOD = (const float*)(ws + WS_MOD); bf16_t* X1 = (bf16_t*)(ws + WS_X1);
        const int row0 = u.pm * 256 + wr * 64 + fr, colw = u.pn * 256 + wc * 32 + 8 * fq, b = (u.pm * 256) >> 12;
#pragma unroll
        for (int bj = 0; bj < 2; ++bj) { const int col = colw + bj * 128;
            const f32x4 gt0 = *(const f32x4*)(MOD + b * 12288 + 2 * DM + col), gt1 = *(const f32x4*)(MOD + b * 12288 + 2 * DM + col + 4);
#pragma unroll
            for (int ai = 0; ai < 2; ++ai) { f32x4 xv[4][2];
#pragma unroll
                for (int m = 0; m < 4; ++m) { const float* xp = x + (size_t)(row0 + ai * 128 + m * 16) * DM + col; xv[m][0] = __builtin_nontemporal_load((const f32x4*)xp); xv[m][1] = __builtin_nontemporal_load((const f32x4*)(xp + 4)); }
                __builtin_amdgcn_sched_barrier(0);
#pragma unroll
                for (int m = 0; m < 4; ++m) { const f32x4 v0 = xv[m][0] + gt0 * acc[ai][bj][m][0], v1 = xv[m][1] + gt1 * acc[ai][bj][m][1];
                    u32x4 w; w.x = pk2(v0.x, v0.y); w.y = pk2(v0.z, v0.w); w.z = pk2(v1.x, v1.y); w.w = pk2(v1.z, v1.w);
                    *(u32x4*)(X1 + (size_t)(row0 + ai * 128 + m * 16) * DM + col) = w; }
                __builtin_amdgcn_sched_barrier(0); } }
    }
};

__device__ __forceinline__ void p8_norm2_route(Frame& F) {
    LAS float* CA = (LAS float*)F.lds; LAS float* CB = CA + DM;
    LAS float* SS = CB + DM;
    LAS float* PART = SS + 128;
    LAS float* LOGI = PART + 2 * 4 * 16 * 48;
    const float* MOD = WSP(float, WS_MOD); bf16_t* XN = WSP(bf16_t, WS_XN); const bf16_t* X1 = WSP(bf16_t, WS_X1);
    int* LIST = WSP(int, WS_LIST); float* LISTW = WSP(float, WS_LISTW);
    const u32x4* WRH = WSP(u32x4, WS_WRF); const u32x4* WRL = WRH + 64 * 3 * 64;
    const int lane = F.lane, tid = F.tid, rg = F.wave >> 2, kq4 = F.wave & 3, r = lane & 15, kq = lane >> 4;
    for (int rb = F.bid; rb < M / 32; rb += F.G) {
        const int b = (rb * 32) / SEQ;
        __syncthreads();
        for (int k = tid; k < DM; k += NTHREADS) { CA[k] = F.g_norm2[k] * (1.0f + MOD[b * 12288 + 4 * DM + k]); CB[k] = MOD[b * 12288 + 3 * DM + k]; }
        const size_t row = (size_t)rb * 32 + 16 * rg + r;
        const bf16_t* xp = X1 + row * DM + 512 * kq4 + 8 * kq;
        u32x4 v[16];
#pragma unroll
        for (int s2 = 0; s2 < 16; ++s2) v[s2] = *(const u32x4*)(xp + 32 * s2);
        float ss = 0.f;
#pragma unroll
        for (int s2 = 0; s2 < 16; ++s2) { const unsigned w_[4] = {v[s2].x, v[s2].y, v[s2].z, v[s2].w};
#pragma unroll
            for (int q = 0; q < 4; ++q) { const float lo_ = bf2f(w_[q] & 0xffffu), hi_ = __uint_as_float(w_[q] & 0xffff0000u); ss += lo_ * lo_ + hi_ * hi_; } }
        ss += __shfl_xor(ss, 16); ss += __shfl_xor(ss, 32);
        if (kq == 0) SS[(rg * 4 + kq4) * 16 + r] = ss;
        __syncthreads();
        const float tot = (SS[(rg * 4 + 0) * 16 + r] + SS[(rg * 4 + 1) * 16 + r]) + (SS[(rg * 4 + 2) * 16 + r] + SS[(rg * 4 + 3) * 16 + r]);
        const float rs = 1.0f / sqrtf(tot * (1.0f / DM) + EPS);
        u32x4 ah[16], al[16];
#pragma unroll
        for (int s2 = 0; s2 < 16; ++s2) {
            const int kb = 512 * kq4 + 32 * s2 + 8 * kq;
            const f32x4 ca0 = *(const LAS f32x4*)(CA + kb), ca1 = *(const LAS f32x4*)(CA + kb + 4), cb0 = *(const LAS f32x4*)(CB + kb), cb1 = *(const LAS f32x4*)(CB + kb + 4);
            const f32x4 x0 = {bf2f(v[s2].x & 0xffffu), __uint_as_float(v[s2].x & 0xffff0000u), bf2f(v[s2].y & 0xffffu), __uint_as_float(v[s2].y & 0xffff0000u)};
            const f32x4 x1 = {bf2f(v[s2].z & 0xffffu), __uint_as_float(v[s2].z & 0xffff0000u), bf2f(v[s2].w & 0xffffu), __uint_as_float(v[s2].w & 0xffff0000u)};
            const f32x4 h0 = x0 * rs * ca0 + cb0, h1 = x1 * rs * ca1 + cb1;
            u32x4 hi; hi.x = pk2(h0.x, h0.y); hi.y = pk2(h0.z, h0.w); hi.z = pk2(h1.x, h1.y); hi.w = pk2(h1.z, h1.w);
            *(u32x4*)(XN + row * DM + kb) = hi;
            u32x4 lo;
            lo.x = pk2(h0.x - bf2f(hi.x & 0xffffu), h0.y - __uint_as_float(hi.x & 0xffff0000u)); lo.y = pk2(h0.z - bf2f(hi.y & 0xffffu), h0.w - __uint_as_float(hi.y & 0xffff0000u));
            lo.z = pk2(h1.x - bf2f(hi.z & 0xffffu), h1.y - __uint_as_float(hi.z & 0xffff0000u)); lo.w = pk2(h1.z - bf2f(hi.w & 0xffffu), h1.w - __uint_as_float(hi.w & 0xffff0000u));
            ah[s2] = hi; al[s2] = lo;
        __builtin_amdgcn_sched_barrier(0);
        }
        f32x4 acc[3] = {{0.f, 0.f, 0.f, 0.f}, {0.f, 0.f, 0.f, 0.f}, {0.f, 0.f, 0.f, 0.f}};
        const u32x4* wh = WRH + (size_t)(16 * kq4) * 192 + lane; const u32x4* wl = WRL + (size_t)(16 * kq4) * 192 + lane;
        u32x4 bh[2][3], bl[2][3];
#pragma unroll
        for (int t = 0; t < 3; ++t) { bh[0][t] = wh[t * 64]; bl[0][t] = wl[t * 64]; }
#pragma unroll
        for (int s2 = 0; s2 < 16; ++s2) {
            if (s2 + 1 < 16) { wh += 192; wl += 192; asm volatile("" : "+v"(wh), "+v"(wl));
#pragma unroll
                for (int t = 0; t < 3; ++t) { bh[(s2 + 1) & 1][t] = wh[t * 64]; bl[(s2 + 1) & 1][t] = wl[t * 64]; } }
            const bf16x8 a_hi = __builtin_bit_cast(bf16x8, ah[s2]), a_lo = __builtin_bit_cast(bf16x8, al[s2]);
#pragma unroll
            for (int t = 0; t < 3; ++t) {
                const bf16x8 fh = __builtin_bit_cast(bf16x8, bh[s2 & 1][t]), fl = __builtin_bit_cast(bf16x8, bl[s2 & 1][t]);
                acc[t] = __builtin_amdgcn_mfma_f32_16x16x32_bf16(a_lo, fl, acc[t], 0, 0, 0);
                acc[t] = __builtin_amdgcn_mfma_f32_16x16x32_bf16(a_lo, fh, acc[t], 0, 0, 0);
                acc[t] = __builtin_amdgcn_mfma_f32_16x16x32_bf16(a_hi, fl, acc[t], 0, 0, 0);
                acc[t] = __builtin_amdgcn_mfma_f32_16x16x32_bf16(a_hi, fh, acc[t], 0, 0, 0);
            }
            __builtin_amdgcn_sched_barrier(0);
        }
#pragma unroll
        for (int t = 0; t < 3; ++t)
#pragma unroll
            for (int i = 0; i < 4; ++i) PART[((rg * 4 + kq4) * 16 + 4 * kq + i) * 48 + 16 * t + r] = acc[t][i];
        __syncthreads();
        for (int e = tid; e < 32 * 36; e += NTHREADS) { const int rl = e / 36, n = e - rl * 36, g_ = rl >> 4, rr = rl & 15;
            const float sm = (PART[((g_ * 4 + 0) * 16 + rr) * 48 + n] + PART[((g_ * 4 + 1) * 16 + rr) * 48 + n]) + (PART[((g_ * 4 + 2) * 16 + rr) * 48 + n] + PART[((g_ * 4 + 3) * 16 + rr) * 48 + n]);
            LOGI[rl * 36 + n] = sm + (n < 4 ? F.b_rg[n] : F.b_re[n - 4]); }
        __syncthreads();
        if (tid < 32) {
            const LAS float* lg = LOGI + tid * 36;
            int grp = 0; float gm = lg[0];
#pragma unroll
            for (int g = 1; g < 4; ++g) if (lg[g] > gm) { gm = lg[g]; grp = g; }
            float gs = 0.f;
#pragma unroll
            for (int g = 0; g < 4; ++g) gs += expf(lg[g] - gm);
            const float pgrp = 1.0f / gs;
            float el[8];
#pragma unroll
            for (int e = 0; e < 8; ++e) { el[e] = lg[4 + e]; if (grp == 1) el[e] = lg[12 + e]; if (grp == 2) el[e] = lg[20 + e]; if (grp == 3) el[e] = lg[28 + e]; }
            int e0 = 0; float v0 = el[0];
#pragma unroll
            for (int e = 1; e < 8; ++e) if (el[e] > v0) { v0 = el[e]; e0 = e; }
            int e1 = -1; float v1 = -INFINITY;
#pragma unroll
            for (int e = 0; e < 8; ++e) if (e != e0 && el[e] > v1) { v1 = el[e]; e1 = e; }
            const float p1 = expf(v1 - v0), w0 = pgrp / (1.0f + p1), w1 = pgrp * p1 / (1.0f + p1);
            const int m = rb * 32 + tid;
            const int ea = grp * 8 + e0, eb = grp * 8 + e1;
            LAS unsigned* LC = (LAS unsigned*)(LOGI + 32 * 36);
            LC[tid] = 0u; LDS_WAIT(); asm volatile("" ::: "memory");
            const unsigned ra = __hip_atomic_fetch_add(LC + ea, 1u, __ATOMIC_RELAXED, __HIP_MEMORY_SCOPE_WORKGROUP);
            const unsigned rbk = __hip_atomic_fetch_add(LC + eb, 1u, __ATOMIC_RELAXED, __HIP_MEMORY_SCOPE_WORKGROUP);
            LDS_WAIT(); asm volatile("" ::: "memory");
            { const unsigned c_ = LC[tid]; unsigned base = 0u; if (c_) base = __hip_atomic_fetch_add(F.ctl + CW_CNT + CNT_STRIDE * tid, c_, RLX_AGENT); LC[32 + tid] = base; }
            LDS_WAIT(); asm volatile("" ::: "memory");
            const unsigned sa = LC[32 + ea] + ra, sb = LC[32 + eb] + rbk;
            LIST[ea * M + sa] = 2 * m; LISTW[ea * M + sa] = w0;
            LIST[eb * M + sb] = 2 * m + 1; LISTW[eb * M + sb] = w1;
        }
    }
}

template <bool DEEP> __device__ __forceinline__ void expert_gu_weights(Frame& F, int e0, int e1) {
    LAS float* scr = (LAS float*)(F.lds + F.wave * 16384);
    const int gw = F.bid * NWAVES + F.wave, NGW = F.G * NWAVES;
#define P8_DESC(it, d) do { const int e_ = e0 + (it) / 1024; const int r_ = (it) % 1024; d.K = DM; d.N = EFF; d.WT = (bf16_t*)(F.ws + wgu_off(e_)); \
        if (r_ < 512) { d.W = F.w_eg + (size_t)e_ * DM * EFF; d.kind = 2; d.item = r_; } \
        else { d.W = F.w_eu + (size_t)e_ * DM * EFF; d.kind = 3; d.item = r_ - 512; } } while (0)
    if (DEEP) TD_STREAM2(gw, NGW, (e1 - e0) * 1024, P8_DESC, F.lane, scr); else TD_STREAM(gw, NGW, (e1 - e0) * 1024, P8_DESC, F.lane, scr);
#undef P8_DESC
}
__device__ __forceinline__ void p8_expert_weights(Frame& F) { __syncthreads(); expert_gu_weights<false>(F, NEARLY, NEXP); }

constexpr int MOE_TAB_OFF = LDSCTL_OFF + 2048;
struct ProbMoe : ProbBase {
    unsigned char* ws; const LAS int* tab; int nct; unsigned* done;
    __device__ __forceinline__ bool decode(int L, U& u) const {
        const int l = (int)(threadIdx.x & 31); const bool in = (L >= tab[65 + l]) && (L < tab[66 + l]);
        const unsigned long long bal = __ballot(in);
        if (bal == 0ull) return false;
        const int e = __builtin_ctzll(bal); const int rem = L - tab[65 + e];
        u.aux = e; u.pm = rem / nct; u.pn = rem - u.pm * nct; return true;
    }
    __device__ __forceinline__ int rowbase(int e) const { return tab[32 + e]; }
    __device__ __forceinline__ int count(int e) const { return tab[e]; }
};
__device__ __forceinline__ void moe_table(LAS unsigned char* lds, const unsigned* cnt, int nct) {
    LAS int* tab = (LAS int*)(lds + MOE_TAB_OFF);
    __syncthreads();
    if (threadIdx.x < NEXP) tab[threadIdx.x] = (int)__hip_atomic_load(cnt + CNT_STRIDE * threadIdx.x, __ATOMIC_RELAXED, __HIP_MEMORY_SCOPE_AGENT);
    __syncthreads();
    if (threadIdx.x == 0) { int rb = 0, st = 0; for (int e = 0; e < NEXP; ++e) { tab[32 + e] = rb; tab[65 + e] = st; const int nrt = (tab[e] + 255) >> 8; rb += nrt * 256; st += nrt * nct; } tab[64] = rb; tab[97] = st; }
    __syncthreads();
}
struct ProbMoe1 : ProbMoe {
    static constexpr bool PERM = true;
    __device__ __forceinline__ bool next(int i, U& u) const { return decode(i * G + c, u); }
    __device__ __forceinline__ void bases(const U& u, const char*& a, const char*& b) const { a = (const char*)(ws + WS_XN); b = (const char*)(ws + wgu_off(u.aux)) + ((size_t)u.pn * 256) * K * 2; }
    __device__ __forceinline__ void lane_offs(const U& u, const int (&stR)[2], const int (&stC)[2], unsigned (&va)[2][2]) const {
        const int* LIST = (const int*)(ws + WS_LIST); const int n = count(u.aux);
#pragma unroll
        for (int h = 0; h < 2; ++h)
#pragma unroll
            for (int i = 0; i < 2; ++i) { const int sl = u.pm * 256 + h * 128 + stR[i]; const int tok = LIST[u.aux * M + (sl < n ? sl : 0)] >> 1; va[h][i] = (unsigned)(tok * K + stC[i]) * 2u; }
    }
    __device__ __forceinline__ void epi(f32x4 (&acc)[2][2][4][2], const U& u, int wr, int wc, int fr, int fq) const {
        const float* LISTW = (const float*)(ws + WS_LISTW); bf16_t* ACT = (bf16_t*)(ws + WS_ACT);
        const int n = count(u.aux), rb = rowbase(u.aux);
        const int f0 = u.pn * 128 + wc * 16 + 4 * fq;
        float wts[8];
#pragma unroll
        for (int ai = 0; ai < 2; ++ai)
#pragma unroll
            for (int m = 0; m < 4; ++m) { const int sl = u.pm * 256 + ai * 128 + wr * 64 + m * 16 + fr; wts[ai * 4 + m] = LISTW[u.aux * M + (sl < n ? sl : 0)]; }
        __builtin_amdgcn_sched_barrier(0);
#pragma unroll
        for (int ai = 0; ai < 2; ++ai)
#pragma unroll
            for (int m = 0; m < 4; ++m) { const int sl = u.pm * 256 + ai * 128 + wr * 64 + m * 16 + fr;
                if (sl < n) { const float wt = wts[ai * 4 + m];
#pragma unroll
                    for (int bj = 0; bj < 2; ++bj) { const f32x4 g = acc[ai][bj][m][0], uu = acc[ai][bj][m][1]; float v[4];
#pragma unroll
                        for (int e = 0; e < 4; ++e) v[e] = siluf_(g[e]) * uu[e] * wt;
                        const unsigned long long w = (unsigned long long)pk2(v[0], v[1]) | ((unsigned long long)pk2(v[2], v[3]) << 32);
                        __hip_atomic_store((unsigned long long*)(ACT + (size_t)(rb + sl) * EFF + f0 + bj * 64), w, RLX_AGENT); } } }
        asm volatile("s_waitcnt vmcnt(0)" ::: "memory");
        if ((threadIdx.x & 63) == 0) __hip_atomic_fetch_add(done + 16 * ((rb >> 8) + u.pm), 1u, RLX_AGENT);
    }
};
struct ProbMoe2 : ProbMoe {
    static constexpr bool PERM = true;
    __device__ __forceinline__ void ready(const U& u, bool me) const {
        if (me) { unsigned* p = done + 16 * ((rowbase(u.aux) >> 8) + u.pm); unsigned sp = 0;
            while (__hip_atomic_load(p, RLX_AGENT) < 32u) { __builtin_amdgcn_s_sleep(2); if (++sp > (1u << 20)) break; }
            __builtin_amdgcn_fence(__ATOMIC_ACQUIRE, "agent"); asm volatile("s_waitcnt vmcnt(0)" ::: "memory"); }
    }
    __device__ __forceinline__ bool next(int i, U& u) const {
        const int u1 = tab[97] >> 1;
        const int base = u1 / G, rem = u1 - base * G, tot = tab[97];
        int n_early = 2 * base * G; if (n_early > tot) n_early = tot;
        int L;
        if (c >= rem) { const int W = G - rem, first = c - rem; const int ce = (n_early > first) ? (n_early - first + W - 1) / W : 0;
            L = (i < ce) ? (i * W + first) : (n_early + (i - ce) * G + c); }
        else L = n_early + i * G + c;
        return decode(L, u);
    }
    __device__ __forceinline__ void bases(const U& u, const char*& a, const char*& b) const { a = (const char*)(ws + WS_ACT) + (size_t)(rowbase(u.aux) + u.pm * 256) * K * 2; b = (const char*)(ws + WS_WD_T) + ((size_t)u.aux * DM + u.pn * 256) * K * 2; }
    __device__ __forceinline__ void lane_offs(const U&, const int (&stR)[2], const int (&stC)[2], unsigned (&va)[2][2]) const { lane_offs_plain(stR, stC, va); }
    __device__ __forceinline__ void epi(f32x4 (&acc)[2][2][4][2], const U& u, int wr, int wc, int fr, int fq) const {
        const int* LIST = (const int*)(ws + WS_LIST); bf16_t* YS = (bf16_t*)(ws + WS_YS);
        const int n = count(u.aux);
        const int colw = u.pn * 256 + wc * 32 + 8 * fq;
        int slots[8];
#pragma unroll
        for (int ai = 0; ai < 2; ++ai)
#pragma unroll
            for (int m = 0; m < 4; ++m) { const int sl = u.pm * 256 + ai * 128 + wr * 64 + m * 16 + fr; slots[ai * 4 + m] = LIST[u.aux * M + (sl < n ? sl : 0)]; }
        __builtin_amdgcn_sched_barrier(0);
#pragma unroll
        for (int ai = 0; ai < 2; ++ai)
#pragma unroll
            for (int m = 0; m < 4; ++m) { const int sl = u.pm * 256 + ai * 128 + wr * 64 + m * 16 + fr;
                if (sl < n) { const int slot = slots[ai * 4 + m];
#pragma unroll
                    for (int bj = 0; bj < 2; ++bj) { const f32x4 v0 = acc[ai][bj][m][0], v1 = acc[ai][bj][m][1];
                        u32x4 w; w.x = pk2(v0[0], v0[1]); w.y = pk2(v0[2], v0[3]); w.z = pk2(v1[0], v1[1]); w.w = pk2(v1[2], v1[3]);
                        *(u32x4*)(YS + (size_t)slot * DM + colw + bj * 128) = w; } } }
    }
};

__device__ __forceinline__ void p11_final(Frame& F, float* dst) {
    const float* MOD = WSP(float, WS_MOD); const bf16_t* YS = WSP(bf16_t, WS_YS);
    const int gw = F.bid * NWAVES + F.wave, NGW = F.G * NWAVES, lane = F.lane;
    for (int m = gw; m < M; m += NGW) {
        const int b = m >> 12; const bf16_t* row = WSP(bf16_t, WS_X1) + (size_t)m * DM; float* orow = dst + (size_t)m * DM; f32x4 v[8]; float s = 0.f;
#pragma unroll
        for (int j = 0; j < 8; ++j) { const int k = 4 * (lane + 64 * j); const u32x2 xr = __builtin_nontemporal_load((const u32x2*)(row + k)); const f32x4 xv = {bf2f(xr.x & 0xffffu), bf2f(xr.x >> 16), bf2f(xr.y & 0xffffu), bf2f(xr.y >> 16)}, gt = *(const f32x4*)(MOD + b * 12288 + 5 * DM + k);
            const u32x2 y0 = __builtin_nontemporal_load((const u32x2*)(YS + (size_t)(2 * m) * DM + k)), y1 = __builtin_nontemporal_load((const u32x2*)(YS + (size_t)(2 * m + 1) * DM + k));
            f32x4 y; y.x = bf2f(y0.x & 0xffffu) + bf2f(y1.x & 0xffffu); y.y = bf2f(y0.x >> 16) + bf2f(y1.x >> 16); y.z = bf2f(y0.y & 0xffffu) + bf2f(y1.y & 0xffffu); y.w = bf2f(y0.y >> 16) + bf2f(y1.y >> 16);
            v[j] = xv + gt * y; s += (v[j].x * v[j].x + v[j].y * v[j].y) + (v[j].z * v[j].z + v[j].w * v[j].w); }
        f32x4 gf[8];
#pragma unroll
        for (int j = 0; j < 8; ++j) gf[j] = *(const f32x4*)(F.g_final + 4 * (lane + 64 * j));
        const float rs = 1.0f / sqrtf(wave_sum(s) * (1.0f / DM) + EPS);
#pragma unroll
        for (int j = 0; j < 8; ++j) { const int k = 4 * (lane + 64 * j); __builtin_nontemporal_store(v[j] * rs * gf[j], (f32x4*)(orow + k)); }
    }
}

constexpr int NPHASE = 12;
struct Args { const void* in[21]; float* out; unsigned char* ws; int ph_lo, ph_hi; };
__global__ void __launch_bounds__(NTHREADS, 2) hybrid_block_fwd(Args args) {
    extern __shared__ __attribute__((aligned(16))) unsigned char lds_raw[];
    Frame F;
    F.lds = (LAS unsigned char*)lds_raw;
    F.tid = threadIdx.x; F.lane = F.tid & 63; F.wave = __builtin_amdgcn_readfirstlane(F.tid >> 6); F.G = gridDim.x; F.bid = blockIdx.x;
    F.ws = args.ws; F.ctl = (unsigned*)(args.ws + WS_CTL); F.out = args.out;
    F.x = (const float*)args.in[0]; F.c = (const float*)args.in[1]; F.positions = (const int*)args.in[2]; F.w_ada = (const float*)args.in[3]; F.b_ada = (const float*)args.in[4];
    F.g_norm1 = (const float*)args.in[5]; F.w_in = (const float*)args.in[6]; F.g_head = (const float*)args.in[7]; F.hglb = (const float*)args.in[8]; F.w_attn_up = (const float*)args.in[9];
    F.w_hgrn_up = (const float*)args.in[10]; F.w_out = (const float*)args.in[11]; F.g_norm2 = (const float*)args.in[12]; F.w_rg = (const float*)args.in[13]; F.b_rg = (const float*)args.in[14];
    F.w_re = (const float*)args.in[15]; F.b_re = (const float*)args.in[16]; F.w_eg = (const float*)args.in[17]; F.w_eu = (const float*)args.in[18]; F.w_ed = (const float*)args.in[19]; F.g_final = (const float*)args.in[20];
    volatile LAS unsigned* MISC = (volatile LAS unsigned*)(F.lds + MISC_OFF);
    for (int u = F.tid; u < (LDS_EXTRA - LDSCTL_OFF) / 4; u += NTHREADS) ((LAS unsigned*)(F.lds + LDSCTL_OFF))[u] = 0u;
    __syncthreads();
    const int lo = args.ph_lo, hi = args.ph_hi;
    XcdBarrier bar; bar.bar = F.ctl + CW_BAR; bar.x = 0; bar.st = nullptr;
    if (hi - lo > 1) bar = xcd_barrier_post(F.ctl + CW_BAR, MISC + 8);
#ifndef PHMASK
#define PHMASK 0xfff
#endif
#define IN(k) (((PHMASK >> (k)) & 1) && lo <= (k) && (k) < hi)
#define SEAM(k) do { if (IN(k) && IN((k) + 1)) xcd_barrier(bar); } while (0)
#ifndef REPMASK
#define REPMASK 0
#endif
#define RUN2(k, BODY) do { if (IN(k)) { BODY } if (((REPMASK >> (k)) & 1) && IN(k)) { xcd_barrier(bar); BODY } } while (0)
    RUN2(0, p0_prologue(F);); SEAM(0);
    RUN2(1, p1_norm1(F);); SEAM(1);
#define BODY2 { ProbWin P; P.K = DM; P.G = F.G; P.c = F.bid; P.A = (const char*)(F.ws + WS_XN); P.B = (const char*)(F.ws + WS_WIN_T); P.ws = F.ws; P.hglb = F.hglb; pg8::gemm_phase(F.lds, P); }
    RUN2(2, BODY2); SEAM(2);
    RUN2(3, p3_indexer(F); p3_late_weights(F); p3_hgrn_upd(F);); if ((REPMASK >> 20) & 1) { xcd_barrier(bar); p3_indexer(F); } if ((REPMASK >> 21) & 1) { xcd_barrier(bar); p3_hgrn_upd(F); } SEAM(3);
    if (IN(4)) {
        if (F.wave >= 4) { p4_down_weights(F); expert_gu_weights<false>(F, 0, NEARLY); }
        p4_select(F);
        if (F.wave < 4) { p4_down_weights(F); expert_gu_weights<false>(F, 0, NEARLY); }
        p4_hgrn_scan(F); } if ((REPMASK >> 15) & 1) { xcd_barrier(bar); p4_select(F); } if ((REPMASK >> 16) & 1) { xcd_barrier(bar); p4_hgrn_scan(F); } SEAM(4);
    RUN2(5, if (F.bid & 1) { p5_hgrn_out(F); __syncthreads(); p5_attention(F); } else { p5_attention(F); __syncthreads(); p5_hgrn_out(F); }); if ((REPMASK >> 13) & 1) { xcd_barrier(bar); p5_attention(F); } if ((REPMASK >> 14) & 1) { xcd_barrier(bar); p5_hgrn_out(F); } SEAM(5);
#define BODY6 { ProbMerge P; P.K = 1024; P.G = F.G; P.c = F.bid; P.ws = F.ws; pg8::gemm_phase(F.lds, P); }
    RUN2(6, BODY6); SEAM(6);
#define BODY7 { ProbOut P; P.K = DM; P.G = F.G; P.c = F.bid; P.ws = F.ws; P.x = F.x; pg8::gemm_phase(F.lds, P); }
    RUN2(7, BODY7); SEAM(7);
    if (IN(8)) {
        if (F.bid & 1) { p8_norm2_route(F); p8_expert_weights(F); } else { p8_expert_weights(F); p8_norm2_route(F); }
        if ((REPMASK >> 17) & 1) { xcd_barrier(bar); if (F.bid == 0 && F.tid < 32) __hip_atomic_store(F.ctl + CW_CNT + CNT_STRIDE * F.tid, 0u, RLX_AGENT); xcd_barrier(bar); p8_norm2_route(F); } } SEAM(8);
#define XCD_LBID(F) (((F).G % 8 == 0) ? (((F).bid & 7) * ((F).G >> 3) + ((F).bid >> 3)) : (F).bid)
#define BODY9 { moe_table(F.lds, F.ctl + CW_CNT, 4); ProbMoe1 P; P.K = DM; P.G = F.G; P.c = XCD_LBID(F); P.ws = F.ws; P.tab = (const LAS int*)(F.lds + MOE_TAB_OFF); P.nct = 4; P.done = F.ctl + CW_DONE; pg8::gemm_phase(F.lds, P); }
    if (IN(9)) BODY9;
#if MK_MULTI
    SEAM(9);
#endif
#define BODY10 { moe_table(F.lds, F.ctl + CW_CNT, 8); ProbMoe2 P; P.K = EFF; P.G = F.G; P.c = XCD_LBID(F); P.ws = F.ws; P.tab = (const LAS int*)(F.lds + MOE_TAB_OFF); P.nct = 8; P.done = F.ctl + CW_DONE; pg8::gemm_phase(F.lds, P); }
    if (IN(10)) BODY10; SEAM(10);
    if (IN(11)) { if ((REPMASK >> 18) & 1) { p11_final(F, WSP(float, WS_UPDT)); xcd_barrier(bar); } p11_final(F, F.out); }
    if ((REPMASK >> 19) & 1) { xcd_barrier(bar); BODY2 }
#undef IN
#undef SEAM
}

extern "C" void kernel_launch(void* const* d_in, const int* in_sizes, int n_in, void* d_out, int out_size, void* d_ws, size_t ws_size, hipStream_t stream) {
    static int grid = 0;
    if (grid == 0) {
        if (n_in != 21 || in_sizes[0] != M * DM || out_size != M * DM || ws_size < WS_END) { fprintf(stderr, "kernel_launch: unexpected shapes/workspace (n_in %d, in0 %d, out %d, ws %zu)\n", n_in, n_in > 0 ? in_sizes[0] : -1, out_size, ws_size); grid = -1; return; }
        int dev = 0, cus = 0, per_cu = 0;
        if (hipGetDevice(&dev) != hipSuccess || hipDeviceGetAttribute(&cus, hipDeviceAttributeMultiprocessorCount, dev) != hipSuccess) { grid = -1; return; }
        if (hipFuncSetAttribute((const void*)hybrid_block_fwd, hipFuncAttributeMaxDynamicSharedMemorySize, LDS_BYTES) != hipSuccess) { fprintf(stderr, "kernel_launch: hipFuncSetAttribute failed\n"); grid = -1; return; }
        if (hipOccupancyMaxActiveBlocksPerMultiprocessor(&per_cu, (const void*)hybrid_block_fwd, NTHREADS, LDS_BYTES) != hipSuccess || per_cu < 1) fprintf(stderr, "kernel_launch: occupancy query reports %d\n", per_cu);
        (void)hipGetLastError();
        grid = cus;
    }
    if (grid < 0) return;
    (void)hipMemsetAsync((char*)d_ws + WS_CTL, 0, CTL_ZERO_BYTES, stream);
    Args a{};
    for (int i = 0; i < 21; ++i) a.in[i] = d_in[i];
    a.out = (float*)d_out; a.ws = (unsigned char*)d_ws;
#if MK_MULTI
    for (int p = 0; p < NPHASE; ++p) { a.ph_lo = p; a.ph_hi = p + 1; hipLaunchKernelGGL(hybrid_block_fwd, dim3(grid), dim3(NTHREADS), LDS_BYTES, stream, a); }
#else
    a.ph_lo = 0; a.ph_hi = NPHASE; hipLaunchKernelGGL(hybrid_block_fwd, dim3(grid), dim3(NTHREADS), LDS_BYTES, stream, a);
#endif
}
```
